# Optimizing an MI355X kernel written in HIP

```python
import functools
import jax, jax.numpy as jnp
from jax import lax
import numpy as np

D_MODEL = 2048
BATCH = 16
SEQ = 2048
DEPTH = 2
DEC_BATCH = 16
DEC_SEQ = 32
PAST_LEN = 4096

CHUNK = 64
M_HEADS = 4
M_DK = 128
M_DV = 256
M_WIDTH = M_HEADS * M_DV
A_HEADS = 16
A_KV_HEADS = 4
A_HEAD_DIM = 64
A_GROUP = A_HEADS // A_KV_HEADS
A_WIDTH = A_HEADS * A_HEAD_DIM
WINDOW = 128
N_WIN_CHUNKS = WINDOW // CHUNK
N_BUCKETS = 32
MAX_DISTANCE = 128
D_FF = 4 * D_MODEL
EPS = 1e-6
NEG_INF = -1e30
SPLITS = (M_HEADS * M_DK, M_HEADS * M_DK, M_WIDTH, M_WIDTH, M_HEADS, M_HEADS,
          A_WIDTH, A_KV_HEADS * A_HEAD_DIM, A_KV_HEADS * A_HEAD_DIM)
D_IN = sum(SPLITS)

kernel_name = 'hymba_mlstm_swa_sink_stream_step'


def rms_norm(x, g):
    xf = x.astype(jnp.float32)
    y = xf * lax.rsqrt(jnp.mean(xf * xf, axis=-1, keepdims=True) + EPS)
    return (y * g.astype(jnp.float32)).astype(x.dtype)


def t5_bucket(rel):
    half = N_BUCKETS // 2
    exact = half // 2
    n = np.abs(rel)
    large = exact + (np.log(np.maximum(n, 1) / exact) / np.log(MAX_DISTANCE / exact) * (half - exact)).astype(np.int32)
    large = np.minimum(large, half - 1)
    return (rel > 0).astype(np.int32) * half + np.where(n < exact, n, large).astype(np.int32)


def band_bias(rel_bias, n_prev, lq, lk):
    rel = (np.arange(lk)[None, :] - n_prev) - np.arange(lq)[:, None]
    b = rel_bias[jnp.asarray(t5_bucket(rel))]
    return b.transpose(2, 0, 1).reshape(A_KV_HEADS, A_GROUP, lq, lk).astype(jnp.float32)


def sink_attention(q, k, v, bias, sink, valid=None):
    s = jnp.einsum('...qhgd,...khd->...hgqk', q, k).astype(jnp.float32) * A_HEAD_DIM ** -0.5 + bias
    if valid is not None:
        s = jnp.where(valid, s, NEG_INF)
    sk = sink.astype(jnp.float32).reshape(A_KV_HEADS, A_GROUP, 1)
    mx = jnp.maximum(s.max(-1), sk)
    p = jnp.exp(s - mx[..., None])
    p = p / (p.sum(-1) + jnp.exp(sk - mx))[..., None]
    return jnp.einsum('...hgqk,...khd->...qhgd', p.astype(v.dtype), v)


def attn_prompt(q, k, v, rel_bias, sink):
    B, S = q.shape[:2]
    nc = S // CHUNK
    lk = WINDOW + CHUNK
    qc = q.reshape(B, nc, CHUNK, A_KV_HEADS, A_GROUP, A_HEAD_DIM)

    def band(a):
        ap = jnp.pad(a, ((0, 0), (WINDOW, 0), (0, 0), (0, 0))).reshape(B, nc + N_WIN_CHUNKS, CHUNK, A_KV_HEADS, A_HEAD_DIM)
        return jnp.concatenate([ap[:, w:w + nc] for w in range(N_WIN_CHUNKS + 1)], axis=2)

    key_pos = np.arange(nc)[:, None] * CHUNK + np.arange(lk)[None, :] - WINDOW
    valid = jnp.asarray(key_pos >= 0)[:, None, None, None, :]
    o = sink_attention(qc, band(k), band(v), band_bias(rel_bias, WINDOW, CHUNK, lk), sink, valid)
    return o.reshape(B, S, A_WIDTH), (k[:, -WINDOW:], v[:, -WINDOW:])


def attn_sample(q, k, v, ck, cv, rel_bias, sink):
    B, L = q.shape[:2]
    n_win = ck.shape[1]
    kk = jnp.concatenate([ck.astype(k.dtype), k], axis=1)
    vv = jnp.concatenate([cv.astype(v.dtype), v], axis=1)
    o = sink_attention(q.reshape(B, L, A_KV_HEADS, A_GROUP, A_HEAD_DIM), kk, vv,
                       band_bias(rel_bias, n_win, L, n_win + L), sink)
    return o.reshape(B, L, A_WIDTH), (kk[:, -n_win:], vv[:, -n_win:])


def mlstm_chunk(carry, xs):
    C, n, m = carry
    q, k, v, ig, logf = xs
    L = q.shape[1]
    b = jnp.cumsum(logf, axis=1).transpose(0, 2, 1)
    igh = ig.transpose(0, 2, 1)
    causal = jnp.tril(jnp.ones((L, L), dtype=bool))
    D = jnp.where(causal, b[..., :, None] - b[..., None, :] + igh[..., None, :], NEG_INF)
    inter = b + m[..., None]
    m_t = jnp.maximum(inter, D.max(-1))
    w = jnp.exp(D - m_t[..., None]) * jnp.einsum('blhk,bshk->bhls', q, k)
    g = jnp.exp(inter - m_t)
    num = jnp.einsum('bhls,bshv->blhv', w, v) + jnp.einsum('bhl,bhvk,blhk->blhv', g, C, q)
    den = w.sum(-1) + g * jnp.einsum('bhk,blhk->bhl', n, q)
    h = num / jnp.maximum(jnp.abs(den), jnp.exp(-m_t)).transpose(0, 2, 1)[..., None]
    m_end = m_t[..., -1]
    wk = jnp.exp(b[..., -1:] - b + igh - m_end[..., None])
    decay = jnp.exp(inter[..., -1] - m_end)
    C_new = decay[..., None, None] * C + jnp.einsum('bhs,bshv,bshk->bhvk', wk, v, k)
    n_new = decay[..., None] * n + jnp.einsum('bhs,bshk->bhk', wk, k)
    return (C_new, n_new, m_end), h


def mlstm_prompt(q, k, v, ig, logf):
    B, S = q.shape[:2]
    nc = S // CHUNK

    def chunks(a):
        return a.reshape(B, nc, CHUNK, *a.shape[2:]).swapaxes(0, 1)

    init = (jnp.zeros((B, M_HEADS, M_DV, M_DK), jnp.float32),
            jnp.zeros((B, M_HEADS, M_DK), jnp.float32),
            jnp.zeros((B, M_HEADS), jnp.float32))
    state, h = lax.scan(mlstm_chunk, init, (chunks(q), chunks(k), chunks(v), chunks(ig), chunks(logf)))
    return h.swapaxes(0, 1).reshape(B, S, M_HEADS, M_DV), state


def mlstm_sample(q, k, v, ig, logf, C, n, m):
    f32 = jnp.float32
    state, h = mlstm_chunk((C.astype(f32), n.astype(f32), m.astype(f32)), (q, k, v, ig, logf))
    return h, state


def trunk_layer(x, attn_fn, mlstm_fn, g_mix, w_in, b_i, b_f, g_q, g_k, g_mo, g_ao, w_out, g_ffn, w_up, w_down):
    B, L, _ = x.shape
    f32 = jnp.float32
    h = rms_norm(x, g_mix)
    mq, mk, mv, mo, mi, mf, aq, ak, av = jnp.split(h @ w_in, np.cumsum(SPLITS)[:-1].tolist(), axis=-1)
    hm, m_state = mlstm_fn(mq.reshape(B, L, M_HEADS, M_DK).astype(f32),
                           mk.reshape(B, L, M_HEADS, M_DK).astype(f32) * M_DK ** -0.5,
                           mv.reshape(B, L, M_HEADS, M_DV).astype(f32),
                           (mi + b_i).astype(f32),
                           jax.nn.log_sigmoid((mf + b_f).astype(f32)))
    hm = rms_norm(hm, g_mo.reshape(M_HEADS, M_DV)).reshape(B, L, M_WIDTH).astype(x.dtype) * jax.nn.sigmoid(mo)
    ha, kv_state = attn_fn(rms_norm(aq.reshape(B, L, A_HEADS, A_HEAD_DIM), g_q),
                           rms_norm(ak.reshape(B, L, A_KV_HEADS, A_HEAD_DIM), g_k),
                           av.reshape(B, L, A_KV_HEADS, A_HEAD_DIM))
    ha = rms_norm(ha, g_ao)
    x = x + jnp.concatenate([hm, ha], axis=-1) @ w_out
    u = rms_norm(x, g_ffn) @ w_up
    x = x + jnp.square(jax.nn.relu(u)) @ w_down
    return x, kv_state, m_state


def setup_inputs(seed: int = 0) -> dict:
    key = jax.random.key(seed)
    ks = jax.random.split(key, 24)
    n_win = min(WINDOW, PAST_LEN)

    def nrm(k, shape, scale):
        return scale * jax.random.normal(k, shape, jnp.float32)

    def gain(k, shape):
        return 1.0 + 0.05 * jax.random.normal(k, shape, jnp.float32)

    return {
        'x_prompt': nrm(ks[0], (BATCH, SEQ, D_MODEL), 1.0),
        'x_sample': nrm(ks[1], (DEC_BATCH, DEC_SEQ, D_MODEL), 1.0),
        'cache_k': nrm(ks[2], (DEPTH, DEC_BATCH, n_win, A_KV_HEADS, A_HEAD_DIM), 1.0),
        'cache_v': nrm(ks[3], (DEPTH, DEC_BATCH, n_win, A_KV_HEADS, A_HEAD_DIM), 1.0),
        'state_C': nrm(ks[4], (DEPTH, DEC_BATCH, M_HEADS, M_DV, M_DK), 0.5),
        'state_n': nrm(ks[5], (DEPTH, DEC_BATCH, M_HEADS, M_DK), 0.5),
        'state_m': nrm(ks[6], (DEPTH, DEC_BATCH, M_HEADS), 1.0),
        'rel_bias': nrm(ks[7], (N_BUCKETS, A_HEADS), 0.5),
        'g_mix': gain(ks[8], (DEPTH, D_MODEL)),
        'w_in': nrm(ks[9], (DEPTH, D_MODEL, D_IN), D_MODEL ** -0.5),
        'b_i': nrm(ks[10], (DEPTH, M_HEADS), 0.1),
        'b_f': 3.0 + nrm(ks[11], (DEPTH, M_HEADS), 0.5),
        'g_q': gain(ks[12], (DEPTH, A_HEAD_DIM)),
        'g_k': gain(ks[13], (DEPTH, A_HEAD_DIM)),
        'sinks': nrm(ks[14], (DEPTH, A_HEADS), 0.5),
        'g_mo': gain(ks[15], (DEPTH, M_WIDTH)),
        'g_ao': gain(ks[16], (DEPTH, A_WIDTH)),
        'w_out': nrm(ks[17], (DEPTH, M_WIDTH + A_WIDTH, D_MODEL), (M_WIDTH + A_WIDTH) ** -0.5),
        'g_ffn': gain(ks[18], (DEPTH, D_MODEL)),
        'w_up': nrm(ks[19], (DEPTH, D_MODEL, D_FF), D_MODEL ** -0.5),
        'w_down': nrm(ks[20], (DEPTH, D_FF, D_MODEL), D_FF ** -0.5),
    }


def reference(x_prompt, x_sample, cache_k, cache_v, state_C, state_n, state_m, rel_bias,
              g_mix, w_in, b_i, b_f, g_q, g_k, sinks, g_mo, g_ao, w_out, g_ffn, w_up, w_down):
    xp, xs = x_prompt, x_sample
    p_k, p_v, p_C, p_n, p_m = [], [], [], [], []
    s_k, s_v, s_C, s_n, s_m = [], [], [], [], []
    for l in range(DEPTH):
        w = (g_mix[l], w_in[l], b_i[l], b_f[l], g_q[l], g_k[l], g_mo[l], g_ao[l], w_out[l], g_ffn[l], w_up[l], w_down[l])
        xp, (k_, v_), (C_, n_, m_) = trunk_layer(
            xp, functools.partial(attn_prompt, rel_bias=rel_bias, sink=sinks[l]), mlstm_prompt, *w)
        p_k.append(k_); p_v.append(v_); p_C.append(C_); p_n.append(n_); p_m.append(m_)
        xs, (k_, v_), (C_, n_, m_) = trunk_layer(
            xs,
            functools.partial(attn_sample, ck=cache_k[l], cv=cache_v[l], rel_bias=rel_bias, sink=sinks[l]),
            functools.partial(mlstm_sample, C=state_C[l], n=state_n[l], m=state_m[l]), *w)
        s_k.append(k_); s_v.append(v_); s_C.append(C_); s_n.append(n_); s_m.append(m_)
    return (xp, xs,
            jnp.stack(p_k), jnp.stack(p_v), jnp.stack(p_C), jnp.stack(p_n), jnp.stack(p_m),
            jnp.stack(s_k), jnp.stack(s_v), jnp.stack(s_C), jnp.stack(s_n), jnp.stack(s_m))
```

```cpp
#include <hip/hip_runtime.h>
#include <hip/hip_cooperative_groups.h>
#include <cstdio>
#include <cstdint>
namespace cg = cooperative_groups;
namespace pg8 {
#define PG8_LAS __attribute__((address_space(3)))
typedef unsigned short bf16_t;
typedef short bf16x8 __attribute__((ext_vector_type(8)));
typedef float f32x4 __attribute__((ext_vector_type(4)));
typedef unsigned u32x4 __attribute__((ext_vector_type(4)));
constexpr int BM = 256, BK = 64, HALF = 128, HTB = HALF * BK * 2  , STAGE_BYTES = 8 * HTB, NXCD = 8, WGM = 8;

__host__ __device__ __forceinline__ int lds_byte(int r, int c) { const int st = (r >> 4) * 2 + (c >> 5), rr = r & 15, cc = c & 31, ob = rr * 64 + cc * 2; return st * 1024 + (ob ^ (((ob >> 9) & 1) << 5)); }
__host__ __device__ __forceinline__ void stage_rc(int b, int& R, int& C) { const int st = b / 1024, sb = b % 1024, swz = sb ^ (((sb >> 9) & 1) << 5); R = (st >> 1) * 16 + swz / 64; C = (st & 1) * 32 + (swz % 64) / 2; }
__host__ __device__ __forceinline__ int perm32(int rho) { const int n = rho >> 4, i = rho & 15; return 8 * (i >> 2) + 4 * n + (i & 3); }

struct Unit { int pm, pn, ko; };
struct Gemm { const bf16_t* A; const bf16_t* Bt; int M, N, K, ld; };

struct StaticOrder {
    int nM, nN, nwg, G, c;
    __host__ __device__ void init(int M, int N, int G_, int c_) { nM = M / BM; nN = N / BM; nwg = nM * nN; G = G_; c = c_; }
    __host__ __device__ bool next(int i, Unit& u) const {
        const long L = (long)i * G + c; if (L >= nwg) return false;
        int wgid = (int)L; { const int q = nwg / NXCD, r = nwg % NXCD, xcd = wgid % NXCD, off = wgid / NXCD; wgid = (xcd < r ? xcd * (q + 1) : r * (q + 1) + (xcd - r) * q) + off; }
        const int nig = WGM * nN, gid = wgid / nig, fm = gid * WGM, gsz = (nM - fm) < WGM ? (nM - fm) : WGM;
        u.pm = fm + ((wgid % nig) % gsz); u.pn = (wgid % nig) / gsz; u.ko = 0; return true;
    }
    __device__ __forceinline__ void a_ready(const Unit&) const {}
    __device__ __forceinline__ void done(const Unit&) const {}
};

__device__ __forceinline__ unsigned cvt_pk_bf16(float lo, float hi) { unsigned r; asm volatile("v_cvt_pk_bf16_f32 %0, %1, %2" : "=v"(r) : "v"(lo), "v"(hi)); return r; }
typedef unsigned u32x2 __attribute__((ext_vector_type(2)));
template <int ACT> struct EpiBf16 {
    static constexpr bool PERM = true, AFTER_DRAIN = false, KSCALE = false;
    bf16_t* O; int ldc;
    __device__ __forceinline__ void operator()(const f32x4 (&acc)[2][2][4][2], const Unit& u, int wr, int wc, int fr, int fq) const {
        const int row0 = u.pm * BM + wr * 64 + fr; const int col0 = u.pn * BM + wc * 32 + 8 * fq;
#pragma unroll
        for (int ai = 0; ai < 2; ++ai)
#pragma unroll
            for (int m = 0; m < 4; ++m) { bf16_t* rowp = O + (size_t)(row0 + ai * HALF + m * 16) * ldc + col0;
#pragma unroll
                for (int bj = 0; bj < 2; ++bj) { f32x4 v0 = acc[ai][bj][m][0], v1 = acc[ai][bj][m][1];
                    if (ACT == 2) {
#pragma unroll
                        for (int e = 0; e < 4; ++e) { float a = fmaxf(v0[e], 0.f), b = fmaxf(v1[e], 0.f); v0[e] = a * a; v1[e] = b * b; } }
                    u32x4 w; w.x = cvt_pk_bf16(v0[0], v0[1]); w.y = cvt_pk_bf16(v0[2], v0[3]); w.z = cvt_pk_bf16(v1[0], v1[1]); w.w = cvt_pk_bf16(v1[2], v1[3]);
                    *(u32x4*)(rowp + bj * HALF) = w; } }
    }
};
struct EpiRes {
    static constexpr bool PERM = false, AFTER_DRAIN = false, KSCALE = false;
    const float* base_lo; const float* base_hi; float* out; int ldc; int split_pm;
    __device__ __forceinline__ void operator()(const f32x4 (&acc)[2][2][4][2], const Unit& u, int wr, int wc, int fr, int fq) const {
        const float* base = (u.pm < split_pm) ? base_lo : base_hi;
        const int col0 = u.pn * BM + wc * 32 + 4 * fq;
#pragma unroll
        for (int ai = 0; ai < 2; ++ai)
#pragma unroll
            for (int m = 0; m < 4; ++m) { const size_t off = (size_t)(u.pm * BM + ai * HALF + wr * 64 + m * 16 + fr) * ldc + col0;
                f32x4 bs[2][2];
#pragma unroll
                for (int bj = 0; bj < 2; ++bj)
#pragma unroll
                    for (int n = 0; n < 2; ++n) bs[bj][n] = *(const f32x4*)(base + off + bj * HALF + n * 16);
#pragma unroll
                for (int bj = 0; bj < 2; ++bj)
#pragma unroll
                    for (int n = 0; n < 2; ++n) *(f32x4*)(out + off + bj * HALF + n * 16) = bs[bj][n] + acc[ai][bj][m][n];
                asm volatile("" ::: "memory"); }
    }
};

struct SplitKOrder {
    int nN, nsplit, kslice, pm0, G, c;
    __host__ __device__ void init(int N, int nsplit_, int kslice_, int pm0_, int G_, int c_) { nN = N / BM; nsplit = nsplit_; kslice = kslice_; pm0 = pm0_; G = G_; c = c_; }
    __host__ __device__ bool next(int i, Unit& u) const {
        const int L = i * G + c; if (L >= 2 * nN * nsplit) return false;
        const int ks = L % nsplit, t = L / nsplit; u.pn = t % nN; u.pm = pm0 + t / nN; u.ko = ks * kslice; return true; }
    __device__ __forceinline__ void a_ready(const Unit&) const {}
    __device__ __forceinline__ void done(const Unit&) const {}
};
struct EpiPartial {
    static constexpr bool PERM = false, AFTER_DRAIN = false, KSCALE = false;
    float* P; int ldc, kslice, row0, rows;
    __device__ __forceinline__ void operator()(const f32x4 (&acc)[2][2][4][2], const Unit& u, int wr, int wc, int fr, int fq) const {
        const int col0 = u.pn * BM + wc * 32 + 4 * fq; float* base = P + (size_t)(u.ko / kslice) * rows * ldc;
#pragma unroll
        for (int ai = 0; ai < 2; ++ai)
#pragma unroll
            for (int m = 0; m < 4; ++m) { float* p = base + (size_t)(u.pm * BM + ai * HALF + wr * 64 + m * 16 + fr - row0) * ldc + col0;
#pragma unroll
                for (int bj = 0; bj < 2; ++bj)
#pragma unroll
                    for (int n = 0; n < 2; ++n) *(f32x4*)(p + bj * HALF + n * 16) = acc[ai][bj][m][n]; }
    }
};

__device__ __forceinline__ float bf_lo(unsigned w) { return __builtin_bit_cast(float, w << 16); }
__device__ __forceinline__ float bf_hi(unsigned w) { return __builtin_bit_cast(float, w & 0xffff0000u); }
template <int ACT, bool GATES> struct EpiScale {
    static constexpr bool PERM = true, AFTER_DRAIN = false, KSCALE = false;
    bf16_t* O; int ldc; const float* ssq; float inv_k, eps; float* gt; const float* bi; const float* bf; int gate_pn;
    __device__ __forceinline__ void operator()(const f32x4 (&acc)[2][2][4][2], const Unit& u, int wr, int wc, int fr, int fq) const {
        const int row0 = u.pm * BM + wr * 64 + fr; const int col0 = u.pn * BM + wc * 32 + 8 * fq;
        if (GATES && u.pn == gate_pn) {
            if (wc == 0 && fq == 0) { const f32x4 vbi = *(const f32x4*)bi, vbf = *(const f32x4*)bf;
#pragma unroll
                for (int ai = 0; ai < 2; ++ai)
#pragma unroll
                    for (int m = 0; m < 4; ++m) { const int row = row0 + ai * HALF + m * 16; const float r = 1.0f / sqrtf(ssq[row] * inv_k + eps);
                        const f32x4 gi = acc[ai][0][m][0] * r + vbi; const f32x4 z = acc[ai][0][m][1] * r + vbf; f32x4 lf;
#pragma unroll
                        for (int e2 = 0; e2 < 4; ++e2) lf[e2] = fminf(z[e2], 0.f) - log1pf(expf(-fabsf(z[e2])));
                        *(f32x4*)(gt + (size_t)row * 8) = gi; *(f32x4*)(gt + (size_t)row * 8 + 4) = lf; } }
            return; }
#pragma unroll
        for (int ai = 0; ai < 2; ++ai)
#pragma unroll
            for (int m = 0; m < 4; ++m) { const int row = row0 + ai * HALF + m * 16; const float r = 1.0f / sqrtf(ssq[row] * inv_k + eps);
                bf16_t* rowp = O + (size_t)row * ldc + col0;
#pragma unroll
                for (int bj = 0; bj < 2; ++bj) { f32x4 v0 = acc[ai][bj][m][0] * r, v1 = acc[ai][bj][m][1] * r;
                    if (ACT == 2) {
#pragma unroll
                        for (int e2 = 0; e2 < 4; ++e2) { float p = fmaxf(v0[e2], 0.f), q = fmaxf(v1[e2], 0.f); v0[e2] = p * p; v1[e2] = q * q; } }
                    u32x4 w; w.x = cvt_pk_bf16(v0[0], v0[1]); w.y = cvt_pk_bf16(v0[2], v0[3]); w.z = cvt_pk_bf16(v1[0], v1[1]); w.w = cvt_pk_bf16(v1[2], v1[3]);
                    *(u32x4*)(rowp + bj * HALF) = w; } }
    }
};
struct EpiResB {
    static constexpr bool PERM = true, AFTER_DRAIN = false, KSCALE = false;
    bf16_t* X; int ldc; float* ssq;
    __device__ __forceinline__ void operator()(const f32x4 (&acc)[2][2][4][2], const Unit& u, int wr, int wc, int fr, int fq) const {
        const int row0 = u.pm * BM + wr * 64 + fr; const int col0 = u.pn * BM + wc * 32 + 8 * fq;
        u32x4 b[2][4][2];
#pragma unroll
        for (int ai = 0; ai < 2; ++ai)
#pragma unroll
            for (int m = 0; m < 4; ++m)
#pragma unroll
                for (int bj = 0; bj < 2; ++bj) b[ai][m][bj] = *(const u32x4*)(X + (size_t)(row0 + ai * HALF + m * 16) * ldc + col0 + bj * HALF);
#pragma unroll
        for (int ai = 0; ai < 2; ++ai)
#pragma unroll
            for (int m = 0; m < 4; ++m) { const int row = row0 + ai * HALF + m * 16; bf16_t* rowp = X + (size_t)row * ldc + col0; float q = 0.f;
#pragma unroll
                for (int bj = 0; bj < 2; ++bj) { const u32x4 bb = b[ai][m][bj];
                    const f32x4 v0 = acc[ai][bj][m][0] + (f32x4){bf_lo(bb.x), bf_hi(bb.x), bf_lo(bb.y), bf_hi(bb.y)};
                    const f32x4 v1 = acc[ai][bj][m][1] + (f32x4){bf_lo(bb.z), bf_hi(bb.z), bf_lo(bb.w), bf_hi(bb.w)};
                    q += (v0[0] * v0[0] + v0[1] * v0[1]) + (v0[2] * v0[2] + v0[3] * v0[3]) + (v1[0] * v1[0] + v1[1] * v1[1]) + (v1[2] * v1[2] + v1[3] * v1[3]);
                    u32x4 w; w.x = cvt_pk_bf16(v0[0], v0[1]); w.y = cvt_pk_bf16(v0[2], v0[3]); w.z = cvt_pk_bf16(v1[0], v1[1]); w.w = cvt_pk_bf16(v1[2], v1[3]);
                    *(u32x4*)(rowp + bj * HALF) = w; }
                q += __shfl_xor(q, 16); q += __shfl_xor(q, 32);
                if (fq == 0) unsafeAtomicAdd(ssq + row, q); }
    }
};
struct EpiResF {
    static constexpr bool PERM = true, AFTER_DRAIN = false, KSCALE = false;
    const bf16_t* X; float* Y; int ldc;
    __device__ __forceinline__ void operator()(const f32x4 (&acc)[2][2][4][2], const Unit& u, int wr, int wc, int fr, int fq) const {
        const int row0 = u.pm * BM + wr * 64 + fr; const int col0 = u.pn * BM + wc * 32 + 8 * fq;
        u32x4 b[2][4][2];
#pragma unroll
        for (int ai = 0; ai < 2; ++ai)
#pragma unroll
            for (int m = 0; m < 4; ++m)
#pragma unroll
                for (int bj = 0; bj < 2; ++bj) b[ai][m][bj] = *(const u32x4*)(X + (size_t)(row0 + ai * HALF + m * 16) * ldc + col0 + bj * HALF);
#pragma unroll
        for (int ai = 0; ai < 2; ++ai)
#pragma unroll
            for (int m = 0; m < 4; ++m) { const size_t off = (size_t)(row0 + ai * HALF + m * 16) * ldc + col0;
#pragma unroll
                for (int bj = 0; bj < 2; ++bj) { const u32x4 bb = b[ai][m][bj];
                    *(f32x4*)(Y + off + bj * HALF) = acc[ai][bj][m][0] + (f32x4){bf_lo(bb.x), bf_hi(bb.x), bf_lo(bb.y), bf_hi(bb.y)};
                    *(f32x4*)(Y + off + bj * HALF + 4) = acc[ai][bj][m][1] + (f32x4){bf_lo(bb.z), bf_hi(bb.z), bf_lo(bb.w), bf_hi(bb.w)}; } }
    }
};

struct EpiResBK {
    static constexpr bool PERM = true, AFTER_DRAIN = false, KSCALE = true;
    static constexpr int TBL_OFF = 131072 + 256, TBL_BYTES = 256 * 5 * 4;
    bf16_t* X; int ldc; float* ssq; const float* hsq; float eps;
    __device__ __forceinline__ void unit_begin(PG8_LAS unsigned char* lds, const Unit& u, int ui, int tid) const {
        if (tid < 256) { const float* hp = hsq + (size_t)(u.pm * BM + tid) * 8; const f32x4 h4 = *(const f32x4*)hp; const float ha = hp[4];
            const float x0 = h4[0] * (1.0f / 256.0f) + eps, x1 = h4[1] * (1.0f / 256.0f) + eps, x2 = h4[2] * (1.0f / 256.0f) + eps, x3 = h4[3] * (1.0f / 256.0f) + eps, xa = ha * (1.0f / 1024.0f) + eps;
            PG8_LAS float* T = (PG8_LAS float*)(lds + TBL_OFF + (ui & 1) * TBL_BYTES) + tid * 5;
            T[0] = __builtin_sqrtf(x1 * __builtin_amdgcn_rcpf(x0)); T[1] = __builtin_sqrtf(x2 * __builtin_amdgcn_rcpf(x1)); T[2] = __builtin_sqrtf(x3 * __builtin_amdgcn_rcpf(x2));
            T[3] = __builtin_sqrtf(xa * __builtin_amdgcn_rcpf(x3)); T[4] = 1.0f / sqrtf(xa); }
    }
    __device__ __forceinline__ void kscale(f32x4 (&acc)[2][2][4][2], PG8_LAS unsigned char* lds, int ui, int seg, int wr, int fr) const {
        const PG8_LAS float* T = (const PG8_LAS float*)(lds + TBL_OFF + (ui & 1) * TBL_BYTES) + (wr * 64 + fr) * 5 + seg - 1;
#pragma unroll
        for (int ai = 0; ai < 2; ++ai)
#pragma unroll
            for (int m = 0; m < 4; ++m) { const float f = T[(ai * HALF + m * 16) * 5];
#pragma unroll
                for (int bj = 0; bj < 2; ++bj)
#pragma unroll
                    for (int n = 0; n < 2; ++n) acc[ai][bj][m][n] = acc[ai][bj][m][n] * f; }
    }
    __device__ __forceinline__ void epi(const f32x4 (&acc)[2][2][4][2], const Unit& u, PG8_LAS unsigned char* lds, int ui, int wr, int wc, int fr, int fq) const {
        const int row0 = u.pm * BM + wr * 64 + fr; const int col0 = u.pn * BM + wc * 32 + 8 * fq;
        const PG8_LAS float* T = (const PG8_LAS float*)(lds + TBL_OFF + (ui & 1) * TBL_BYTES) + (wr * 64 + fr) * 5 + 4;
        u32x4 b[2][4][2];
#pragma unroll
        for (int ai = 0; ai < 2; ++ai)
#pragma unroll
            for (int m = 0; m < 4; ++m)
#pragma unroll
                for (int bj = 0; bj < 2; ++bj) b[ai][m][bj] = *(const u32x4*)(X + (size_t)(row0 + ai * HALF + m * 16) * ldc + col0 + bj * HALF);
#pragma unroll
        for (int ai = 0; ai < 2; ++ai)
#pragma unroll
            for (int m = 0; m < 4; ++m) { const int row = row0 + ai * HALF + m * 16; bf16_t* rowp = X + (size_t)row * ldc + col0; float q = 0.f; const float ra = T[(ai * HALF + m * 16) * 5];
#pragma unroll
                for (int bj = 0; bj < 2; ++bj) { const u32x4 bb = b[ai][m][bj];
                    const f32x4 v0 = acc[ai][bj][m][0] * ra + (f32x4){bf_lo(bb.x), bf_hi(bb.x), bf_lo(bb.y), bf_hi(bb.y)};
                    const f32x4 v1 = acc[ai][bj][m][1] * ra + (f32x4){bf_lo(bb.z), bf_hi(bb.z), bf_lo(bb.w), bf_hi(bb.w)};
                    q += (v0[0] * v0[0] + v0[1] * v0[1]) + (v0[2] * v0[2] + v0[3] * v0[3]) + (v1[0] * v1[0] + v1[1] * v1[1]) + (v1[2] * v1[2] + v1[3] * v1[3]);
                    u32x4 w; w.x = cvt_pk_bf16(v0[0], v0[1]); w.y = cvt_pk_bf16(v0[2], v0[3]); w.z = cvt_pk_bf16(v1[0], v1[1]); w.w = cvt_pk_bf16(v1[2], v1[3]);
                    *(u32x4*)(rowp + bj * HALF) = w; }
                q += __shfl_xor(q, 16); q += __shfl_xor(q, 32);
                if (fq == 0) unsafeAtomicAdd(ssq + row, q); }
    }
};

template <class Epi, class Sched, bool ALIGN_EPI = false, bool SP2 = false>
__device__ __forceinline__ void gemm_phase(PG8_LAS unsigned char* lds, const Gemm g, const Sched& S, const Epi& E) {
    int tid_ = threadIdx.x; asm volatile("" : "+v"(tid_)); const int tid = tid_, wid = __builtin_amdgcn_readfirstlane(tid >> 6), lane = tid & 63, wr = wid >> 2, wc = wid & 3, fr = lane & 15, fq = lane >> 4;
    const int K = g.ld, nt = g.K / BK;
    unsigned voffA[2], voffB[2];
#pragma unroll
    for (int i = 0; i < 2; ++i) { int R, C; stage_rc(tid * 16 + i * 8192, R, C); const int Rb = Epi::PERM ? ((R & ~31) + perm32(R & 31)) : R;
        voffA[i] = (unsigned)(R * K + C) * 2u; voffB[i] = (unsigned)(Rb * K + C) * 2u; }
    const size_t kstep = (size_t)(BK * 2);
    const size_t hstep = (size_t)HALF * K * 2;
    const size_t tstep = 2 * hstep;
    const unsigned ldsw = (unsigned)wid * 1024u;
    const int aoff = lds_byte(wr * 64 + fr, fq * 8), boff = lds_byte(wc * 32 + fr, fq * 8);
#define PG8_SA(b, h) (((b) * 2 + (h)) * HTB)
#define PG8_SB(b, h) ((4 + (b) * 2 + (h)) * HTB)
#define PG8_STAGE(bufoff, gbase, voff) do { _Pragma("unroll") for (int _i = 0; _i < 2; ++_i) \
        __builtin_amdgcn_global_load_lds((const unsigned*)((const char*)(gbase) + (voff)[_i]), (PG8_LAS unsigned*)(lds + (bufoff) + ldsw + _i * 8192), 16, 0, 0); } while (0)
#define PG8_LDA(dst, b, h) do { _Pragma("unroll") for (int m = 0; m < 4; ++m) _Pragma("unroll") for (int k = 0; k < 2; ++k) dst[m][k] = *(const PG8_LAS bf16x8*)(lds + PG8_SA(b, h) + aoff + m * 2048 + k * 1024); } while (0)
#define PG8_LDB(dst, b, h) do { _Pragma("unroll") for (int n = 0; n < 2; ++n) _Pragma("unroll") for (int k = 0; k < 2; ++k) dst[n][k] = *(const PG8_LAS bf16x8*)(lds + PG8_SB(b, h) + boff + n * 2048 + k * 1024); } while (0)
#define PG8_MMA(ai, bj, At, Bt) do { __builtin_amdgcn_s_setprio(1); _Pragma("unroll") for (int m = 0; m < 4; ++m) _Pragma("unroll") for (int n = 0; n < 2; ++n) _Pragma("unroll") for (int k = 0; k < 2; ++k) \
        acc[ai][bj][m][n] = __builtin_amdgcn_mfma_f32_16x16x32_bf16(Bt[n][k], At[m][k], acc[ai][bj][m][n], 0, 0, 0); __builtin_amdgcn_s_setprio(0); } while (0)
#define PG8_WAIT_V(n) asm volatile("s_waitcnt vmcnt(" #n ")" ::: "memory")
#define PG8_WAIT_L(n) asm volatile("s_waitcnt lgkmcnt(" #n ")" ::: "memory")
#define PG8_BAR __builtin_amdgcn_s_barrier()
#define PG8_SCHED __builtin_amdgcn_sched_barrier(0)
    Unit cur, nxt; int ui = 0;
    if (!S.next(0, cur)) return;
    f32x4 acc[2][2][4][2];
#pragma unroll
    for (int a = 0; a < 2; ++a)
#pragma unroll
        for (int b = 0; b < 2; ++b)
#pragma unroll
            for (int m = 0; m < 4; ++m)
#pragma unroll
                for (int n = 0; n < 2; ++n) acc[a][b][m][n] = (f32x4){0.f, 0.f, 0.f, 0.f};
    bf16x8 At[4][2], B0[2][2], B1[2][2];
    const char* cA = (const char*)g.A + (size_t)cur.pm * tstep + (size_t)cur.ko * 2; const char* cB = (const char*)g.Bt + (size_t)cur.pn * tstep + (size_t)cur.ko * 2;
    S.a_ready(cur);
    if constexpr (Epi::KSCALE) E.unit_begin(lds, cur, ui, tid);
    if constexpr (SP2) {
        PG8_STAGE(PG8_SB(0, 0), cB, voffB); PG8_STAGE(PG8_SB(0, 1), cB + hstep, voffB); PG8_STAGE(PG8_SA(0, 0), cA, voffA); PG8_STAGE(PG8_SA(0, 1), cA + hstep, voffA);
        if (wr == 1) PG8_BAR;
        PG8_WAIT_V(2); PG8_BAR;
        PG8_STAGE(PG8_SB(1, 0), cB + kstep, voffB); PG8_STAGE(PG8_SA(1, 0), cA + kstep, voffA); PG8_STAGE(PG8_SB(1, 1), cB + hstep + kstep, voffB);
        PG8_WAIT_V(6); PG8_BAR;
    } else {
        PG8_STAGE(PG8_SB(0, 0), cB, voffB); PG8_STAGE(PG8_SA(0, 0), cA, voffA); PG8_STAGE(PG8_SB(0, 1), cB + hstep, voffB); PG8_STAGE(PG8_SA(0, 1), cA + hstep, voffA);
        if (wr == 1) PG8_BAR;
        PG8_WAIT_V(4); PG8_BAR;
        PG8_STAGE(PG8_SB(1, 0), cB + kstep, voffB); PG8_STAGE(PG8_SA(1, 0), cA + kstep, voffA); PG8_STAGE(PG8_SB(1, 1), cB + hstep + kstep, voffB);
        PG8_WAIT_V(6); PG8_BAR;
    }
    for (;;) {
        const bool has_next = S.next(ui + 1, nxt);
        const char* nA = has_next ? (const char*)g.A + (size_t)nxt.pm * tstep + (size_t)nxt.ko * 2 : cA; const char* nB = has_next ? (const char*)g.Bt + (size_t)nxt.pn * tstep + (size_t)nxt.ko * 2 : cB;
        for (int t = 0; t < nt; t += 2) {
            const bool last = (t == nt - 2);
            if constexpr (Epi::KSCALE) { if (t == 4 || t == 8 || t == 12 || t == 16) E.kscale(acc, lds, ui, t >> 2, wr, fr); }
            const char* a1 = cA + (size_t)(t + 1) * kstep;
            const char* a2 = last ? nA : cA + (size_t)(t + 2) * kstep; const char* b2 = last ? nB : cB + (size_t)(t + 2) * kstep;
            const char* a3 = a2 + kstep; const char* b3 = b2 + kstep;
            if (last && has_next) S.a_ready(nxt);
            if constexpr (SP2) {
            PG8_LDB(B0, 0, 0); PG8_LDB(B1, 0, 1); PG8_SCHED; PG8_LDA(At, 0, 0); PG8_STAGE(PG8_SA(1, 1), a1 + hstep, voffA);
            PG8_WAIT_V(8); PG8_WAIT_L(0); PG8_BAR; PG8_MMA(0, 0, At, B0); PG8_MMA(0, 1, At, B1); PG8_BAR; PG8_SCHED;
            PG8_LDA(At, 0, 1); PG8_STAGE(PG8_SB(0, 0), b2, voffB); PG8_STAGE(PG8_SB(0, 1), b2 + hstep, voffB); PG8_STAGE(PG8_SA(0, 0), a2, voffA);
            PG8_WAIT_V(8); PG8_WAIT_L(0); PG8_BAR; PG8_MMA(1, 0, At, B0); PG8_MMA(1, 1, At, B1); PG8_BAR; PG8_SCHED;
            PG8_LDB(B0, 1, 0); PG8_LDB(B1, 1, 1); PG8_SCHED; PG8_LDA(At, 1, 0); PG8_STAGE(PG8_SA(0, 1), a2 + hstep, voffA);
            PG8_WAIT_V(8); PG8_WAIT_L(0); PG8_BAR; PG8_MMA(0, 0, At, B0); PG8_MMA(0, 1, At, B1); PG8_BAR; PG8_SCHED;
            PG8_LDA(At, 1, 1); PG8_STAGE(PG8_SB(1, 0), b3, voffB); PG8_STAGE(PG8_SB(1, 1), b3 + hstep, voffB); PG8_STAGE(PG8_SA(1, 0), a3, voffA);
            PG8_WAIT_V(8); PG8_WAIT_L(0); PG8_BAR; PG8_MMA(1, 0, At, B0); PG8_MMA(1, 1, At, B1); PG8_BAR; PG8_SCHED;
            } else {
            PG8_LDB(B0, 0, 0); PG8_SCHED; PG8_LDA(At, 0, 0); PG8_STAGE(PG8_SA(1, 1), a1 + hstep, voffA);
            PG8_WAIT_L(8); PG8_BAR; PG8_WAIT_L(0); PG8_MMA(0, 0, At, B0); PG8_BAR; PG8_SCHED;
            PG8_LDB(B1, 0, 1); PG8_STAGE(PG8_SB(0, 0), b2, voffB);
            PG8_BAR; PG8_WAIT_L(0); PG8_MMA(0, 1, At, B1); PG8_BAR;
            PG8_LDA(At, 0, 1); PG8_STAGE(PG8_SA(0, 0), a2, voffA);
            PG8_BAR; PG8_WAIT_L(0); PG8_MMA(1, 0, At, B0); PG8_BAR; PG8_SCHED;
            PG8_STAGE(PG8_SB(0, 1), b2 + hstep, voffB);
            PG8_WAIT_V(6); PG8_BAR; PG8_MMA(1, 1, At, B1); PG8_BAR;
            PG8_LDB(B0, 1, 0); PG8_SCHED; PG8_LDA(At, 1, 0); PG8_STAGE(PG8_SA(0, 1), a2 + hstep, voffA);
            PG8_WAIT_L(8); PG8_BAR; PG8_WAIT_L(0); PG8_MMA(0, 0, At, B0); PG8_BAR; PG8_SCHED;
            PG8_LDB(B1, 1, 1); PG8_STAGE(PG8_SB(1, 0), b3, voffB);
            PG8_BAR; PG8_WAIT_L(0); PG8_MMA(0, 1, At, B1); PG8_BAR;
            PG8_LDA(At, 1, 1); PG8_STAGE(PG8_SA(1, 0), a3, voffA);
            PG8_BAR; PG8_WAIT_L(0); PG8_MMA(1, 0, At, B0); PG8_BAR; PG8_SCHED;
            PG8_STAGE(PG8_SB(1, 1), b3 + hstep, voffB);
            PG8_WAIT_V(6); PG8_BAR; PG8_MMA(1, 1, At, B1); PG8_BAR;
            }
        }
        if constexpr (ALIGN_EPI) { if (wr == 0) PG8_BAR; }
        if constexpr (Epi::KSCALE) { E.epi(acc, cur, lds, ui, wr, wc, fr, fq); S.done(cur); } else
        if constexpr (!Epi::AFTER_DRAIN) { E(acc, cur, wr, wc, fr, fq); S.done(cur); }
        if (!has_next) break;
#pragma unroll
        for (int a = 0; a < 2; ++a)
#pragma unroll
            for (int b = 0; b < 2; ++b)
#pragma unroll
                for (int m = 0; m < 4; ++m)
#pragma unroll
                    for (int n = 0; n < 2; ++n) acc[a][b][m][n] = (f32x4){0.f, 0.f, 0.f, 0.f};
        cur = nxt; cA = nA; cB = nB; ++ui;
        if constexpr (Epi::KSCALE) E.unit_begin(lds, cur, ui, tid);
        if constexpr (ALIGN_EPI) { if (wr == 1) PG8_BAR; }
    }
    PG8_WAIT_V(0);
    if constexpr (!ALIGN_EPI) { if (wr == 0) PG8_BAR; }
    PG8_BAR;
    if constexpr (Epi::AFTER_DRAIN) { E.fused(acc, cur, wr, wc, fr, fq, lds, wid, lane); S.done(cur); }
#undef PG8_SA
#undef PG8_SB
#undef PG8_STAGE
#undef PG8_LDA
#undef PG8_LDB
#undef PG8_MMA
#undef PG8_WAIT_V
#undef PG8_WAIT_L
#undef PG8_BAR
#undef PG8_SCHED
}
}
#define LAS __attribute__((address_space(3)))
typedef unsigned short bf16_t;
typedef short bf16x8 __attribute__((ext_vector_type(8)));
typedef float f32x4 __attribute__((ext_vector_type(4)));
typedef unsigned u32x4 __attribute__((ext_vector_type(4)));
typedef unsigned u32x2 __attribute__((ext_vector_type(2)));

constexpr int DM = 2048, NB = 16, SEQ = 2048, SB = 16, SL = 32, FF = 8192;
constexpr int MP = NB * SEQ;
constexpr int MS = SB * SL;
constexpr int MT = MP + MS;
constexpr int DIN = 4616, NPJ = 4608, NPW = 4864;
constexpr int DIN_UNUSED = 0;
constexpr int PJ_MQ = 0, PJ_MK = 512, PJ_MV = 1024, PJ_MO = 2048, PJ_AQ = 3072, PJ_AK = 4096, PJ_AV = 4352;
constexpr float EPS = 1e-6f;
constexpr size_t O_YP = 0, O_YS = 67108864, O_PCK = 68157440, O_PCV = 69206016, O_PC = 70254592, O_PN = 74448896, O_PM = 74465280,
                 O_SCK = 74465408, O_SCV = 75513984, O_SC = 76562560, O_SN = 80756864, O_SM = 80773248;
constexpr size_t MiB = 1u << 20;
constexpr size_t WS_WIN = 1 * MiB;
constexpr size_t WS_SSQ = 64 * 1024;
constexpr size_t WS_WOUT = WS_WIN + 38 * MiB;
constexpr size_t WS_WUP = WS_WOUT + 16 * MiB;
constexpr size_t WS_WDN = WS_WUP + 64 * MiB;
constexpr size_t WS_XN = WS_WDN + 64 * MiB;
constexpr size_t WS_GATES = WS_XN + 130 * MiB;
constexpr size_t WS_BIG = WS_GATES + 2 * MiB;
constexpr size_t WS_PROJ = WS_BIG, WS_MIX = WS_BIG + 293 * MiB;
constexpr size_t WS_PART = WS_BIG + 520 * MiB;
constexpr size_t WS_HSQ = WS_PART + 64 * MiB;
constexpr size_t WS_END = WS_HSQ + 3 * MiB;
constexpr int LDS_BYTES = 147456;

__device__ __forceinline__ unsigned f2bf(float f) { unsigned u = __builtin_bit_cast(unsigned, f); return (u + 0x7fffu + ((u >> 16) & 1u)) >> 16; }
__device__ __forceinline__ float bflo(unsigned w) { return __builtin_bit_cast(float, w << 16); }
__device__ __forceinline__ float bfhi(unsigned w) { return __builtin_bit_cast(float, w & 0xffff0000u); }
typedef float f32x2_t __attribute__((ext_vector_type(2)));
typedef __bf16 bf16x2_t __attribute__((ext_vector_type(2)));
__device__ __forceinline__ unsigned pkbf(float lo, float hi) { unsigned r; asm volatile("v_cvt_pk_bf16_f32 %0, %1, %2" : "=v"(r) : "v"(lo), "v"(hi)); return r; }
__device__ __forceinline__ unsigned pkbf_mfma(float lo, float hi) { const f32x2_t v = {lo, hi}; const bf16x2_t b = __builtin_convertvector(v, bf16x2_t); return __builtin_bit_cast(unsigned, b); }
__device__ __forceinline__ void unpack8(const u32x4 w, float (&f)[8]) { f[0] = bflo(w.x); f[1] = bfhi(w.x); f[2] = bflo(w.y); f[3] = bfhi(w.y); f[4] = bflo(w.z); f[5] = bfhi(w.z); f[6] = bflo(w.w); f[7] = bfhi(w.w); }
__device__ __forceinline__ float wave_sum(float v) {
#pragma unroll
    for (int o = 1; o < 64; o <<= 1) v += __shfl_xor(v, o);
    return v;
}
#define LDS_WAIT() asm volatile("s_waitcnt lgkmcnt(0)" ::: "memory")
#define MFMA16(a, b, c) __builtin_amdgcn_mfma_f32_16x16x32_bf16((a), (b), (c), 0, 0, 0)

struct Args { const float* in[21]; float* out; unsigned char* ws; int ph_lo, ph_hi; };
struct Ctx {
    LAS unsigned char* lds;
    int tid, lane, wave, G, bid;
};
#define FIN(i) (a.in[i])
#define FOUT (a.out)
#define FWS (a.ws)

__device__ __forceinline__ void transpose_item(const float* W, int ldw, int c0, int nvalid, int k0, bf16_t* WT, int Kdst, int r0, float scale, const float* gk, LAS float* scr, int lane) {
#pragma unroll 8
    for (int i = 0; i < 32; ++i) { const int kk = 2 * i + (lane >> 5); scr[kk * 33 + (lane & 31)] = ((lane & 31) < nvalid) ? W[(size_t)(k0 + kk) * ldw + c0 + (lane & 31)] : 0.f; }
    LDS_WAIT(); asm volatile("" ::: "memory");
    const int c = lane & 7;
    float sk[8];
#pragma unroll
    for (int e = 0; e < 8; ++e) sk[e] = gk ? scale * gk[k0 + 8 * c + e] : scale;
#pragma unroll
    for (int j = 0; j < 4; ++j) { const int n = (lane >> 3) + 8 * j; const LAS float* s = scr + (8 * c) * 33 + n;
        u32x4 o; o.x = pkbf(s[0 * 33] * sk[0], s[1 * 33] * sk[1]); o.y = pkbf(s[2 * 33] * sk[2], s[3 * 33] * sk[3]); o.z = pkbf(s[4 * 33] * sk[4], s[5 * 33] * sk[5]); o.w = pkbf(s[6 * 33] * sk[6], s[7 * 33] * sk[7]);
        *(u32x4*)(WT + (size_t)(r0 + n) * Kdst + k0 + 8 * c) = o; }
    LDS_WAIT(); asm volatile("" ::: "memory");
}
__device__ __forceinline__ void phase_weights(Ctx& F, const Args& a) {
    LAS float* scr = (LAS float*)(F.lds + F.wave * 16384);
    const int gw = F.bid * 8 + F.wave, NGW = F.G * 8;
    constexpr int I_IN = 32 * 152, I_OUT = 32 * 64, I_UP = 32 * 256, I_DN = 128 * 64, I_L = I_IN + I_OUT + I_UP + I_DN;
    for (int it = gw; it < 2 * I_L; it += NGW) {
        const int l = it / I_L; int r = it % I_L;
        if (r < I_IN) { const int kb = r / 152, nb = r % 152, n0 = nb * 32;
            const int c0 = n0 < 3072 ? n0 : (n0 < 4608 ? n0 + 8 : 3072); const int nvalid = n0 < 4608 ? 32 : (n0 == 4608 ? 8 : 0);
            const float sc = (n0 >= PJ_MK && n0 < PJ_MV) ? 0.08838834764831845f : 1.0f;
            transpose_item(FIN(9) + (size_t)l * DM * DIN, DIN, c0, nvalid, kb * 64, (bf16_t*)(FWS + WS_WIN) + (size_t)l * NPW * DM, DM, n0, sc, FIN(8) + l * DM, scr, F.lane); continue; }
        r -= I_IN;
        if (r < I_OUT) { const int kb = r / 64, nb = r % 64;
            transpose_item(FIN(17) + (size_t)l * DM * DM, DM, nb * 32, 32, kb * 64, (bf16_t*)(FWS + WS_WOUT) + (size_t)l * DM * DM, DM, nb * 32, 1.0f, nullptr, scr, F.lane); continue; }
        r -= I_OUT;
        if (r < I_UP) { const int kb = r / 256, nb = r % 256;
            transpose_item(FIN(19) + (size_t)l * DM * FF, FF, nb * 32, 32, kb * 64, (bf16_t*)(FWS + WS_WUP) + (size_t)l * FF * DM, DM, nb * 32, 1.0f, FIN(18) + l * DM, scr, F.lane); continue; }
        r -= I_UP;
        { const int kb = r / 64, nb = r % 64;
            transpose_item(FIN(20) + (size_t)l * FF * DM, DM, nb * 32, 32, kb * 64, (bf16_t*)(FWS + WS_WDN) + (size_t)l * DM * FF, FF, nb * 32, 1.0f, nullptr, scr, F.lane); }
    }
}

__device__ __forceinline__ void phase_convert(Ctx& F, const Args& a) {
    bf16_t* XB = (bf16_t*)(FWS + WS_XN); float* SSQ = (float*)(FWS + WS_SSQ);
    const float* xlo = FIN(0); const float* xhi = FIN(1) - (size_t)MP * DM;
    const int gw = F.bid * 8 + F.wave, NGW = F.G * 8;
    f32x4 v[8], vn[8];
    if (gw < MT) { const float* xr = (gw < MP ? xlo : xhi) + (size_t)gw * DM + 4 * F.lane;
#pragma unroll
        for (int j = 0; j < 8; ++j) v[j] = *(const f32x4*)(xr + 256 * j); }
    for (int m = gw; m < MT; m += NGW) {
        const int mn = m + NGW;
        if (mn < MT) { const float* xr = (mn < MP ? xlo : xhi) + (size_t)mn * DM + 4 * F.lane;
#pragma unroll
            for (int j = 0; j < 8; ++j) vn[j] = *(const f32x4*)(xr + 256 * j); }
        float ss = 0.f; bf16_t* orow = XB + (size_t)m * DM + 4 * F.lane;
#pragma unroll
        for (int j = 0; j < 8; ++j) { ss += (v[j].x * v[j].x + v[j].y * v[j].y) + (v[j].z * v[j].z + v[j].w * v[j].w);
            u32x2 w; w.x = pkbf(v[j].x, v[j].y); w.y = pkbf(v[j].z, v[j].w); *(u32x2*)(orow + 256 * j) = w; }
        ss = wave_sum(ss);
        if (F.lane == 0) { SSQ[m] = ss; SSQ[MT + m] = 0.f; SSQ[2 * MT + m] = 0.f; SSQ[3 * MT + m] = 0.f; }
        if (F.lane < 16) ((float*)(FWS + WS_HSQ))[(size_t)(F.lane >> 3) * MT * 8 + (size_t)m * 8 + (F.lane & 7)] = 0.f;
#pragma unroll
        for (int j = 0; j < 8; ++j) v[j] = vn[j];
    }
}
__device__ __forceinline__ void phase_fold(Ctx& F, const Args& a, float* ssq, float* yout, const float* hsq) {
    bf16_t* XB = (bf16_t*)(FWS + WS_XN); const float* part = (const float*)(FWS + WS_PART);
    for (int m = MP + F.bid * 8 + F.wave; m < MT; m += F.G * 8) {
        bf16_t* xr = XB + (size_t)m * DM; f32x4 v[8];
#pragma unroll
        for (int j = 0; j < 4; ++j) { const u32x4 b = *(const u32x4*)(xr + (F.lane + 64 * j) * 8); float f[8]; unpack8(b, f);
            v[2 * j] = (f32x4){f[0], f[1], f[2], f[3]}; v[2 * j + 1] = (f32x4){f[4], f[5], f[6], f[7]}; }
        for (int k = 0; k < 16; ++k) { const float* pp = part + ((size_t)k * MS + (m - MP)) * DM;
            float sc = 1.0f;
            if (hsq) { const int sg = k < 8 ? (k >> 1) : 4; sc = 1.0f / sqrtf(hsq[(size_t)m * 8 + sg] * (sg < 4 ? (1.0f / 256.0f) : (1.0f / 1024.0f)) + EPS); }
#pragma unroll
            for (int j = 0; j < 4; ++j) { v[2 * j] += *(const f32x4*)(pp + (F.lane + 64 * j) * 8) * sc; v[2 * j + 1] += *(const f32x4*)(pp + (F.lane + 64 * j) * 8 + 4) * sc; } }
        if (yout) {
#pragma unroll
            for (int j = 0; j < 4; ++j) { *(f32x4*)(yout + (size_t)m * DM + (F.lane + 64 * j) * 8) = v[2 * j]; *(f32x4*)(yout + (size_t)m * DM + (F.lane + 64 * j) * 8 + 4) = v[2 * j + 1]; }
        } else { float ss = 0.f;
#pragma unroll
            for (int j = 0; j < 4; ++j) { const f32x4 p = v[2 * j], q = v[2 * j + 1];
                ss += (p.x * p.x + p.y * p.y) + (p.z * p.z + p.w * p.w) + (q.x * q.x + q.y * q.y) + (q.z * q.z + q.w * q.w);
                u32x4 w; w.x = pkbf(p.x, p.y); w.y = pkbf(p.z, p.w); w.z = pkbf(q.x, q.y); w.w = pkbf(q.z, q.w); *(u32x4*)(xr + (F.lane + 64 * j) * 8) = w; }
            ss = wave_sum(ss); if (F.lane == 0) ssq[m] = ss; }
    }
}

template <bool GATES>
__device__ __forceinline__ void phase_norm(Ctx& F, const Args& a, const float* xlo, const float* xhi  , const float* gvec, int l, float* ycopy, const float* part) {
    bf16_t* XN = (bf16_t*)(FWS + WS_XN);
    float* GT = (float*)(FWS + WS_GATES);
    LAS f32x4* WG = (LAS f32x4*)F.lds;
    if (GATES) {
        const float* win = FIN(9) + (size_t)l * DM * DIN;
        for (int k = F.tid; k < DM; k += 512) { const int j = k >> 8, ln = (k & 255) >> 2, e = k & 3;
            const f32x4 wa = *(const f32x4*)(win + (size_t)k * DIN + 3072), wb = *(const f32x4*)(win + (size_t)k * DIN + 3076);
            WG[((j * 4 + e) * 2 + 0) * 64 + ln] = wa; WG[((j * 4 + e) * 2 + 1) * 64 + ln] = wb; }
        __syncthreads();
    }
    f32x4 gv[8];
#pragma unroll
    for (int j = 0; j < 8; ++j) gv[j] = *(const f32x4*)(gvec + 4 * F.lane + 256 * j);
    float bi[4], bfv[4];
    if (GATES) {
#pragma unroll
        for (int h = 0; h < 4; ++h) { bi[h] = FIN(10)[l * 4 + h]; bfv[h] = FIN(11)[l * 4 + h]; } }
    const int gw = F.bid * 8 + F.wave, NGW = F.G * 8;
    f32x4 v[8], vn[8];
    if (gw < MT) { const float* xr = (gw < MP ? xlo : xhi) + (size_t)gw * DM + 4 * F.lane;
#pragma unroll
        for (int j = 0; j < 8; ++j) v[j] = *(const f32x4*)(xr + 256 * j); }
    for (int m = gw; m < MT; m += NGW) {
        const int mn = m + NGW;
        if (mn < MT) { const float* xr = (mn < MP ? xlo : xhi) + (size_t)mn * DM + 4 * F.lane;
#pragma unroll
            for (int j = 0; j < 8; ++j) vn[j] = *(const f32x4*)(xr + 256 * j); }
        float ss = 0.f;
        if (part && m >= MP) {
            for (int k = 0; k < 16; ++k) { const float* pp = part + ((size_t)k * MS + (m - MP)) * DM + 4 * F.lane;
#pragma unroll
                for (int j = 0; j < 8; ++j) v[j] += *(const f32x4*)(pp + 256 * j); }
#pragma unroll
            for (int j = 0; j < 8; ++j) *(f32x4*)(ycopy + (size_t)m * DM + 4 * F.lane + 256 * j) = v[j];
        }
#pragma unroll
        for (int j = 0; j < 8; ++j) ss += (v[j].x * v[j].x + v[j].y * v[j].y) + (v[j].z * v[j].z + v[j].w * v[j].w);
        const float rstd = 1.0f / sqrtf(wave_sum(ss) * (1.0f / DM) + EPS);
        if (!part && ycopy && m >= MP) {
#pragma unroll
            for (int j = 0; j < 8; ++j) *(f32x4*)(ycopy + (size_t)m * DM + 4 * F.lane + 256 * j) = v[j]; }
        bf16_t* orow = XN + (size_t)m * DM + 4 * F.lane;
        float ga[8];
#pragma unroll
        for (int q = 0; q < 8; ++q) ga[q] = 0.f;
#pragma unroll
        for (int j = 0; j < 8; ++j) { const f32x4 hv = v[j] * rstd * gv[j];
            u32x2 w; w.x = pkbf(hv.x, hv.y); w.y = pkbf(hv.z, hv.w); *(u32x2*)(orow + 256 * j) = w;
            if (GATES) {
#pragma unroll
                for (int e = 0; e < 4; ++e) { const f32x4 wa = WG[((j * 4 + e) * 2 + 0) * 64 + F.lane], wb = WG[((j * 4 + e) * 2 + 1) * 64 + F.lane]; const float hx = hv[e];
                    ga[0] += hx * wa.x; ga[1] += hx * wa.y; ga[2] += hx * wa.z; ga[3] += hx * wa.w; ga[4] += hx * wb.x; ga[5] += hx * wb.y; ga[6] += hx * wb.z; ga[7] += hx * wb.w; } } }
        if (GATES) {
#pragma unroll
            for (int q = 0; q < 8; ++q) ga[q] = wave_sum(ga[q]);
            if (F.lane == 0) { f32x4 o0, o1;
#pragma unroll
                for (int h = 0; h < 4; ++h) { o0[h] = ga[h] + bi[h]; const float z = ga[4 + h] + bfv[h]; o1[h] = fminf(z, 0.f) - log1pf(expf(-fabsf(z))); }
                *(f32x4*)(GT + (size_t)m * 8) = o0; *(f32x4*)(GT + (size_t)m * 8 + 4) = o1; } }
#pragma unroll
        for (int j = 0; j < 8; ++j) v[j] = vn[j];
    }
    if (GATES) __syncthreads();
}

namespace ml {
constexpr int QS = 272, TS = 144;
constexpr int OFF_Q = 0, OFF_K = 17408, OFF_CB = 34816, OFF_KT = 52224  , OFF_VT = 89088  , OFF_W = 107520, OFF_SC = 116736  ,
              OFF_DEN = 118784, OFF_NQ = 119296, OFF_N = 119552;
}
struct MReg { u32x4 q[2], k[2], v; u32x2 mo[2]; float ig, lf; };
__device__ __forceinline__ void ml_load(MReg& R, const bf16_t* PROJ, const float* GT, int row0, int nvalid, int h, int vs, int tid, int lane, int w) {
    const u32x4 z = {0u, 0u, 0u, 0u};
#pragma unroll
    for (int j = 0; j < 2; ++j) { const int r = (tid >> 4) + 32 * j; R.q[j] = (r < nvalid) ? *(const u32x4*)(PROJ + (size_t)(row0 + r) * NPJ + PJ_MQ + h * 128 + (tid & 15) * 8) : z; }
    const bool ok = lane < nvalid; const size_t rb = (size_t)(row0 + lane) * NPJ;
#pragma unroll
    for (int j = 0; j < 2; ++j) R.k[j] = ok ? *(const u32x4*)(PROJ + rb + PJ_MK + h * 128 + (w + 8 * j) * 8) : z;
    R.v = ok ? *(const u32x4*)(PROJ + rb + PJ_MV + h * 256 + vs * 64 + w * 8) : z;
    R.ig = ok ? GT[(size_t)(row0 + lane) * 8 + h] : -1e30f; R.lf = ok ? GT[(size_t)(row0 + lane) * 8 + 4 + h] : 0.f;
    { const int t = (w >> 1) * 16 + (lane & 15);
#pragma unroll
        for (int j = 0; j < 2; ++j) R.mo[j] = (t < nvalid) ? *(const u32x2*)(PROJ + (size_t)(row0 + t) * NPJ + PJ_MO + h * 256 + vs * 64 + ((w & 1) * 2 + j) * 16 + 4 * (lane >> 4)) : (u32x2){0u, 0u}; }
}
__device__ __forceinline__ float ml_stage(const MReg& R, LAS unsigned char* lds, int buf, float& m_prev, int tid, int lane, int w) {
    using namespace ml;
    float b = R.lf;
#pragma unroll
    for (int o = 1; o < 64; o <<= 1) { const float t = __shfl_up(b, o); if (lane >= o) b += t; }
    const float a = R.ig - b; float pm = a;
#pragma unroll
    for (int o = 1; o < 64; o <<= 1) { const float t = __shfl_up(pm, o); if (lane >= o) pm = fmaxf(pm, t); }
    const float M = fmaxf(m_prev, pm), M63 = __shfl(M, 63), b63 = __shfl(b, 63);
    const float wk = __expf(a - M63), decay = __expf(m_prev - M63), gt = __expf(m_prev - M), emt = __expf(-(b + M));
    if (w == 0) { LAS float* sc = (LAS float*)(lds + OFF_SC) + buf * 256; sc[lane] = a; sc[64 + lane] = M; sc[128 + lane] = gt; sc[192 + lane] = emt; }
    m_prev = b63 + M63;
#pragma unroll
    for (int j = 0; j < 2; ++j) *(LAS u32x4*)(lds + OFF_Q + ((tid >> 4) + 32 * j) * QS + (tid & 15) * 16) = R.q[j];
#pragma unroll
    for (int j = 0; j < 2; ++j) { *(LAS u32x4*)(lds + OFF_K + lane * QS + (w + 8 * j) * 16) = R.k[j];
        float f[8]; unpack8(R.k[j], f);
#pragma unroll
        for (int e = 0; e < 8; ++e) *(LAS bf16_t*)(lds + OFF_KT + buf * 18432 + ((w + 8 * j) * 8 + e) * TS + lane * 2) = (bf16_t)f2bf(f[e] * wk); }
    { const unsigned vw[4] = {R.v.x, R.v.y, R.v.z, R.v.w};
#pragma unroll
        for (int e = 0; e < 8; ++e) *(LAS bf16_t*)(lds + OFF_VT + buf * 9216 + (w * 8 + e) * TS + lane * 2) = (bf16_t)((e & 1) ? (vw[e >> 1] >> 16) : (vw[e >> 1] & 0xffffu)); }
    return decay;
}
__device__ __forceinline__ void mlstm_chain(Ctx& F, const Args& a, const float* C0, const float* n0, const float* m0, float* Cout, float* nout, float* mout,
                                            int row0, int nchunks, int nvalid, int h, int vs, float* hsq, const float* gmo) {
    using namespace ml;
    LAS unsigned char* lds = F.lds;
    const bf16_t* PROJ = (const bf16_t*)(FWS + WS_PROJ); const float* GT = (const float*)(FWS + WS_GATES); bf16_t* MIX = (bf16_t*)(FWS + WS_MIX);
    const int tid = F.tid, lane = F.lane, w = F.wave, c16 = lane & 15, g = lane >> 4, tt = w >> 1, half = w & 1;
    __syncthreads();
    f32x4 accC[4];
#pragma unroll
    for (int vt = 0; vt < 4; ++vt) { accC[vt] = C0 ? *(const f32x4*)(C0 + (size_t)(vs * 64 + vt * 16 + c16) * 128 + 16 * w + 4 * g) : (f32x4){0.f, 0.f, 0.f, 0.f};
        u32x2 o; o.x = pkbf(accC[vt][0], accC[vt][1]); o.y = pkbf(accC[vt][2], accC[vt][3]); *(LAS u32x2*)(lds + OFF_CB + (vt * 16 + c16) * QS + (16 * w + 4 * g) * 2) = o; }
    if (tid < 128) ((LAS float*)(lds + OFF_N))[tid] = n0 ? n0[tid] : 0.f;
    float m_prev = m0 ? m0[0] : 0.f;
    f32x4 gmv[2];
#pragma unroll
    for (int j = 0; j < 2; ++j) gmv[j] = *(const f32x4*)(gmo + h * 256 + vs * 64 + ((w & 1) * 2 + j) * 16 + 4 * (lane >> 4));
    MReg RA, RB; ml_load(RA, PROJ, GT, row0, nvalid, h, vs, tid, lane, w);
    if (nchunks > 1) ml_load(RB, PROJ, GT, row0 + 64, nvalid, h, vs, tid, lane, w);
    float decay = ml_stage(RA, lds, 0, m_prev, tid, lane, w);
    u32x2 mocur[2] = {RA.mo[0], RA.mo[1]};
    if (nchunks > 2) ml_load(RA, PROJ, GT, row0 + 128, nvalid, h, vs, tid, lane, w);
    auto step = [&](const int c, MReg& R) __attribute__((always_inline)) {
        const int buf = c & 1; const int rbase = row0 + c * 64;
        __syncthreads();
        const LAS float* sc = (const LAS float*)(lds + OFF_SC) + buf * 256;
        bf16x8 qf[4];
#pragma unroll
        for (int ks = 0; ks < 4; ++ks) qf[ks] = *(const LAS bf16x8*)(lds + OFF_Q + (tt * 16 + c16) * QS + (g * 8 + 32 * ks) * 2);
        const int t = tt * 16 + c16; const float Mt = sc[64 + t];
        float dsum = 0.f;
#pragma unroll
        for (int j = 0; j < 2; ++j) { const int st = half * 2 + j; f32x4 wv = {0.f, 0.f, 0.f, 0.f};
            if (st <= tt) { f32x4 acc = {0.f, 0.f, 0.f, 0.f};
#pragma unroll
                for (int ks = 0; ks < 4; ++ks) { const bf16x8 kf = *(const LAS bf16x8*)(lds + OFF_K + (st * 16 + c16) * QS + (g * 8 + 32 * ks) * 2); acc = MFMA16(kf, qf[ks], acc); }
                const f32x4 as = *(const LAS f32x4*)(sc + st * 16 + 4 * g);
#pragma unroll
                for (int r = 0; r < 4; ++r) { const int s = st * 16 + 4 * g + r; wv[r] = (s <= t) ? __expf(as[r] - Mt) * acc[r] : 0.f; } }
            dsum += (wv[0] + wv[1]) + (wv[2] + wv[3]);
            u32x2 o; o.x = pkbf(wv[0], wv[1]); o.y = pkbf(wv[2], wv[3]); *(LAS u32x2*)(lds + OFF_W + t * TS + (st * 16 + 4 * g) * 2) = o; }
        dsum += __shfl_xor(dsum, 16); dsum += __shfl_xor(dsum, 32);
        if (g == 0) ((LAS float*)(lds + OFF_DEN))[t * 2 + half] = dsum;
        f32x4 acc2[2];
#pragma unroll
        for (int j = 0; j < 2; ++j) { const int vt = half * 2 + j; acc2[j] = (f32x4){0.f, 0.f, 0.f, 0.f};
#pragma unroll
            for (int ks = 0; ks < 4; ++ks) { const bf16x8 cf = *(const LAS bf16x8*)(lds + OFF_CB + (vt * 16 + c16) * QS + (g * 8 + 32 * ks) * 2); acc2[j] = MFMA16(cf, qf[ks], acc2[j]); } }
        { const int tq = tid >> 3, part = tid & 7; float s = 0.f;
#pragma unroll
            for (int i = 0; i < 2; ++i) { const u32x4 qq = *(const LAS u32x4*)(lds + OFF_Q + tq * QS + (part * 16 + i * 8) * 2); float f[8]; unpack8(qq, f);
                const LAS float* nn = (const LAS float*)(lds + OFF_N) + part * 16 + i * 8;
#pragma unroll
                for (int e = 0; e < 8; ++e) s += f[e] * nn[e]; }
            s += __shfl_xor(s, 1); s += __shfl_xor(s, 2); s += __shfl_xor(s, 4);
            if (part == 0) ((LAS float*)(lds + OFF_NQ))[tq] = s; }
        __syncthreads();
        bf16x8 wf[2];
#pragma unroll
        for (int ks = 0; ks < 2; ++ks) wf[ks] = *(const LAS bf16x8*)(lds + OFF_W + (tt * 16 + c16) * TS + (g * 8 + 32 * ks) * 2);
        const float gtt = sc[128 + t], emt = sc[192 + t];
        const float den = ((const LAS float*)(lds + OFF_DEN))[t * 2] + ((const LAS float*)(lds + OFF_DEN))[t * 2 + 1] + gtt * ((const LAS float*)(lds + OFF_NQ))[t];
        const float inv = 1.0f / fmaxf(fabsf(den), emt);
        const LAS unsigned char* vtb = lds + OFF_VT + buf * 9216; const LAS unsigned char* ktb = lds + OFF_KT + buf * 18432;
        float hq2 = 0.f;
#pragma unroll
        for (int j = 0; j < 2; ++j) { const int vt = half * 2 + j; f32x4 a1 = {0.f, 0.f, 0.f, 0.f};
#pragma unroll
            for (int ks = 0; ks < 2; ++ks) { const bf16x8 vf = *(const LAS bf16x8*)(vtb + (vt * 16 + c16) * TS + (g * 8 + 32 * ks) * 2); a1 = MFMA16(vf, wf[ks], a1); }
            const f32x4 hv = (a1 + gtt * acc2[j]) * inv;
            hq2 += (hv[0] * hv[0] + hv[1] * hv[1]) + (hv[2] * hv[2] + hv[3] * hv[3]);
            if (t < nvalid) { const u32x2 mo = mocur[j];
                const f32x4 mf = {bflo(mo.x), bfhi(mo.x), bflo(mo.y), bfhi(mo.y)}; f32x4 ov;
#pragma unroll
                for (int r = 0; r < 4; ++r) ov[r] = hv[r] * gmv[j][r] * (1.0f / (1.0f + __expf(-mf[r])));
                u32x2 o; o.x = pkbf(ov[0], ov[1]); o.y = pkbf(ov[2], ov[3]); *(u32x2*)(MIX + (size_t)(rbase + t) * DM + h * 256 + vs * 64 + vt * 16 + 4 * g) = o; } }
        bf16x8 kf2[2];
#pragma unroll
        for (int ks = 0; ks < 2; ++ks) kf2[ks] = *(const LAS bf16x8*)(ktb + (w * 16 + c16) * TS + (g * 8 + 32 * ks) * 2);
#pragma unroll
        for (int vt = 0; vt < 4; ++vt) { accC[vt] = accC[vt] * decay;
#pragma unroll
            for (int ks = 0; ks < 2; ++ks) { const bf16x8 vf = *(const LAS bf16x8*)(vtb + (vt * 16 + c16) * TS + (g * 8 + 32 * ks) * 2); accC[vt] = MFMA16(kf2[ks], vf, accC[vt]); }
            u32x2 o; o.x = pkbf_mfma(accC[vt][0], accC[vt][1]); o.y = pkbf_mfma(accC[vt][2], accC[vt][3]); *(LAS u32x2*)(lds + OFF_CB + (vt * 16 + c16) * QS + (16 * w + 4 * g) * 2) = o; }
        { float s = 0.f;
#pragma unroll
            for (int i = 0; i < 2; ++i) { const u32x4 kk = *(const LAS u32x4*)(ktb + (w * 16 + c16) * TS + (g * 16 + i * 8) * 2); float f[8]; unpack8(kk, f);
#pragma unroll
                for (int e = 0; e < 8; ++e) s += f[e]; }
            s += __shfl_xor(s, 16); s += __shfl_xor(s, 32);
            if (g == 0) { LAS float* nn = (LAS float*)(lds + OFF_N) + w * 16 + c16; *nn = decay * (*nn) + s; } }
        hq2 += __shfl_xor(hq2, 16); hq2 += __shfl_xor(hq2, 32);
        if (g == 0 && t < nvalid) unsafeAtomicAdd(hsq + (size_t)(rbase + t) * 8 + h, hq2);
        if (c + 1 < nchunks) { decay = ml_stage(R, lds, buf ^ 1, m_prev, tid, lane, w); mocur[0] = R.mo[0]; mocur[1] = R.mo[1];
            if (c + 3 < nchunks) ml_load(R, PROJ, GT, rbase + 192, nvalid, h, vs, tid, lane, w); }
    };
    for (int c = 0; c < nchunks; c += 2) { step(c, RB); if (c + 1 < nchunks) step(c + 1, RA); }
    __syncthreads();
#pragma unroll
    for (int vt = 0; vt < 4; ++vt) *(f32x4*)(Cout + (size_t)(vs * 64 + vt * 16 + c16) * 128 + 16 * w + 4 * g) = accC[vt];
    if (vs == 0 && tid < 128) nout[tid] = ((const LAS float*)(lds + OFF_N))[tid];
    if (vs == 0 && tid == 0) mout[0] = m_prev;
}

namespace at {
constexpr int KS = 144, VS = 400;
constexpr int OFF_KN = 0, OFF_VT = 27648, OFF_BT = 53248;
}
__device__ __forceinline__ int t5_bucket(int rel) {
    const int n = rel < 0 ? -rel : rel; int v;
    if (n < 8) v = n; else if (n <= 11) v = 8; else if (n <= 15) v = 9; else if (n <= 22) v = 10; else if (n <= 31) v = 11; else if (n <= 45) v = 12; else if (n <= 63) v = 13; else if (n <= 90) v = 14; else v = 15;
    return v + (rel > 0 ? 16 : 0);
}
__device__ __forceinline__ void knorm8(float (&f)[8], const float* gk, int ch) {
    float ss = 0.f;
#pragma unroll
    for (int e = 0; e < 8; ++e) ss += f[e] * f[e];
    ss += __shfl_xor(ss, 1); ss += __shfl_xor(ss, 2); ss += __shfl_xor(ss, 4);
    const float rn = 1.0f / sqrtf(ss * (1.0f / 64.0f) + EPS);
#pragma unroll
    for (int e = 0; e < 8; ++e) f[e] = f[e] * rn * gk[ch * 8 + e];
}
__device__ __forceinline__ void attn_unit(Ctx& F, const Args& a, int l, bool prompt, int b, int c, int kvh) {
    using namespace at;
    LAS unsigned char* lds = F.lds;
    const bf16_t* PROJ = (const bf16_t*)(FWS + WS_PROJ); bf16_t* MIX = (bf16_t*)(FWS + WS_MIX);
    const int tid = F.tid, lane = F.lane, w = F.wave, c16 = lane & 15, g = lane >> 4;
    const float* gq = FIN(12) + l * 64; const float* gk = FIN(13) + l * 64;
    float* hsq = (float*)(FWS + WS_HSQ) + (size_t)l * MT * 8; const float* gao = FIN(16) + l * 1024;
    __syncthreads();
    int nkeys, nprev;
    if (prompt) {
        const int nkc = (c < 2 ? c : 2) + 1; nkeys = nkc * 64; nprev = nkeys - 64; const int p0 = (c - (nkc - 1)) * 64;
        for (int kc = 0; kc < nkc; ++kc) {
            const bool own = (kc == nkc - 1) && (c >= 30);
            { const int key = tid >> 3, ch = tid & 7; const size_t row = (size_t)b * SEQ + p0 + kc * 64 + key;
                const u32x4 kk = *(const u32x4*)(PROJ + row * NPJ + PJ_AK + kvh * 64 + ch * 8); float f[8]; unpack8(kk, f); knorm8(f, gk, ch);
                u32x4 o; o.x = pkbf(f[0], f[1]); o.y = pkbf(f[2], f[3]); o.z = pkbf(f[4], f[5]); o.w = pkbf(f[6], f[7]);
                *(LAS u32x4*)(lds + OFF_KN + (kc * 64 + key) * KS + ch * 16) = o;
                if (own) { float* dst = FOUT + O_PCK + ((size_t)(l * 16 + b) * 128 + (c * 64 + key - 1920)) * 256 + kvh * 64 + ch * 8;
                    *(f32x4*)dst = (f32x4){f[0], f[1], f[2], f[3]}; *(f32x4*)(dst + 4) = (f32x4){f[4], f[5], f[6], f[7]}; } }
            { const size_t row = (size_t)b * SEQ + p0 + kc * 64 + lane;
                const u32x4 vv = *(const u32x4*)(PROJ + row * NPJ + PJ_AV + kvh * 64 + w * 8); float f[8]; unpack8(vv, f);
#pragma unroll
                for (int e = 0; e < 8; ++e) *(LAS bf16_t*)(lds + OFF_VT + (w * 8 + e) * VS + (kc * 64 + lane) * 2) = (bf16_t)(__builtin_bit_cast(unsigned, f[e]) >> 16);
                if (own) { float* dst = FOUT + O_PCV + ((size_t)(l * 16 + b) * 128 + (c * 64 + lane - 1920)) * 256 + kvh * 64 + w * 8;
                    *(f32x4*)dst = (f32x4){f[0], f[1], f[2], f[3]}; *(f32x4*)(dst + 4) = (f32x4){f[4], f[5], f[6], f[7]}; } }
        }
    } else {
        nkeys = 160; nprev = 128;
        const float* ck = FIN(2) + (size_t)(l * 16 + b) * 128 * 256; const float* cv = FIN(3) + (size_t)(l * 16 + b) * 128 * 256;
        float* sk = FOUT + O_SCK + (size_t)(l * 16 + b) * 128 * 256; float* sv = FOUT + O_SCV + (size_t)(l * 16 + b) * 128 * 256;
#pragma unroll
        for (int j = 0; j < 2; ++j) {
            { const int key = (tid >> 3) + 64 * j, ch = tid & 7; const float* src = ck + (size_t)key * 256 + kvh * 64 + ch * 8;
                const f32x4 va = *(const f32x4*)src, bb = *(const f32x4*)(src + 4);
                u32x4 o; o.x = pkbf(va.x, va.y); o.y = pkbf(va.z, va.w); o.z = pkbf(bb.x, bb.y); o.w = pkbf(bb.z, bb.w);
                *(LAS u32x4*)(lds + OFF_KN + key * KS + ch * 16) = o;
                if (key >= 32) { float* dst = sk + (size_t)(key - 32) * 256 + kvh * 64 + ch * 8; *(f32x4*)dst = va; *(f32x4*)(dst + 4) = bb; } }
            { const int key = lane + 64 * j; const float* src = cv + (size_t)key * 256 + kvh * 64 + w * 8;
                const f32x4 va = *(const f32x4*)src, bb = *(const f32x4*)(src + 4); const float f[8] = {va.x, va.y, va.z, va.w, bb.x, bb.y, bb.z, bb.w};
#pragma unroll
                for (int e = 0; e < 8; ++e) *(LAS bf16_t*)(lds + OFF_VT + (w * 8 + e) * VS + key * 2) = (bf16_t)f2bf(f[e]);
                if (key >= 32) { float* dst = sv + (size_t)(key - 32) * 256 + kvh * 64 + w * 8; *(f32x4*)dst = va; *(f32x4*)(dst + 4) = bb; } }
        }
        if (tid < 256) { const int key = tid >> 3, ch = tid & 7; const size_t row = (size_t)MP + b * SL + key;
            const u32x4 kk = *(const u32x4*)(PROJ + row * NPJ + PJ_AK + kvh * 64 + ch * 8); float f[8]; unpack8(kk, f); knorm8(f, gk, ch);
            u32x4 o; o.x = pkbf(f[0], f[1]); o.y = pkbf(f[2], f[3]); o.z = pkbf(f[4], f[5]); o.w = pkbf(f[6], f[7]);
            *(LAS u32x4*)(lds + OFF_KN + (128 + key) * KS + ch * 16) = o;
            float* dst = sk + (size_t)(96 + key) * 256 + kvh * 64 + ch * 8; *(f32x4*)dst = (f32x4){f[0], f[1], f[2], f[3]}; *(f32x4*)(dst + 4) = (f32x4){f[4], f[5], f[6], f[7]}; }
        if (lane < 32) { const size_t row = (size_t)MP + b * SL + lane;
            const u32x4 vv = *(const u32x4*)(PROJ + row * NPJ + PJ_AV + kvh * 64 + w * 8); float f[8]; unpack8(vv, f);
#pragma unroll
            for (int e = 0; e < 8; ++e) *(LAS bf16_t*)(lds + OFF_VT + (w * 8 + e) * VS + (128 + lane) * 2) = (bf16_t)(__builtin_bit_cast(unsigned, f[e]) >> 16);
            float* dst = sv + (size_t)(96 + lane) * 256 + kvh * 64 + w * 8; *(f32x4*)dst = (f32x4){f[0], f[1], f[2], f[3]}; *(f32x4*)(dst + 4) = (f32x4){f[4], f[5], f[6], f[7]}; }
    }
    __syncthreads();
    const int hl = w >> 1, hq = kvh * 4 + hl; const float sink = FIN(14)[l * 16 + hq];
    const LAS float* BT = (const LAS float*)(lds + OFF_BT) + hq * 256;
    const int nqt = prompt ? 2 : 1, nkb = nkeys >> 5;
    for (int qt = 0; qt < nqt; ++qt) {
        const int qin = prompt ? (w & 1) * 32 + qt * 16 + c16 : (w & 1) * 16 + c16;
        const size_t row = prompt ? (size_t)b * SEQ + c * 64 + qin : (size_t)MP + b * SL + qin;
        bf16x8 qf[2];
        { float f[2][8]; float ss = 0.f;
#pragma unroll
            for (int ks = 0; ks < 2; ++ks) { const u32x4 qq = *(const u32x4*)(PROJ + row * NPJ + PJ_AQ + hq * 64 + g * 8 + 32 * ks); unpack8(qq, f[ks]);
#pragma unroll
                for (int e = 0; e < 8; ++e) ss += f[ks][e] * f[ks][e]; }
            ss += __shfl_xor(ss, 16); ss += __shfl_xor(ss, 32);
            const float rn = 0.125f / sqrtf(ss * (1.0f / 64.0f) + EPS);
#pragma unroll
            for (int ks = 0; ks < 2; ++ks) { u32x4 o; const float* gg = gq + g * 8 + 32 * ks;
                o.x = pkbf(f[ks][0] * rn * gg[0], f[ks][1] * rn * gg[1]); o.y = pkbf(f[ks][2] * rn * gg[2], f[ks][3] * rn * gg[3]);
                o.z = pkbf(f[ks][4] * rn * gg[4], f[ks][5] * rn * gg[5]); o.w = pkbf(f[ks][6] * rn * gg[6], f[ks][7] * rn * gg[7]);
                qf[ks] = __builtin_bit_cast(bf16x8, o); } }
        float mrun = sink, lsum = (g == 0) ? 1.0f : 0.0f;
        f32x4 O[4];
#pragma unroll
        for (int dt = 0; dt < 4; ++dt) O[dt] = (f32x4){0.f, 0.f, 0.f, 0.f};
        for (int kb = 0; kb < nkb; ++kb) {
            f32x4 s[2];
#pragma unroll
            for (int j = 0; j < 2; ++j) { s[j] = (f32x4){0.f, 0.f, 0.f, 0.f};
#pragma unroll
                for (int ks = 0; ks < 2; ++ks) { const bf16x8 kf = *(const LAS bf16x8*)(lds + OFF_KN + (kb * 32 + 16 * j + c16) * KS + (g * 8 + 32 * ks) * 2); s[j] = MFMA16(kf, qf[ks], s[j]); }
                const int ib = kb * 32 + 16 * j + 4 * g - nprev - qin + 191;
#pragma unroll
                for (int r = 0; r < 4; ++r) s[j][r] += BT[ib + r]; }
            float mx = fmaxf(fmaxf(fmaxf(s[0][0], s[0][1]), fmaxf(s[0][2], s[0][3])), fmaxf(fmaxf(s[1][0], s[1][1]), fmaxf(s[1][2], s[1][3])));
            mx = fmaxf(mx, __shfl_xor(mx, 16)); mx = fmaxf(mx, __shfl_xor(mx, 32));
            const float mnew = fmaxf(mrun, mx), alpha = __expf(mrun - mnew); mrun = mnew;
            float ps = 0.f;
#pragma unroll
            for (int j = 0; j < 2; ++j)
#pragma unroll
                for (int r = 0; r < 4; ++r) { s[j][r] = __expf(s[j][r] - mnew); ps += s[j][r]; }
            lsum = lsum * alpha + ps;
            u32x4 pw; pw.x = pkbf(s[0][0], s[0][1]); pw.y = pkbf(s[0][2], s[0][3]); pw.z = pkbf(s[1][0], s[1][1]); pw.w = pkbf(s[1][2], s[1][3]);
            const bf16x8 pf = __builtin_bit_cast(bf16x8, pw);
#pragma unroll
            for (int dt = 0; dt < 4; ++dt) { const LAS unsigned char* vp = lds + OFF_VT + (dt * 16 + c16) * VS + (kb * 32 + 4 * g) * 2;
                const u32x2 v0 = *(const LAS u32x2*)vp, v1 = *(const LAS u32x2*)(vp + 32);
                u32x4 vw; vw.x = v0.x; vw.y = v0.y; vw.z = v1.x; vw.w = v1.y;
                O[dt] = O[dt] * alpha; O[dt] = MFMA16(__builtin_bit_cast(bf16x8, vw), pf, O[dt]); }
        }
        lsum += __shfl_xor(lsum, 16); lsum += __shfl_xor(lsum, 32);
        const float inv = 1.0f / lsum; float aq2 = 0.f;
#pragma unroll
        for (int dt = 0; dt < 4; ++dt) { const f32x4 ov = O[dt] * inv; const f32x4 gg = *(const f32x4*)(gao + hq * 64 + dt * 16 + 4 * g);
            aq2 += (ov[0] * ov[0] + ov[1] * ov[1]) + (ov[2] * ov[2] + ov[3] * ov[3]);
            u32x2 o; o.x = pkbf(ov[0] * gg[0], ov[1] * gg[1]); o.y = pkbf(ov[2] * gg[2], ov[3] * gg[3]);
            *(u32x2*)(MIX + row * DM + 1024 + hq * 64 + dt * 16 + 4 * g) = o; }
        aq2 += __shfl_xor(aq2, 16); aq2 += __shfl_xor(aq2, 32);
        if (g == 0) unsafeAtomicAdd(hsq + row * 8 + 4, aq2);
    }
}


struct AReg { u32x4 kk[3], vv[3], q[2][2]; };
__device__ __forceinline__ void attn_loadp(AReg& R, const bf16_t* PROJ, int b, int c, int kvh, int tid, int lane, int w) {
    const int nkc = (c < 2 ? c : 2) + 1, p0 = (c - (nkc - 1)) * 64, c16 = lane & 15, g = lane >> 4, hq = kvh * 4 + (w >> 1);
#pragma unroll
    for (int kc = 0; kc < 3; ++kc) if (kc < nkc) {
        R.kk[kc] = *(const u32x4*)(PROJ + ((size_t)b * SEQ + p0 + kc * 64 + (tid >> 3)) * NPJ + PJ_AK + kvh * 64 + (tid & 7) * 8);
        R.vv[kc] = *(const u32x4*)(PROJ + ((size_t)b * SEQ + p0 + kc * 64 + lane) * NPJ + PJ_AV + kvh * 64 + w * 8); }
#pragma unroll
    for (int qt = 0; qt < 2; ++qt) { const size_t row = (size_t)b * SEQ + c * 64 + (w & 1) * 32 + qt * 16 + c16;
#pragma unroll
        for (int ks = 0; ks < 2; ++ks) R.q[qt][ks] = *(const u32x4*)(PROJ + row * NPJ + PJ_AQ + hq * 64 + g * 8 + 32 * ks); }
}
__device__ __forceinline__ void attn_prompt_unit(Ctx& F, const Args& a, int l, int b, int c, int kvh, AReg& R, bool has_next, int nb, int nc, int nkvh) {
    using namespace at;
    LAS unsigned char* lds = F.lds;
    const bf16_t* PROJ = (const bf16_t*)(FWS + WS_PROJ); bf16_t* MIX = (bf16_t*)(FWS + WS_MIX);
    const int tid = F.tid, lane = F.lane, w = F.wave, c16 = lane & 15, g = lane >> 4;
    const float* gq = FIN(12) + l * 64; const float* gk = FIN(13) + l * 64;
    float* hsq = (float*)(FWS + WS_HSQ) + (size_t)l * MT * 8; const float* gao = FIN(16) + l * 1024;
    const int nkc = (c < 2 ? c : 2) + 1, nkeys = nkc * 64, nprev = nkeys - 64;
    __syncthreads();
#pragma unroll
    for (int kc = 0; kc < 3; ++kc) if (kc < nkc) {
        const bool own = (kc == nkc - 1) && (c >= 30);
        { const int key = tid >> 3, ch = tid & 7; float f[8]; unpack8(R.kk[kc], f); knorm8(f, gk, ch);
            u32x4 o; o.x = pkbf(f[0], f[1]); o.y = pkbf(f[2], f[3]); o.z = pkbf(f[4], f[5]); o.w = pkbf(f[6], f[7]);
            *(LAS u32x4*)(lds + OFF_KN + (kc * 64 + key) * KS + ch * 16) = o;
            if (own) { float* dst = FOUT + O_PCK + ((size_t)(l * 16 + b) * 128 + (c * 64 + key - 1920)) * 256 + kvh * 64 + ch * 8;
                *(f32x4*)dst = (f32x4){f[0], f[1], f[2], f[3]}; *(f32x4*)(dst + 4) = (f32x4){f[4], f[5], f[6], f[7]}; } }
        { float f[8]; unpack8(R.vv[kc], f);
#pragma unroll
            for (int e = 0; e < 8; ++e) *(LAS bf16_t*)(lds + OFF_VT + (w * 8 + e) * VS + (kc * 64 + lane) * 2) = (bf16_t)(__builtin_bit_cast(unsigned, f[e]) >> 16);
            if (own) { float* dst = FOUT + O_PCV + ((size_t)(l * 16 + b) * 128 + (c * 64 + lane - 1920)) * 256 + kvh * 64 + w * 8;
                *(f32x4*)dst = (f32x4){f[0], f[1], f[2], f[3]}; *(f32x4*)(dst + 4) = (f32x4){f[4], f[5], f[6], f[7]}; } }
    }
    const int hl = w >> 1, hq = kvh * 4 + hl; const float sink = FIN(14)[l * 16 + hq];
    bf16x8 qf[2][2];
#pragma unroll
    for (int qt = 0; qt < 2; ++qt) { float f[2][8]; float ss = 0.f;
#pragma unroll
        for (int ks = 0; ks < 2; ++ks) { unpack8(R.q[qt][ks], f[ks]);
#pragma unroll
            for (int e = 0; e < 8; ++e) ss += f[ks][e] * f[ks][e]; }
        ss += __shfl_xor(ss, 16); ss += __shfl_xor(ss, 32);
        const float rn = 0.125f / sqrtf(ss * (1.0f / 64.0f) + EPS);
#pragma unroll
        for (int ks = 0; ks < 2; ++ks) { u32x4 o; const float* gg = gq + g * 8 + 32 * ks;
            o.x = pkbf(f[ks][0] * rn * gg[0], f[ks][1] * rn * gg[1]); o.y = pkbf(f[ks][2] * rn * gg[2], f[ks][3] * rn * gg[3]);
            o.z = pkbf(f[ks][4] * rn * gg[4], f[ks][5] * rn * gg[5]); o.w = pkbf(f[ks][6] * rn * gg[6], f[ks][7] * rn * gg[7]);
            qf[qt][ks] = __builtin_bit_cast(bf16x8, o); } }
    __syncthreads();
    if (has_next) attn_loadp(R, PROJ, nb, nc, nkvh, tid, lane, w);
    f32x4 gaov[4];
#pragma unroll
    for (int dt = 0; dt < 4; ++dt) gaov[dt] = *(const f32x4*)(gao + hq * 64 + dt * 16 + 4 * g);
    const LAS float* BT = (const LAS float*)(lds + OFF_BT) + hq * 256;
    const int nkb = nkeys >> 5;
    const int qin0 = (w & 1) * 32 + c16;
    float mrun[2] = {sink, sink}, lsum[2] = {(g == 0) ? 1.0f : 0.0f, (g == 0) ? 1.0f : 0.0f};
    f32x4 O[2][4];
#pragma unroll
    for (int qt = 0; qt < 2; ++qt)
#pragma unroll
        for (int dt = 0; dt < 4; ++dt) O[qt][dt] = (f32x4){0.f, 0.f, 0.f, 0.f};
    for (int kb = 0; kb < nkb; ++kb) {
        bf16x8 kf[2][2];
#pragma unroll
        for (int j = 0; j < 2; ++j)
#pragma unroll
            for (int ks = 0; ks < 2; ++ks) kf[j][ks] = *(const LAS bf16x8*)(lds + OFF_KN + (kb * 32 + 16 * j + c16) * KS + (g * 8 + 32 * ks) * 2);
        f32x4 s[2][2];
#pragma unroll
        for (int qt = 0; qt < 2; ++qt)
#pragma unroll
            for (int j = 0; j < 2; ++j) { s[qt][j] = (f32x4){0.f, 0.f, 0.f, 0.f};
#pragma unroll
                for (int ks = 0; ks < 2; ++ks) s[qt][j] = MFMA16(kf[j][ks], qf[qt][ks], s[qt][j]); }
        bf16x8 pf[2];
#pragma unroll
        for (int qt = 0; qt < 2; ++qt) {
#pragma unroll
            for (int j = 0; j < 2; ++j) { const int ib = kb * 32 + 16 * j + 4 * g - nprev - (qin0 + 16 * qt) + 191;
#pragma unroll
                for (int r = 0; r < 4; ++r) s[qt][j][r] += BT[ib + r]; }
            float mx = fmaxf(fmaxf(fmaxf(s[qt][0][0], s[qt][0][1]), fmaxf(s[qt][0][2], s[qt][0][3])), fmaxf(fmaxf(s[qt][1][0], s[qt][1][1]), fmaxf(s[qt][1][2], s[qt][1][3])));
            mx = fmaxf(mx, __shfl_xor(mx, 16)); mx = fmaxf(mx, __shfl_xor(mx, 32));
            const float mnew = fmaxf(mrun[qt], mx), alpha = __expf(mrun[qt] - mnew); mrun[qt] = mnew;
            float ps = 0.f;
#pragma unroll
            for (int j = 0; j < 2; ++j)
#pragma unroll
                for (int r = 0; r < 4; ++r) { s[qt][j][r] = __expf(s[qt][j][r] - mnew); ps += s[qt][j][r]; }
            lsum[qt] = lsum[qt] * alpha + ps;
            u32x4 pw; pw.x = pkbf(s[qt][0][0], s[qt][0][1]); pw.y = pkbf(s[qt][0][2], s[qt][0][3]); pw.z = pkbf(s[qt][1][0], s[qt][1][1]); pw.w = pkbf(s[qt][1][2], s[qt][1][3]);
            pf[qt] = __builtin_bit_cast(bf16x8, pw);
#pragma unroll
            for (int dt = 0; dt < 4; ++dt) O[qt][dt] = O[qt][dt] * alpha;
        }
#pragma unroll
        for (int dt = 0; dt < 4; ++dt) { const LAS unsigned char* vp = lds + OFF_VT + (dt * 16 + c16) * VS + (kb * 32 + 4 * g) * 2;
            const u32x2 v0 = *(const LAS u32x2*)vp, v1 = *(const LAS u32x2*)(vp + 32);
            u32x4 vw; vw.x = v0.x; vw.y = v0.y; vw.z = v1.x; vw.w = v1.y; const bf16x8 vf = __builtin_bit_cast(bf16x8, vw);
            O[0][dt] = MFMA16(vf, pf[0], O[0][dt]); O[1][dt] = MFMA16(vf, pf[1], O[1][dt]); }
    }
#pragma unroll
    for (int qt = 0; qt < 2; ++qt) {
        const size_t row = (size_t)b * SEQ + c * 64 + qin0 + 16 * qt;
        float ls = lsum[qt]; ls += __shfl_xor(ls, 16); ls += __shfl_xor(ls, 32);
        const float inv = 1.0f / ls; float aq2 = 0.f;
#pragma unroll
        for (int dt = 0; dt < 4; ++dt) { const f32x4 ov = O[qt][dt] * inv; const f32x4 gg = gaov[dt];
            aq2 += (ov[0] * ov[0] + ov[1] * ov[1]) + (ov[2] * ov[2] + ov[3] * ov[3]);
            u32x2 o; o.x = pkbf(ov[0] * gg[0], ov[1] * gg[1]); o.y = pkbf(ov[2] * gg[2], ov[3] * gg[3]);
            *(u32x2*)(MIX + row * DM + 1024 + hq * 64 + dt * 16 + 4 * g) = o; }
        aq2 += __shfl_xor(aq2, 16); aq2 += __shfl_xor(aq2, 32);
        if (g == 0) unsafeAtomicAdd(hsq + row * 8 + 4, aq2);
    }
}

template <int WHICH>
__device__ __forceinline__ void phase_mixers(Ctx& F, const Args& a, int l) {
    float* hsq = (float*)(FWS + WS_HSQ) + (size_t)l * MT * 8; const float* gmo = FIN(15) + l * 1024;
#ifndef DBG_NO_ML
    if (WHICH & 1) for (int u = F.bid; u < 512; u += F.G) {
        const bool smp = u >= 256; const int uu = u & 255, b = uu >> 4, h = (uu >> 2) & 3, vs = uu & 3; const size_t so = (size_t)((l * 16 + b) * 4 + h);
        if (!smp) mlstm_chain(F, a, nullptr, nullptr, nullptr, FOUT + O_PC + so * 32768, FOUT + O_PN + so * 128, FOUT + O_PM + so, b * SEQ, 32, 64, h, vs, hsq, gmo);
        else mlstm_chain(F, a, FIN(4) + so * 32768, FIN(5) + so * 128, FIN(6) + so, FOUT + O_SC + so * 32768, FOUT + O_SN + so * 128, FOUT + O_SM + so, MP + b * SL, 1, 32, h, vs, hsq, gmo);
    }
#endif
#ifndef DBG_NO_ATTN
    if (WHICH & 2) {
        __syncthreads();
        { LAS float* BT = (LAS float*)(F.lds + at::OFF_BT); const float* rb = FIN(7);
            for (int i = F.tid; i < 4096; i += 512) { const int hh = i >> 8, idx = i & 255; BT[i] = (idx < 255) ? rb[t5_bucket(idx - 191) * 16 + hh] : 0.f; } }
        const bf16_t* PROJ = (const bf16_t*)(FWS + WS_PROJ);
        AReg R; int u = F.bid;
        if (u < 2048) attn_loadp(R, PROJ, u >> 7, (u >> 2) & 31, u & 3, F.tid, F.lane, F.wave);
        for (; u < 2048; u += F.G) { const int un = u + F.G;
            attn_prompt_unit(F, a, l, u >> 7, (u >> 2) & 31, u & 3, R, un < 2048, un >> 7, (un >> 2) & 31, un & 3); }
        for (int v = F.bid; v < 64; v += F.G) attn_unit(F, a, l, false, v >> 2, 0, v & 3);
    }
#endif
    __syncthreads();
}

__device__ __forceinline__ void phase_finalize(Ctx& F, const Args& a, int l) {
    const bf16_t* PROJ = (const bf16_t*)(FWS + WS_PROJ); bf16_t* MIX = (bf16_t*)(FWS + WS_MIX);
    const float* gmo = FIN(15) + l * 1024; const float* gao = FIN(16) + l * 1024;
    const int gw = F.bid * 8 + F.wave, NGW = F.G * 8, lane = F.lane;
    u32x4 raw[4], mo[2], rawn[4], mon[2];
    if (gw < MT) {
#pragma unroll
        for (int j = 0; j < 4; ++j) raw[j] = *(const u32x4*)(MIX + (size_t)gw * DM + (lane + 64 * j) * 8);
#pragma unroll
        for (int j = 0; j < 2; ++j) mo[j] = *(const u32x4*)(PROJ + (size_t)gw * NPJ + PJ_MO + (lane + 64 * j) * 8); }
    for (int m = gw; m < MT; m += NGW) {
        bf16_t* mr = MIX + (size_t)m * DM; const int mn = m + NGW;
        if (mn < MT) {
#pragma unroll
            for (int j = 0; j < 4; ++j) rawn[j] = *(const u32x4*)(MIX + (size_t)mn * DM + (lane + 64 * j) * 8);
#pragma unroll
            for (int j = 0; j < 2; ++j) mon[j] = *(const u32x4*)(PROJ + (size_t)mn * NPJ + PJ_MO + (lane + 64 * j) * 8); }
        float f[4][8];
#pragma unroll
        for (int j = 0; j < 4; ++j) unpack8(raw[j], f[j]);
        float sa = 0.f;
#pragma unroll
        for (int j = 0; j < 2; ++j) { float ss = 0.f;
#pragma unroll
            for (int e = 0; e < 8; ++e) ss += f[j][e] * f[j][e];
            ss += __shfl_xor(ss, 1); ss += __shfl_xor(ss, 2); ss += __shfl_xor(ss, 4); ss += __shfl_xor(ss, 8); ss += __shfl_xor(ss, 16);
            const float rn = 1.0f / sqrtf(ss * (1.0f / 256.0f) + EPS);
            float o[8], mf[8]; unpack8(mo[j], mf); const float* gg = gmo + (lane + 64 * j) * 8;
#pragma unroll
            for (int e = 0; e < 8; ++e) o[e] = f[j][e] * rn * gg[e] * (1.0f / (1.0f + __expf(-mf[e])));
            u32x4 ow; ow.x = pkbf(o[0], o[1]); ow.y = pkbf(o[2], o[3]); ow.z = pkbf(o[4], o[5]); ow.w = pkbf(o[6], o[7]);
            *(u32x4*)(mr + (lane + 64 * j) * 8) = ow; }
#pragma unroll
        for (int j = 2; j < 4; ++j)
#pragma unroll
            for (int e = 0; e < 8; ++e) sa += f[j][e] * f[j][e];
        sa = wave_sum(sa);
        const float ra = 1.0f / sqrtf(sa * (1.0f / 1024.0f) + EPS);
#pragma unroll
        for (int j = 2; j < 4; ++j) { float o[8]; const float* gg = gao + (lane + 64 * (j - 2)) * 8;
#pragma unroll
            for (int e = 0; e < 8; ++e) o[e] = f[j][e] * ra * gg[e];
            u32x4 ow; ow.x = pkbf(o[0], o[1]); ow.y = pkbf(o[2], o[3]); ow.z = pkbf(o[4], o[5]); ow.w = pkbf(o[6], o[7]);
            *(u32x4*)(mr + (lane + 64 * j) * 8) = ow; }
#pragma unroll
        for (int j = 0; j < 4; ++j) raw[j] = rawn[j];
#pragma unroll
        for (int j = 0; j < 2; ++j) mo[j] = mon[j];
    }
}

#define XB_TMO      128
#define XB_XCNT(j)  (256  + 64 * (j))
#define XB_XSUB(j)  (1280 + 64 * (j))
#define XB_XGEN(j)  (2304 + 64 * (j))
#define XB_TOP      3328
#define XB_TOPGEN   3392
#define XCD_BAR_WORDS 3456
#define XB_SPIN_CAP (1u << 18)

__device__ __forceinline__ unsigned xb_ld(unsigned* p)              { return __hip_atomic_load(p, __ATOMIC_RELAXED, __HIP_MEMORY_SCOPE_AGENT); }
__device__ __forceinline__ unsigned xb_add(unsigned* p, unsigned v) { return __hip_atomic_fetch_add(p, v, __ATOMIC_RELAXED, __HIP_MEMORY_SCOPE_AGENT); }
__device__ __forceinline__ unsigned xb_xcc_id() { return (unsigned)__builtin_amdgcn_s_getreg((3 << 11) | 20) & 0xFu; }
#define XB_SPIN(cond, bar) do { unsigned _sp = 0; while (cond) { __builtin_amdgcn_s_sleep(1); \
    if ((++_sp & 255u) == 0u) { if (xb_ld(&(bar)[XB_TMO])) break; if (_sp > XB_SPIN_CAP) { atomicAdd(&(bar)[XB_TMO], 1u); break; } } } } while (0)

struct XcdBarrier {
    unsigned* bar; unsigned x;
    volatile LAS unsigned* st;
};

__device__ __forceinline__ XcdBarrier xcd_barrier_post(unsigned* bar, volatile LAS unsigned* st) {
    XcdBarrier b; b.bar = bar; b.x = xb_xcc_id(); b.st = st;
    if (threadIdx.x == 0) (void)xb_add(&bar[XB_XCNT(b.x)], 1u);
    return b;
}
__device__ __forceinline__ void xcd_barrier_complete(unsigned* bar, unsigned x, unsigned& nloc, unsigned& nx) {
    const unsigned G = gridDim.x * gridDim.y * gridDim.z;
    unsigned sum, cnt, mine, sp = 0u;
    for (;;) {
        sum = 0u; cnt = 0u; mine = 0u;
#pragma unroll
        for (unsigned j = 0; j < 16; ++j) { const unsigned c = xb_ld(&bar[XB_XCNT(j)]); sum += c; cnt += (c > 0u) ? 1u : 0u; mine = (j == x) ? c : mine; }
        if (sum == G) break;
        __builtin_amdgcn_s_sleep(1);
        if ((++sp & 255u) == 0u) { if (xb_ld(&bar[XB_TMO])) break; if (sp > XB_SPIN_CAP) { atomicAdd(&bar[XB_TMO], 1u); break; } }
    }
    nloc = mine > 0u ? mine : 1u; nx = cnt > 0u ? cnt : 1u;
}

__device__ __forceinline__ void xcd_barrier(const XcdBarrier& b) {
    asm volatile("s_waitcnt vmcnt(0)" ::: "memory");
    __syncthreads();
    if (threadIdx.x == 0) {
        unsigned* bar = b.bar;
        __builtin_amdgcn_s_waitcnt(0);
        unsigned nloc = b.st[0], nx = b.st[1];
        if (nloc == 0u) { xcd_barrier_complete(bar, b.x, nloc, nx); b.st[0] = nloc; b.st[1] = nx; }
        const unsigned old = xb_add(&bar[XB_XSUB(b.x)], 1u);
        const unsigned gen = old / nloc;
        if (old + 1u == (gen + 1u) * nloc) {
            __builtin_amdgcn_fence(__ATOMIC_RELEASE, "agent");
            asm volatile("s_waitcnt vmcnt(0)" ::: "memory");
            const unsigned og = xb_add(&bar[XB_TOP], 1u);
            const unsigned tg = og / nx;
            if (og + 1u == (tg + 1u) * nx) xb_add(&bar[XB_TOPGEN], 1u);
            else XB_SPIN(xb_ld(&bar[XB_TOPGEN]) == tg, bar);
            __builtin_amdgcn_fence(__ATOMIC_ACQUIRE, "agent");
            xb_add(&bar[XB_XGEN(b.x)], 1u);
            asm volatile("s_waitcnt vmcnt(0)" ::: "memory");
        } else {
            XB_SPIN(xb_ld(&bar[XB_XGEN(b.x)]) == gen, bar);
            __builtin_amdgcn_fence(__ATOMIC_ACQUIRE, "agent");
            asm volatile("s_waitcnt vmcnt(0)" ::: "memory");
        }
    }
    __syncthreads();
}

constexpr int N_PHASES = 16;

__global__ void __launch_bounds__(512, 2) hymba_fwd(Args a) {
    extern __shared__ __attribute__((aligned(16))) unsigned char lds_raw[];
    cg::grid_group grid = cg::this_grid();
    Ctx F;
    F.lds = (LAS unsigned char*)lds_raw;
    F.tid = threadIdx.x; F.lane = F.tid & 63; F.wave = __builtin_amdgcn_readfirstlane(F.tid >> 6); F.G = gridDim.x; F.bid = blockIdx.x;
    float* Y = a.out;
    bf16_t* XN = (bf16_t*)(FWS + WS_XN); bf16_t* PROJ = (bf16_t*)(FWS + WS_PROJ); bf16_t* MIX = (bf16_t*)(FWS + WS_MIX); bf16_t* U = (bf16_t*)(FWS + WS_BIG);
    if (blockIdx.x == 0) for (int i = threadIdx.x; i < XCD_BAR_WORDS; i += 512) ((unsigned*)FWS)[i] = 0u;
    if (threadIdx.x < 4) ((LAS unsigned*)(F.lds + 131072 + 64))[threadIdx.x] = 0u;
    __syncthreads();
    XcdBarrier bar; bar.bar = (unsigned*)FWS; bar.x = 0; bar.st = nullptr; bool census = false;
    for (int ph = a.ph_lo; ph < a.ph_hi; ++ph) {
        if (ph > a.ph_lo && ph != 1) {
            if (!census) { grid.sync();
                bar = xcd_barrier_post((unsigned*)FWS, (volatile LAS unsigned*)(F.lds + 131072 + 64)); census = true; }
            else xcd_barrier(bar);
        }
        { int t_ = threadIdx.x; asm volatile("" : "+v"(t_)); F.tid = t_; F.lane = t_ & 63; F.wave = __builtin_amdgcn_readfirstlane(t_ >> 6); }
        if (ph == 0) {
#ifndef NO_W
#ifdef PROBE_W2
 phase_weights(F, a); __syncthreads(); phase_weights(F, a); __syncthreads();
#endif
 phase_weights(F, a);
#endif
 __syncthreads(); continue; }
        if (ph == 1) { phase_convert(F, a); __syncthreads(); continue; }
        const int l = (ph - 2) / 7, s = (ph - 2) % 7;
        bf16_t* XB = XN; float* SSQ = (float*)(FWS + WS_SSQ); float* HSQ = (float*)(FWS + WS_HSQ) + (size_t)l * MT * 8;
        float* ssq_in = SSQ + (l == 0 ? 0 : 2 * MT);
        float* ssq_mid = SSQ + (l == 0 ? MT : 3 * MT);
        if (s == 0) { pg8::Gemm g{XB, (const bf16_t*)(FWS + WS_WIN) + (size_t)l * NPW * DM, MT, NPW, DM, DM}; pg8::StaticOrder S; S.init(MT, NPW, F.G, F.bid);
            pg8::EpiScale<0, true> E{PROJ, NPJ, ssq_in, 1.0f / DM, EPS, (float*)(FWS + WS_GATES), FIN(10) + l * 4, FIN(11) + l * 4, NPJ / 256};
            pg8::gemm_phase<pg8::EpiScale<0, true>, pg8::StaticOrder, false, true>(F.lds, g, S, E); }
        else if (s == 1) phase_mixers<3>(F, a, l);
        else if (s == 2 || s == 5) {
            pg8::Gemm g;
            if (s == 2) g = pg8::Gemm{MIX, (const bf16_t*)(FWS + WS_WOUT) + (size_t)l * DM * DM, MP, DM, DM, DM};
            else g = pg8::Gemm{U, (const bf16_t*)(FWS + WS_WDN) + (size_t)l * DM * FF, MP, DM, FF, FF};
            pg8::StaticOrder S; S.init(MP, DM, F.G, F.bid);
            if (s == 2) { pg8::EpiResBK E{XB, DM, ssq_mid, HSQ, EPS}; pg8::gemm_phase<pg8::EpiResBK, pg8::StaticOrder, false, true>(F.lds, g, S, E); }
            else if (l == 1) { pg8::EpiResF E{XB, Y, DM}; pg8::gemm_phase<pg8::EpiResF, pg8::StaticOrder, false, true>(F.lds, g, S, E); }
            else { pg8::EpiResB E{XB, DM, SSQ + 2 * MT}; pg8::gemm_phase<pg8::EpiResB, pg8::StaticOrder, false, true>(F.lds, g, S, E); }
            __syncthreads();
            const int kfull = (s == 2) ? DM : FF; pg8::Gemm g2 = g; g2.K = kfull / 16;
            pg8::SplitKOrder S2; S2.init(DM, 16, kfull / 16, MP / 256, F.G, F.bid);
            pg8::EpiPartial E2{(float*)(FWS + WS_PART), DM, kfull / 16, MP, MS};
            pg8::gemm_phase<pg8::EpiPartial, pg8::SplitKOrder, true, true>(F.lds, g2, S2, E2); }
        else if (s == 3) phase_fold(F, a, ssq_mid, nullptr, HSQ);
        else if (s == 4) { pg8::Gemm g{XB, (const bf16_t*)(FWS + WS_WUP) + (size_t)l * FF * DM, MT, FF, DM, DM}; pg8::StaticOrder S; S.init(MT, FF, F.G, F.bid);
            pg8::EpiScale<2, false> E{U, FF, ssq_mid, 1.0f / DM, EPS, nullptr, nullptr, nullptr, -1};
            pg8::gemm_phase<pg8::EpiScale<2, false>, pg8::StaticOrder, false, true>(F.lds, g, S, E); }
        else { if (l == 0) phase_fold(F, a, SSQ + 2 * MT, nullptr, nullptr); else phase_fold(F, a, nullptr, Y, nullptr); }
        __syncthreads();
    }
#ifdef DBG_STOP
    grid.sync();
#ifdef DBG_F32
    { const float* src = (const float*)(FWS + DBG_SRC); const size_t n = (size_t)DBG_F32;
      for (size_t i = (size_t)blockIdx.x * 512 + threadIdx.x; i < n; i += (size_t)gridDim.x * 512) Y[i] = src[i]; }
#else
    { const bf16_t* src = (const bf16_t*)(FWS + DBG_SRC); const size_t n = (size_t)MT * DM;
      for (size_t i = (size_t)blockIdx.x * 512 + threadIdx.x; i < n; i += (size_t)gridDim.x * 512) Y[i] = __builtin_bit_cast(float, (unsigned)src[i] << 16); }
#endif
#endif
}

#ifndef N_LAUNCH_MODE
#define N_LAUNCH_MODE 0
#endif
extern "C" void kernel_launch(void* const* d_in, const int* in_sizes, int n_in, void* d_out, int out_size, void* d_ws, size_t ws_size, hipStream_t stream) {
    static int grid = 0;
    if (grid == 0) {
        if (n_in != 21 || out_size != 80773376 || ws_size < WS_END) { fprintf(stderr, "kernel_launch: unexpected shapes (n_in %d out %d ws %zu need %zu)\n", n_in, out_size, ws_size, (size_t)WS_END); grid = -1; return; }
        int dev = 0, cus = 0, per_cu = 0;
        hipGetDevice(&dev); hipDeviceGetAttribute(&cus, hipDeviceAttributeMultiprocessorCount, dev);
        if (hipFuncSetAttribute((const void*)hymba_fwd, hipFuncAttributeMaxDynamicSharedMemorySize, LDS_BYTES) != hipSuccess) { fprintf(stderr, "kernel_launch: hipFuncSetAttribute failed\n"); grid = -1; return; }
        if (hipOccupancyMaxActiveBlocksPerMultiprocessor(&per_cu, (const void*)hymba_fwd, 512, LDS_BYTES) != hipSuccess || per_cu < 1) { fprintf(stderr, "kernel_launch: occupancy query gave %d\n", per_cu); per_cu = 1; }
        (void)hipGetLastError();
        grid = cus * per_cu;
        fprintf(stderr, "kernel_launch: grid %d (cus %d x %d)\n", grid, cus, per_cu);
    }
    if (grid < 0) return;
#ifdef DBG_MEMSET
    (void)hipMemsetAsync(d_ws, 0, WS_END, stream); (void)hipMemsetAsync(d_out, 0, (size_t)out_size * 4, stream);
#endif
    Args a{};
    for (int i = 0; i < 21; ++i) a.in[i] = (const float*)d_in[i];
    a.out = (float*)d_out; a.ws = (unsigned char*)d_ws;
#if N_LAUNCH_MODE == 0
#ifdef DBG_STOP
    a.ph_lo = 0; a.ph_hi = DBG_STOP;
#else
    a.ph_lo = 0; a.ph_hi = N_PHASES;
#endif
    { void* args[] = {&a}; hipError_t e = hipLaunchCooperativeKernel((const void*)hymba_fwd, dim3(grid), dim3(512), args, LDS_BYTES, stream);
        if (e != hipSuccess) fprintf(stderr, "cooperative launch failed: %s (grid %d)\n", hipGetErrorString(e), grid); }
#else
    for (int p = 0; p < N_PHASES; ++p) { a.ph_lo = p; a.ph_hi = p + 1; void* args[] = {&a};
        hipError_t e = hipLaunchCooperativeKernel((const void*)hymba_fwd, dim3(grid), dim3(512), args, LDS_BYTES, stream);
        if (e != hipSuccess) { fprintf(stderr, "cooperative launch %d failed: %s (grid %d)\n", p, hipGetErrorString(e), grid); break; } }
#endif
}
```

```cpp
#include <hip/hip_runtime.h>
#include <hip/hip_cooperative_groups.h>
#include <cstdio>
#include <cstdint>
namespace cg = cooperative_groups;
namespace pg8 {
#define PG8_LAS __attribute__((address_space(3)))
typedef unsigned short bf16_t;
typedef short bf16x8 __attribute__((ext_vector_type(8)));
typedef float f32x4 __attribute__((ext_vector_type(4)));
typedef unsigned u32x4 __attribute__((ext_vector_type(4)));
constexpr int BM = 256, BK = 64, HALF = 128, HTB = HALF * BK * 2  , STAGE_BYTES = 8 * HTB, NXCD = 8, WGM = 8;

__host__ __device__ __forceinline__ int lds_byte(int r, int c) { const int st = (r >> 4) * 2 + (c >> 5), rr = r & 15, cc = c & 31, ob = rr * 64 + cc * 2; return st * 1024 + (ob ^ (((ob >> 9) & 1) << 5)); }
__host__ __device__ __forceinline__ void stage_rc(int b, int& R, int& C) { const int st = b / 1024, sb = b % 1024, swz = sb ^ (((sb >> 9) & 1) << 5); R = (st >> 1) * 16 + swz / 64; C = (st & 1) * 32 + (swz % 64) / 2; }
__host__ __device__ __forceinline__ int perm32(int rho) { const int n = rho >> 4, i = rho & 15; return 8 * (i >> 2) + 4 * n + (i & 3); }

struct Unit { int pm, pn, ko; };
struct Gemm { const bf16_t* A; const bf16_t* Bt; int M, N, K, ld; };

struct StaticOrder {
    int nM, nN, nwg, G, c;
    __host__ __device__ void init(int M, int N, int G_, int c_) { nM = M / BM; nN = N / BM; nwg = nM * nN; G = G_; c = c_; }
    __host__ __device__ bool next(int i, Unit& u) const {
        const long L = (long)i * G + c; if (L >= nwg) return false;
        int wgid = (int)L; { const int q = nwg / NXCD, r = nwg % NXCD, xcd = wgid % NXCD, off = wgid / NXCD; wgid = (xcd < r ? xcd * (q + 1) : r * (q + 1) + (xcd - r) * q) + off; }
        const int nig = WGM * nN, gid = wgid / nig, fm = gid * WGM, gsz = (nM - fm) < WGM ? (nM - fm) : WGM;
        u.pm = fm + ((wgid % nig) % gsz); u.pn = (wgid % nig) / gsz; u.ko = 0; return true;
    }
    __device__ __forceinline__ void a_ready(const Unit&) const {}
    __device__ __forceinline__ void done(const Unit&) const {}
};

__device__ __forceinline__ unsigned cvt_pk_bf16(float lo, float hi) { unsigned r; asm volatile("v_cvt_pk_bf16_f32 %0, %1, %2" : "=v"(r) : "v"(lo), "v"(hi)); return r; }
typedef unsigned u32x2 __attribute__((ext_vector_type(2)));
template <int ACT> struct EpiBf16 {
    static constexpr bool PERM = true, AFTER_DRAIN = false, KSCALE = false;
    bf16_t* O; int ldc;
    __device__ __forceinline__ void operator()(const f32x4 (&acc)[2][2][4][2], const Unit& u, int wr, int wc, int fr, int fq) const {
        const int row0 = u.pm * BM + wr * 64 + fr; const int col0 = u.pn * BM + wc * 32 + 8 * fq;
#pragma unroll
        for (int ai = 0; ai < 2; ++ai)
#pragma unroll
            for (int m = 0; m < 4; ++m) { bf16_t* rowp = O + (size_t)(row0 + ai * HALF + m * 16) * ldc + col0;
#pragma unroll
                for (int bj = 0; bj < 2; ++bj) { f32x4 v0 = acc[ai][bj][m][0], v1 = acc[ai][bj][m][1];
                    if (ACT == 2) {
#pragma unroll
                        for (int e = 0; e < 4; ++e) { float a = fmaxf(v0[e], 0.f), b = fmaxf(v1[e], 0.f); v0[e] = a * a; v1[e] = b * b; } }
                    u32x4 w; w.x = cvt_pk_bf16(v0[0], v0[1]); w.y = cvt_pk_bf16(v0[2], v0[3]); w.z = cvt_pk_bf16(v1[0], v1[1]); w.w = cvt_pk_bf16(v1[2], v1[3]);
                    *(u32x4*)(rowp + bj * HALF) = w; } }
    }
};
struct EpiRes {
    static constexpr bool PERM = false, AFTER_DRAIN = false, KSCALE = false;
    const float* base_lo; const float* base_hi; float* out; int ldc; int split_pm;
    __device__ __forceinline__ void operator()(const f32x4 (&acc)[2][2][4][2], const Unit& u, int wr, int wc, int fr, int fq) const {
        const float* base = (u.pm < split_pm) ? base_lo : base_hi;
        const int col0 = u.pn * BM + wc * 32 + 4 * fq;
#pragma unroll
        for (int ai = 0; ai < 2; ++ai)
#pragma unroll
            for (int m = 0; m < 4; ++m) { const size_t off = (size_t)(u.pm * BM + ai * HALF + wr * 64 + m * 16 + fr) * ldc + col0;
                f32x4 bs[2][2];
#pragma unroll
                for (int bj = 0; bj < 2; ++bj)
#pragma unroll
                    for (int n = 0; n < 2; ++n) bs[bj][n] = *(const f32x4*)(base + off + bj * HALF + n * 16);
#pragma unroll
                for (int bj = 0; bj < 2; ++bj)
#pragma unroll
                    for (int n = 0; n < 2; ++n) *(f32x4*)(out + off + bj * HALF + n * 16) = bs[bj][n] + acc[ai][bj][m][n];
                asm volatile("" ::: "memory"); }
    }
};

struct SplitKOrder {
    int nN, nsplit, kslice, pm0, G, c;
    __host__ __device__ void init(int N, int nsplit_, int kslice_, int pm0_, int G_, int c_) { nN = N / BM; nsplit = nsplit_; kslice = kslice_; pm0 = pm0_; G = G_; c = c_; }
    __host__ __device__ bool next(int i, Unit& u) const {
        const int L = i * G + c; if (L >= 2 * nN * nsplit) return false;
        const int ks = L % nsplit, t = L / nsplit; u.pn = t % nN; u.pm = pm0 + t / nN; u.ko = ks * kslice; return true; }
    __device__ __forceinline__ void a_ready(const Unit&) const {}
    __device__ __forceinline__ void done(const Unit&) const {}
};
struct EpiPartial {
    static constexpr bool PERM = false, AFTER_DRAIN = false, KSCALE = false;
    float* P; int ldc, kslice, row0, rows;
    __device__ __forceinline__ void operator()(const f32x4 (&acc)[2][2][4][2], const Unit& u, int wr, int wc, int fr, int fq) const {
        const int col0 = u.pn * BM + wc * 32 + 4 * fq; float* base = P + (size_t)(u.ko / kslice) * rows * ldc;
#pragma unroll
        for (int ai = 0; ai < 2; ++ai)
#pragma unroll
            for (int m = 0; m < 4; ++m) { float* p = base + (size_t)(u.pm * BM + ai * HALF + wr * 64 + m * 16 + fr - row0) * ldc + col0;
#pragma unroll
                for (int bj = 0; bj < 2; ++bj)
#pragma unroll
                    for (int n = 0; n < 2; ++n) *(f32x4*)(p + bj * HALF + n * 16) = acc[ai][bj][m][n]; }
    }
};

__device__ __forceinline__ float bf_lo(unsigned w) { return __builtin_bit_cast(float, w << 16); }
__device__ __forceinline__ float bf_hi(unsigned w) { return __builtin_bit_cast(float, w & 0xffff0000u); }
template <int ACT, bool GATES> struct EpiScale {
    static constexpr bool PERM = true, AFTER_DRAIN = false, KSCALE = false;
    bf16_t* O; int ldc; const float* ssq; float inv_k, eps; float* gt; const float* bi; const float* bf; int gate_pn;
    __device__ __forceinline__ void operator()(const f32x4 (&acc)[2][2][4][2], const Unit& u, int wr, int wc, int fr, int fq) const {
        const int row0 = u.pm * BM + wr * 64 + fr; const int col0 = u.pn * BM + wc * 32 + 8 * fq;
        if (GATES && u.pn == gate_pn) {
            if (wc == 0 && fq == 0) { const f32x4 vbi = *(const f32x4*)bi, vbf = *(const f32x4*)bf;
#pragma unroll
                for (int ai = 0; ai < 2; ++ai)
#pragma unroll
                    for (int m = 0; m < 4; ++m) { const int row = row0 + ai * HALF + m * 16; const float r = 1.0f / sqrtf(ssq[row] * inv_k + eps);
                        const f32x4 gi = acc[ai][0][m][0] * r + vbi; const f32x4 z = acc[ai][0][m][1] * r + vbf; f32x4 lf;
#pragma unroll
                        for (int e2 = 0; e2 < 4; ++e2) lf[e2] = fminf(z[e2], 0.f) - log1pf(expf(-fabsf(z[e2])));
                        *(f32x4*)(gt + (size_t)row * 8) = gi; *(f32x4*)(gt + (size_t)row * 8 + 4) = lf; } }
            return; }
        float rr[2][4];
#pragma unroll
        for (int ai = 0; ai < 2; ++ai)
#pragma unroll
            for (int m = 0; m < 4; ++m) rr[ai][m] = ssq[row0 + ai * HALF + m * 16];
        asm volatile("" : "+v"(rr[0][0]), "+v"(rr[0][1]), "+v"(rr[0][2]), "+v"(rr[0][3]), "+v"(rr[1][0]), "+v"(rr[1][1]), "+v"(rr[1][2]), "+v"(rr[1][3]));
#pragma unroll
        for (int ai = 0; ai < 2; ++ai)
#pragma unroll
            for (int m = 0; m < 4; ++m) rr[ai][m] = 1.0f / sqrtf(rr[ai][m] * inv_k + eps);
#pragma unroll
        for (int ai = 0; ai < 2; ++ai)
#pragma unroll
            for (int m = 0; m < 4; ++m) asm volatile("" : "+v"(rr[ai][m]));
#pragma unroll
        for (int ai = 0; ai < 2; ++ai)
#pragma unroll
            for (int m = 0; m < 4; ++m) { const int row = row0 + ai * HALF + m * 16; const float r = rr[ai][m];
                bf16_t* rowp = O + (size_t)row * ldc + col0;
#pragma unroll
                for (int bj = 0; bj < 2; ++bj) { f32x4 v0 = acc[ai][bj][m][0] * r, v1 = acc[ai][bj][m][1] * r;
                    if (ACT == 2) {
#pragma unroll
                        for (int e2 = 0; e2 < 4; ++e2) { float p = fmaxf(v0[e2], 0.f), q = fmaxf(v1[e2], 0.f); v0[e2] = p * p; v1[e2] = q * q; } }
                    u32x4 w; w.x = cvt_pk_bf16(v0[0], v0[1]); w.y = cvt_pk_bf16(v0[2], v0[3]); w.z = cvt_pk_bf16(v1[0], v1[1]); w.w = cvt_pk_bf16(v1[2], v1[3]);
                    *(u32x4*)(rowp + bj * HALF) = w; } }
    }
};
struct EpiResB {
    static constexpr bool PERM = true, AFTER_DRAIN = false, KSCALE = false;
    bf16_t* X; int ldc; float* ssq;
    __device__ __forceinline__ void operator()(const f32x4 (&acc)[2][2][4][2], const Unit& u, int wr, int wc, int fr, int fq) const {
        const int row0 = u.pm * BM + wr * 64 + fr; const int col0 = u.pn * BM + wc * 32 + 8 * fq;
        u32x4 b[2][4][2];
#pragma unroll
        for (int ai = 0; ai < 2; ++ai)
#pragma unroll
            for (int m = 0; m < 4; ++m)
#pragma unroll
                for (int bj = 0; bj < 2; ++bj) b[ai][m][bj] = *(const u32x4*)(X + (size_t)(row0 + ai * HALF + m * 16) * ldc + col0 + bj * HALF);
        __builtin_amdgcn_s_waitcnt(0x0F70); asm volatile("" ::: "memory");
#pragma unroll
        for (int ai = 0; ai < 2; ++ai)
#pragma unroll
            for (int m = 0; m < 4; ++m) { const int row = row0 + ai * HALF + m * 16; bf16_t* rowp = X + (size_t)row * ldc + col0; float q = 0.f;
#pragma unroll
                for (int bj = 0; bj < 2; ++bj) { const u32x4 bb = b[ai][m][bj];
                    const f32x4 v0 = acc[ai][bj][m][0] + (f32x4){bf_lo(bb.x), bf_hi(bb.x), bf_lo(bb.y), bf_hi(bb.y)};
                    const f32x4 v1 = acc[ai][bj][m][1] + (f32x4){bf_lo(bb.z), bf_hi(bb.z), bf_lo(bb.w), bf_hi(bb.w)};
                    q += (v0[0] * v0[0] + v0[1] * v0[1]) + (v0[2] * v0[2] + v0[3] * v0[3]) + (v1[0] * v1[0] + v1[1] * v1[1]) + (v1[2] * v1[2] + v1[3] * v1[3]);
                    u32x4 w; w.x = cvt_pk_bf16(v0[0], v0[1]); w.y = cvt_pk_bf16(v0[2], v0[3]); w.z = cvt_pk_bf16(v1[0], v1[1]); w.w = cvt_pk_bf16(v1[2], v1[3]);
                    *(u32x4*)(rowp + bj * HALF) = w; }
                q += __shfl_xor(q, 16); q += __shfl_xor(q, 32);
                if (fq == 0) unsafeAtomicAdd(ssq + row, q); }
    }
};
struct EpiResF {
    static constexpr bool PERM = true, AFTER_DRAIN = false, KSCALE = false;
    const bf16_t* X; float* Y; int ldc;
    __device__ __forceinline__ void operator()(const f32x4 (&acc)[2][2][4][2], const Unit& u, int wr, int wc, int fr, int fq) const {
        const int row0 = u.pm * BM + wr * 64 + fr; const int col0 = u.pn * BM + wc * 32 + 8 * fq;
        u32x4 b[2][4][2];
#pragma unroll
        for (int ai = 0; ai < 2; ++ai)
#pragma unroll
            for (int m = 0; m < 4; ++m)
#pragma unroll
                for (int bj = 0; bj < 2; ++bj) b[ai][m][bj] = *(const u32x4*)(X + (size_t)(row0 + ai * HALF + m * 16) * ldc + col0 + bj * HALF);
        __builtin_amdgcn_s_waitcnt(0x0F70); asm volatile("" ::: "memory");
#pragma unroll
        for (int ai = 0; ai < 2; ++ai)
#pragma unroll
            for (int m = 0; m < 4; ++m) { const size_t off = (size_t)(row0 + ai * HALF + m * 16) * ldc + col0;
#pragma unroll
                for (int bj = 0; bj < 2; ++bj) { const u32x4 bb = b[ai][m][bj];
                    *(f32x4*)(Y + off + bj * HALF) = acc[ai][bj][m][0] + (f32x4){bf_lo(bb.x), bf_hi(bb.x), bf_lo(bb.y), bf_hi(bb.y)};
                    *(f32x4*)(Y + off + bj * HALF + 4) = acc[ai][bj][m][1] + (f32x4){bf_lo(bb.z), bf_hi(bb.z), bf_lo(bb.w), bf_hi(bb.w)}; } }
    }
};

struct EpiResBK {
    static constexpr bool PERM = true, AFTER_DRAIN = false, KSCALE = true;
    static constexpr int TBL_OFF = 131072 + 256, TBL_BYTES = 256 * 5 * 4;
    bf16_t* X; int ldc; float* ssq; const float* hsq; float eps;
    __device__ __forceinline__ void unit_begin(PG8_LAS unsigned char* lds, const Unit& u, int ui, int tid) const {
        if (tid < 256) { const float* hp = hsq + (size_t)(u.pm * BM + tid) * 8; const f32x4 h4 = *(const f32x4*)hp; const float ha = hp[4];
            const float x0 = h4[0] * (1.0f / 256.0f) + eps, x1 = h4[1] * (1.0f / 256.0f) + eps, x2 = h4[2] * (1.0f / 256.0f) + eps, x3 = h4[3] * (1.0f / 256.0f) + eps, xa = ha * (1.0f / 1024.0f) + eps;
            PG8_LAS float* T = (PG8_LAS float*)(lds + TBL_OFF + (ui & 1) * TBL_BYTES) + tid * 5;
            T[0] = __builtin_sqrtf(x1 * __builtin_amdgcn_rcpf(x0)); T[1] = __builtin_sqrtf(x2 * __builtin_amdgcn_rcpf(x1)); T[2] = __builtin_sqrtf(x3 * __builtin_amdgcn_rcpf(x2));
            T[3] = __builtin_sqrtf(xa * __builtin_amdgcn_rcpf(x3)); T[4] = 1.0f / sqrtf(xa); }
    }
    __device__ __forceinline__ void kscale(f32x4 (&acc)[2][2][4][2], PG8_LAS unsigned char* lds, int ui, int seg, int wr, int fr) const {
        const PG8_LAS float* T = (const PG8_LAS float*)(lds + TBL_OFF + (ui & 1) * TBL_BYTES) + (wr * 64 + fr) * 5 + seg - 1;
#pragma unroll
        for (int ai = 0; ai < 2; ++ai)
#pragma unroll
            for (int m = 0; m < 4; ++m) { const float f = T[(ai * HALF + m * 16) * 5];
#pragma unroll
                for (int bj = 0; bj < 2; ++bj)
#pragma unroll
                    for (int n = 0; n < 2; ++n) acc[ai][bj][m][n] = acc[ai][bj][m][n] * f; }
    }
    __device__ __forceinline__ void epi(const f32x4 (&acc)[2][2][4][2], const Unit& u, PG8_LAS unsigned char* lds, int ui, int wr, int wc, int fr, int fq) const {
        const int row0 = u.pm * BM + wr * 64 + fr; const int col0 = u.pn * BM + wc * 32 + 8 * fq;
        const PG8_LAS float* T = (const PG8_LAS float*)(lds + TBL_OFF + (ui & 1) * TBL_BYTES) + (wr * 64 + fr) * 5 + 4;
        u32x4 b[2][4][2];
#pragma unroll
        for (int ai = 0; ai < 2; ++ai)
#pragma unroll
            for (int m = 0; m < 4; ++m)
#pragma unroll
                for (int bj = 0; bj < 2; ++bj) b[ai][m][bj] = *(const u32x4*)(X + (size_t)(row0 + ai * HALF + m * 16) * ldc + col0 + bj * HALF);
        __builtin_amdgcn_s_waitcnt(0x0F70); asm volatile("" ::: "memory");
#pragma unroll
        for (int ai = 0; ai < 2; ++ai)
#pragma unroll
            for (int m = 0; m < 4; ++m) { const int row = row0 + ai * HALF + m * 16; bf16_t* rowp = X + (size_t)row * ldc + col0; float q = 0.f; const float ra = T[(ai * HALF + m * 16) * 5];
#pragma unroll
                for (int bj = 0; bj < 2; ++bj) { const u32x4 bb = b[ai][m][bj];
                    const f32x4 v0 = acc[ai][bj][m][0] * ra + (f32x4){bf_lo(bb.x), bf_hi(bb.x), bf_lo(bb.y), bf_hi(bb.y)};
                    const f32x4 v1 = acc[ai][bj][m][1] * ra + (f32x4){bf_lo(bb.z), bf_hi(bb.z), bf_lo(bb.w), bf_hi(bb.w)};
                    q += (v0[0] * v0[0] + v0[1] * v0[1]) + (v0[2] * v0[2] + v0[3] * v0[3]) + (v1[0] * v1[0] + v1[1] * v1[1]) + (v1[2] * v1[2] + v1[3] * v1[3]);
                    u32x4 w; w.x = cvt_pk_bf16(v0[0], v0[1]); w.y = cvt_pk_bf16(v0[2], v0[3]); w.z = cvt_pk_bf16(v1[0], v1[1]); w.w = cvt_pk_bf16(v1[2], v1[3]);
                    *(u32x4*)(rowp + bj * HALF) = w; }
                q += __shfl_xor(q, 16); q += __shfl_xor(q, 32);
                if (fq == 0) unsafeAtomicAdd(ssq + row, q); }
    }
};

template <class Epi, class Sched, bool ALIGN_EPI = false, bool SP2 = false>
__device__ __forceinline__ void gemm_phase(PG8_LAS unsigned char* lds, const Gemm g, const Sched& S, const Epi& E) {
    int tid_ = threadIdx.x; asm volatile("" : "+v"(tid_)); const int tid = tid_, wid = __builtin_amdgcn_readfirstlane(tid >> 6), lane = tid & 63, wr = wid >> 2, wc = wid & 3, fr = lane & 15, fq = lane >> 4;
    const int K = g.ld, nt = g.K / BK;
    unsigned voffA[2], voffB[2];
#pragma unroll
    for (int i = 0; i < 2; ++i) { int R, C; stage_rc(tid * 16 + i * 8192, R, C); const int Rb = Epi::PERM ? ((R & ~31) + perm32(R & 31)) : R;
        voffA[i] = (unsigned)(R * K + C) * 2u; voffB[i] = (unsigned)(Rb * K + C) * 2u; }
    const size_t kstep = (size_t)(BK * 2);
    const size_t hstep = (size_t)HALF * K * 2;
    const size_t tstep = 2 * hstep;
    const unsigned ldsw = (unsigned)wid * 1024u;
    const int aoff = lds_byte(wr * 64 + fr, fq * 8), boff = lds_byte(wc * 32 + fr, fq * 8);
#define PG8_SA(b, h) (((b) * 2 + (h)) * HTB)
#define PG8_SB(b, h) ((4 + (b) * 2 + (h)) * HTB)
#define PG8_STAGE(bufoff, gbase, voff) do { _Pragma("unroll") for (int _i = 0; _i < 2; ++_i) \
        __builtin_amdgcn_global_load_lds((const unsigned*)((const char*)(gbase) + (voff)[_i]), (PG8_LAS unsigned*)(lds + (bufoff) + ldsw + _i * 8192), 16, 0, 0); } while (0)
#define PG8_LDA(dst, b, h) do { _Pragma("unroll") for (int m = 0; m < 4; ++m) _Pragma("unroll") for (int k = 0; k < 2; ++k) dst[m][k] = *(const PG8_LAS bf16x8*)(lds + PG8_SA(b, h) + aoff + m * 2048 + k * 1024); } while (0)
#define PG8_LDB(dst, b, h) do { _Pragma("unroll") for (int n = 0; n < 2; ++n) _Pragma("unroll") for (int k = 0; k < 2; ++k) dst[n][k] = *(const PG8_LAS bf16x8*)(lds + PG8_SB(b, h) + boff + n * 2048 + k * 1024); } while (0)
#define PG8_MMA(ai, bj, At, Bt) do { __builtin_amdgcn_s_setprio(1); _Pragma("unroll") for (int m = 0; m < 4; ++m) _Pragma("unroll") for (int n = 0; n < 2; ++n) _Pragma("unroll") for (int k = 0; k < 2; ++k) \
        acc[ai][bj][m][n] = __builtin_amdgcn_mfma_f32_16x16x32_bf16(Bt[n][k], At[m][k], acc[ai][bj][m][n], 0, 0, 0); __builtin_amdgcn_s_setprio(0); } while (0)
#define PG8_WAIT_V(n) asm volatile("s_waitcnt vmcnt(" #n ")" ::: "memory")
#define PG8_WAIT_L(n) asm volatile("s_waitcnt lgkmcnt(" #n ")" ::: "memory")
#define PG8_BAR __builtin_amdgcn_s_barrier()
#define PG8_SCHED __builtin_amdgcn_sched_barrier(0)
    Unit cur, nxt; int ui = 0;
    if (!S.next(0, cur)) return;
    f32x4 acc[2][2][4][2];
#pragma unroll
    for (int a = 0; a < 2; ++a)
#pragma unroll
        for (int b = 0; b < 2; ++b)
#pragma unroll
            for (int m = 0; m < 4; ++m)
#pragma unroll
                for (int n = 0; n < 2; ++n) acc[a][b][m][n] = (f32x4){0.f, 0.f, 0.f, 0.f};
    bf16x8 At[4][2], B0[2][2], B1[2][2];
    const char* cA = (const char*)g.A + (size_t)cur.pm * tstep + (size_t)cur.ko * 2; const char* cB = (const char*)g.Bt + (size_t)cur.pn * tstep + (size_t)cur.ko * 2;
    S.a_ready(cur);
    if constexpr (Epi::KSCALE) E.unit_begin(lds, cur, ui, tid);
    if constexpr (SP2) {
        PG8_STAGE(PG8_SB(0, 0), cB, voffB); PG8_STAGE(PG8_SB(0, 1), cB + hstep, voffB); PG8_STAGE(PG8_SA(0, 0), cA, voffA); PG8_STAGE(PG8_SA(0, 1), cA + hstep, voffA);
        if (wr == 1) PG8_BAR;
        PG8_WAIT_V(2); PG8_BAR;
        PG8_STAGE(PG8_SB(1, 0), cB + kstep, voffB); PG8_STAGE(PG8_SA(1, 0), cA + kstep, voffA); PG8_STAGE(PG8_SB(1, 1), cB + hstep + kstep, voffB);
        PG8_WAIT_V(6); PG8_BAR;
    } else {
        PG8_STAGE(PG8_SB(0, 0), cB, voffB); PG8_STAGE(PG8_SA(0, 0), cA, voffA); PG8_STAGE(PG8_SB(0, 1), cB + hstep, voffB); PG8_STAGE(PG8_SA(0, 1), cA + hstep, voffA);
        if (wr == 1) PG8_BAR;
        PG8_WAIT_V(4); PG8_BAR;
        PG8_STAGE(PG8_SB(1, 0), cB + kstep, voffB); PG8_STAGE(PG8_SA(1, 0), cA + kstep, voffA); PG8_STAGE(PG8_SB(1, 1), cB + hstep + kstep, voffB);
        PG8_WAIT_V(6); PG8_BAR;
    }
    for (;;) {
        const bool has_next = S.next(ui + 1, nxt);
        const char* nA = has_next ? (const char*)g.A + (size_t)nxt.pm * tstep + (size_t)nxt.ko * 2 : cA; const char* nB = has_next ? (const char*)g.Bt + (size_t)nxt.pn * tstep + (size_t)nxt.ko * 2 : cB;
        for (int t = 0; t < nt; t += 2) {
            const bool last = (t == nt - 2);
            if constexpr (Epi::KSCALE) { if (t == 4 || t == 8 || t == 12 || t == 16) E.kscale(acc, lds, ui, t >> 2, wr, fr); }
            const char* a1 = cA + (size_t)(t + 1) * kstep;
            const char* a2 = last ? nA : cA + (size_t)(t + 2) * kstep; const char* b2 = last ? nB : cB + (size_t)(t + 2) * kstep;
            const char* a3 = a2 + kstep; const char* b3 = b2 + kstep;
            if (last && has_next) S.a_ready(nxt);
            if constexpr (SP2) {
            PG8_LDB(B0, 0, 0); PG8_LDB(B1, 0, 1); PG8_SCHED; PG8_LDA(At, 0, 0); PG8_STAGE(PG8_SA(1, 1), a1 + hstep, voffA);
            PG8_WAIT_V(8); PG8_WAIT_L(0); PG8_BAR; PG8_MMA(0, 0, At, B0); PG8_MMA(0, 1, At, B1); PG8_BAR; PG8_SCHED;
            PG8_LDA(At, 0, 1); PG8_STAGE(PG8_SB(0, 0), b2, voffB); PG8_STAGE(PG8_SB(0, 1), b2 + hstep, voffB); PG8_STAGE(PG8_SA(0, 0), a2, voffA);
            PG8_WAIT_V(8); PG8_WAIT_L(0); PG8_BAR; PG8_MMA(1, 0, At, B0); PG8_MMA(1, 1, At, B1); PG8_BAR; PG8_SCHED;
            PG8_LDB(B0, 1, 0); PG8_LDB(B1, 1, 1); PG8_SCHED; PG8_LDA(At, 1, 0); PG8_STAGE(PG8_SA(0, 1), a2 + hstep, voffA);
            PG8_WAIT_V(8); PG8_WAIT_L(0); PG8_BAR; PG8_MMA(0, 0, At, B0); PG8_MMA(0, 1, At, B1); PG8_BAR; PG8_SCHED;
            PG8_LDA(At, 1, 1); PG8_STAGE(PG8_SB(1, 0), b3, voffB); PG8_STAGE(PG8_SB(1, 1), b3 + hstep, voffB); PG8_STAGE(PG8_SA(1, 0), a3, voffA);
            PG8_WAIT_V(8); PG8_WAIT_L(0); PG8_BAR; PG8_MMA(1, 0, At, B0); PG8_MMA(1, 1, At, B1); PG8_BAR; PG8_SCHED;
            } else {
            PG8_LDB(B0, 0, 0); PG8_SCHED; PG8_LDA(At, 0, 0); PG8_STAGE(PG8_SA(1, 1), a1 + hstep, voffA);
            PG8_WAIT_L(8); PG8_BAR; PG8_WAIT_L(0); PG8_MMA(0, 0, At, B0); PG8_BAR; PG8_SCHED;
            PG8_LDB(B1, 0, 1); PG8_STAGE(PG8_SB(0, 0), b2, voffB);
            PG8_BAR; PG8_WAIT_L(0); PG8_MMA(0, 1, At, B1); PG8_BAR;
            PG8_LDA(At, 0, 1); PG8_STAGE(PG8_SA(0, 0), a2, voffA);
            PG8_BAR; PG8_WAIT_L(0); PG8_MMA(1, 0, At, B0); PG8_BAR; PG8_SCHED;
            PG8_STAGE(PG8_SB(0, 1), b2 + hstep, voffB);
            PG8_WAIT_V(6); PG8_BAR; PG8_MMA(1, 1, At, B1); PG8_BAR;
            PG8_LDB(B0, 1, 0); PG8_SCHED; PG8_LDA(At, 1, 0); PG8_STAGE(PG8_SA(0, 1), a2 + hstep, voffA);
            PG8_WAIT_L(8); PG8_BAR; PG8_WAIT_L(0); PG8_MMA(0, 0, At, B0); PG8_BAR; PG8_SCHED;
            PG8_LDB(B1, 1, 1); PG8_STAGE(PG8_SB(1, 0), b3, voffB);
            PG8_BAR; PG8_WAIT_L(0); PG8_MMA(0, 1, At, B1); PG8_BAR;
            PG8_LDA(At, 1, 1); PG8_STAGE(PG8_SA(1, 0), a3, voffA);
            PG8_BAR; PG8_WAIT_L(0); PG8_MMA(1, 0, At, B0); PG8_BAR; PG8_SCHED;
            PG8_STAGE(PG8_SB(1, 1), b3 + hstep, voffB);
            PG8_WAIT_V(6); PG8_BAR; PG8_MMA(1, 1, At, B1); PG8_BAR;
            }
        }
        if constexpr (ALIGN_EPI) { if (wr == 0) PG8_BAR; }
        if constexpr (Epi::KSCALE) { E.epi(acc, cur, lds, ui, wr, wc, fr, fq); S.done(cur); } else
        if constexpr (!Epi::AFTER_DRAIN) { E(acc, cur, wr, wc, fr, fq); S.done(cur); }
        if (!has_next) break;
#pragma unroll
        for (int a = 0; a < 2; ++a)
#pragma unroll
            for (int b = 0; b < 2; ++b)
#pragma unroll
                for (int m = 0; m < 4; ++m)
#pragma unroll
                    for (int n = 0; n < 2; ++n) acc[a][b][m][n] = (f32x4){0.f, 0.f, 0.f, 0.f};
        cur = nxt; cA = nA; cB = nB; ++ui;
        if constexpr (Epi::KSCALE) E.unit_begin(lds, cur, ui, tid);
        if constexpr (ALIGN_EPI) { if (wr == 1) PG8_BAR; }
    }
    PG8_WAIT_V(0);
    if constexpr (!ALIGN_EPI) { if (wr == 0) PG8_BAR; }
    PG8_BAR;
    if constexpr (Epi::AFTER_DRAIN) { E.fused(acc, cur, wr, wc, fr, fq, lds, wid, lane); S.done(cur); }
#undef PG8_SA
#undef PG8_SB
#undef PG8_STAGE
#undef PG8_LDA
#undef PG8_LDB
#undef PG8_MMA
#undef PG8_WAIT_V
#undef PG8_WAIT_L
#undef PG8_BAR
#undef PG8_SCHED
}
}
#define LAS __attribute__((address_space(3)))
typedef unsigned short bf16_t;
typedef short bf16x8 __attribute__((ext_vector_type(8)));
typedef float f32x4 __attribute__((ext_vector_type(4)));
typedef unsigned u32x4 __attribute__((ext_vector_type(4)));
typedef unsigned u32x2 __attribute__((ext_vector_type(2)));

constexpr int DM = 2048, NB = 16, SEQ = 2048, SB = 16, SL = 32, FF = 8192;
constexpr int MP = NB * SEQ;
constexpr int MS = SB * SL;
constexpr int MT = MP + MS;
constexpr int DIN = 4616, NPJ = 4608, NPW = 4864;
constexpr int DIN_UNUSED = 0;
constexpr int PJ_MQ = 0, PJ_MK = 512, PJ_MV = 1024, PJ_MO = 2048, PJ_AQ = 3072, PJ_AK = 4096, PJ_AV = 4352;
constexpr float EPS = 1e-6f;
constexpr size_t O_YP = 0, O_YS = 67108864, O_PCK = 68157440, O_PCV = 69206016, O_PC = 70254592, O_PN = 74448896, O_PM = 74465280,
                 O_SCK = 74465408, O_SCV = 75513984, O_SC = 76562560, O_SN = 80756864, O_SM = 80773248;
constexpr size_t MiB = 1u << 20;
constexpr size_t WS_WIN = 1 * MiB;
constexpr size_t WS_SSQ = 64 * 1024;
constexpr size_t WS_WOUT = WS_WIN + 38 * MiB;
constexpr size_t WS_WUP = WS_WOUT + 16 * MiB;
constexpr size_t WS_WDN = WS_WUP + 64 * MiB;
constexpr size_t WS_XN = WS_WDN + 64 * MiB;
constexpr size_t WS_GATES = WS_XN + 130 * MiB;
constexpr size_t WS_BIG = WS_GATES + 2 * MiB;
constexpr size_t WS_PROJ = WS_BIG, WS_MIX = WS_BIG + 293 * MiB;
constexpr size_t WS_PART = WS_BIG + 520 * MiB;
constexpr size_t WS_HSQ = WS_PART + 64 * MiB;
constexpr size_t WS_END = WS_HSQ + 3 * MiB;
constexpr int LDS_BYTES = 147456;

__device__ __forceinline__ unsigned f2bf(float f) { unsigned u = __builtin_bit_cast(unsigned, f); return (u + 0x7fffu + ((u >> 16) & 1u)) >> 16; }
__device__ __forceinline__ float bflo(unsigned w) { return __builtin_bit_cast(float, w << 16); }
__device__ __forceinline__ float bfhi(unsigned w) { return __builtin_bit_cast(float, w & 0xffff0000u); }
typedef float f32x2_t __attribute__((ext_vector_type(2)));
typedef __bf16 bf16x2_t __attribute__((ext_vector_type(2)));
__device__ __forceinline__ unsigned pkbf(float lo, float hi) { unsigned r; asm volatile("v_cvt_pk_bf16_f32 %0, %1, %2" : "=v"(r) : "v"(lo), "v"(hi)); return r; }
__device__ __forceinline__ unsigned pkbf_mfma(float lo, float hi) { const f32x2_t v = {lo, hi}; const bf16x2_t b = __builtin_convertvector(v, bf16x2_t); return __builtin_bit_cast(unsigned, b); }
__device__ __forceinline__ void unpack8(const u32x4 w, float (&f)[8]) { f[0] = bflo(w.x); f[1] = bfhi(w.x); f[2] = bflo(w.y); f[3] = bfhi(w.y); f[4] = bflo(w.z); f[5] = bfhi(w.z); f[6] = bflo(w.w); f[7] = bfhi(w.w); }
__device__ __forceinline__ float wave_sum(float v) {
#pragma unroll
    for (int o = 1; o < 64; o <<= 1) v += __shfl_xor(v, o);
    return v;
}
#define LDS_WAIT() asm volatile("s_waitcnt lgkmcnt(0)" ::: "memory")
#define MFMA16(a, b, c) __builtin_amdgcn_mfma_f32_16x16x32_bf16((a), (b), (c), 0, 0, 0)

struct Args { const float* in[21]; float* out; unsigned char* ws; int ph_lo, ph_hi; };
struct Ctx {
    LAS unsigned char* lds;
    int tid, lane, wave, G, bid;
};
#define FIN(i) (a.in[i])
#define FOUT (a.out)
#define FWS (a.ws)

__device__ __forceinline__ void transpose_item(const float* W, int ldw, int c0, int nvalid, int k0, bf16_t* WT, int Kdst, int r0, float scale, const float* gk, LAS float* scr, int lane) {
#pragma unroll 8
    for (int i = 0; i < 32; ++i) { const int kk = 2 * i + (lane >> 5); scr[kk * 33 + (lane & 31)] = ((lane & 31) < nvalid) ? W[(size_t)(k0 + kk) * ldw + c0 + (lane & 31)] : 0.f; }
    LDS_WAIT(); asm volatile("" ::: "memory");
    const int c = lane & 7;
    float sk[8];
#pragma unroll
    for (int e = 0; e < 8; ++e) sk[e] = gk ? scale * gk[k0 + 8 * c + e] : scale;
#pragma unroll
    for (int j = 0; j < 4; ++j) { const int n = (lane >> 3) + 8 * j; const LAS float* s = scr + (8 * c) * 33 + n;
        u32x4 o; o.x = pkbf(s[0 * 33] * sk[0], s[1 * 33] * sk[1]); o.y = pkbf(s[2 * 33] * sk[2], s[3 * 33] * sk[3]); o.z = pkbf(s[4 * 33] * sk[4], s[5 * 33] * sk[5]); o.w = pkbf(s[6 * 33] * sk[6], s[7 * 33] * sk[7]);
        *(u32x4*)(WT + (size_t)(r0 + n) * Kdst + k0 + 8 * c) = o; }
    LDS_WAIT(); asm volatile("" ::: "memory");
}
__device__ __forceinline__ void phase_weights(Ctx& F, const Args& a) {
    LAS float* scr = (LAS float*)(F.lds + F.wave * 16384);
    const int gw = F.bid * 8 + F.wave, NGW = F.G * 8;
    constexpr int I_IN = 32 * 152, I_OUT = 32 * 64, I_UP = 32 * 256, I_DN = 128 * 64, I_L = I_IN + I_OUT + I_UP + I_DN;
    for (int it = gw; it < 2 * I_L; it += NGW) {
        const int l = it / I_L; int r = it % I_L;
        if (r < I_IN) { const int kb = r / 152, nb = r % 152, n0 = nb * 32;
            const int c0 = n0 < 3072 ? n0 : (n0 < 4608 ? n0 + 8 : 3072); const int nvalid = n0 < 4608 ? 32 : (n0 == 4608 ? 8 : 0);
            const float sc = (n0 >= PJ_MK && n0 < PJ_MV) ? 0.08838834764831845f : 1.0f;
            transpose_item(FIN(9) + (size_t)l * DM * DIN, DIN, c0, nvalid, kb * 64, (bf16_t*)(FWS + WS_WIN) + (size_t)l * NPW * DM, DM, n0, sc, FIN(8) + l * DM, scr, F.lane); continue; }
        r -= I_IN;
        if (r < I_OUT) { const int kb = r / 64, nb = r % 64;
            transpose_item(FIN(17) + (size_t)l * DM * DM, DM, nb * 32, 32, kb * 64, (bf16_t*)(FWS + WS_WOUT) + (size_t)l * DM * DM, DM, nb * 32, 1.0f, nullptr, scr, F.lane); continue; }
        r -= I_OUT;
        if (r < I_UP) { const int kb = r / 256, nb = r % 256;
            transpose_item(FIN(19) + (size_t)l * DM * FF, FF, nb * 32, 32, kb * 64, (bf16_t*)(FWS + WS_WUP) + (size_t)l * FF * DM, DM, nb * 32, 1.0f, FIN(18) + l * DM, scr, F.lane); continue; }
        r -= I_UP;
        { const int kb = r / 64, nb = r % 64;
            transpose_item(FIN(20) + (size_t)l * FF * DM, DM, nb * 32, 32, kb * 64, (bf16_t*)(FWS + WS_WDN) + (size_t)l * DM * FF, FF, nb * 32, 1.0f, nullptr, scr, F.lane); }
    }
}

__device__ __forceinline__ void phase_convert(Ctx& F, const Args& a) {
    bf16_t* XB = (bf16_t*)(FWS + WS_XN); float* SSQ = (float*)(FWS + WS_SSQ);
    const float* xlo = FIN(0); const float* xhi = FIN(1) - (size_t)MP * DM;
    const int gw = F.bid * 8 + F.wave, NGW = F.G * 8;
    f32x4 v[8], vn[8];
    if (gw < MT) { const float* xr = (gw < MP ? xlo : xhi) + (size_t)gw * DM + 4 * F.lane;
#pragma unroll
        for (int j = 0; j < 8; ++j) v[j] = *(const f32x4*)(xr + 256 * j); }
    for (int m = gw; m < MT; m += NGW) {
        const int mn = m + NGW;
        if (mn < MT) { const float* xr = (mn < MP ? xlo : xhi) + (size_t)mn * DM + 4 * F.lane;
#pragma unroll
            for (int j = 0; j < 8; ++j) vn[j] = *(const f32x4*)(xr + 256 * j); }
        float ss = 0.f; bf16_t* orow = XB + (size_t)m * DM + 4 * F.lane;
#pragma unroll
        for (int j = 0; j < 8; ++j) { ss += (v[j].x * v[j].x + v[j].y * v[j].y) + (v[j].z * v[j].z + v[j].w * v[j].w);
            u32x2 w; w.x = pkbf(v[j].x, v[j].y); w.y = pkbf(v[j].z, v[j].w); *(u32x2*)(orow + 256 * j) = w; }
        ss = wave_sum(ss);
        if (F.lane == 0) { SSQ[m] = ss; SSQ[MT + m] = 0.f; SSQ[2 * MT + m] = 0.f; SSQ[3 * MT + m] = 0.f; }
        if (F.lane < 16) ((float*)(FWS + WS_HSQ))[(size_t)(F.lane >> 3) * MT * 8 + (size_t)m * 8 + (F.lane & 7)] = 0.f;
#pragma unroll
        for (int j = 0; j < 8; ++j) v[j] = vn[j];
    }
}
__device__ __forceinline__ void phase_fold(Ctx& F, const Args& a, float* ssq, float* yout, const float* hsq) {
    bf16_t* XB = (bf16_t*)(FWS + WS_XN); const float* part = (const float*)(FWS + WS_PART);
    for (int m = MP + F.bid * 8 + F.wave; m < MT; m += F.G * 8) {
        bf16_t* xr = XB + (size_t)m * DM; f32x4 v[8];
#pragma unroll
        for (int j = 0; j < 4; ++j) { const u32x4 b = *(const u32x4*)(xr + (F.lane + 64 * j) * 8); float f[8]; unpack8(b, f);
            v[2 * j] = (f32x4){f[0], f[1], f[2], f[3]}; v[2 * j + 1] = (f32x4){f[4], f[5], f[6], f[7]}; }
        for (int k = 0; k < 16; ++k) { const float* pp = part + ((size_t)k * MS + (m - MP)) * DM;
            float sc = 1.0f;
            if (hsq) { const int sg = k < 8 ? (k >> 1) : 4; sc = 1.0f / sqrtf(hsq[(size_t)m * 8 + sg] * (sg < 4 ? (1.0f / 256.0f) : (1.0f / 1024.0f)) + EPS); }
#pragma unroll
            for (int j = 0; j < 4; ++j) { v[2 * j] += *(const f32x4*)(pp + (F.lane + 64 * j) * 8) * sc; v[2 * j + 1] += *(const f32x4*)(pp + (F.lane + 64 * j) * 8 + 4) * sc; } }
        if (yout) {
#pragma unroll
            for (int j = 0; j < 4; ++j) { *(f32x4*)(yout + (size_t)m * DM + (F.lane + 64 * j) * 8) = v[2 * j]; *(f32x4*)(yout + (size_t)m * DM + (F.lane + 64 * j) * 8 + 4) = v[2 * j + 1]; }
        } else { float ss = 0.f;
#pragma unroll
            for (int j = 0; j < 4; ++j) { const f32x4 p = v[2 * j], q = v[2 * j + 1];
                ss += (p.x * p.x + p.y * p.y) + (p.z * p.z + p.w * p.w) + (q.x * q.x + q.y * q.y) + (q.z * q.z + q.w * q.w);
                u32x4 w; w.x = pkbf(p.x, p.y); w.y = pkbf(p.z, p.w); w.z = pkbf(q.x, q.y); w.w = pkbf(q.z, q.w); *(u32x4*)(xr + (F.lane + 64 * j) * 8) = w; }
            ss = wave_sum(ss); if (F.lane == 0) ssq[m] = ss; }
    }
}

template <bool GATES>
__device__ __forceinline__ void phase_norm(Ctx& F, const Args& a, const float* xlo, const float* xhi  , const float* gvec, int l, float* ycopy, const float* part) {
    bf16_t* XN = (bf16_t*)(FWS + WS_XN);
    float* GT = (float*)(FWS + WS_GATES);
    LAS f32x4* WG = (LAS f32x4*)F.lds;
    if (GATES) {
        const float* win = FIN(9) + (size_t)l * DM * DIN;
        for (int k = F.tid; k < DM; k += 512) { const int j = k >> 8, ln = (k & 255) >> 2, e = k & 3;
            const f32x4 wa = *(const f32x4*)(win + (size_t)k * DIN + 3072), wb = *(const f32x4*)(win + (size_t)k * DIN + 3076);
            WG[((j * 4 + e) * 2 + 0) * 64 + ln] = wa; WG[((j * 4 + e) * 2 + 1) * 64 + ln] = wb; }
        __syncthreads();
    }
    f32x4 gv[8];
#pragma unroll
    for (int j = 0; j < 8; ++j) gv[j] = *(const f32x4*)(gvec + 4 * F.lane + 256 * j);
    float bi[4], bfv[4];
    if (GATES) {
#pragma unroll
        for (int h = 0; h < 4; ++h) { bi[h] = FIN(10)[l * 4 + h]; bfv[h] = FIN(11)[l * 4 + h]; } }
    const int gw = F.bid * 8 + F.wave, NGW = F.G * 8;
    f32x4 v[8], vn[8];
    if (gw < MT) { const float* xr = (gw < MP ? xlo : xhi) + (size_t)gw * DM + 4 * F.lane;
#pragma unroll
        for (int j = 0; j < 8; ++j) v[j] = *(const f32x4*)(xr + 256 * j); }
    for (int m = gw; m < MT; m += NGW) {
        const int mn = m + NGW;
        if (mn < MT) { const float* xr = (mn < MP ? xlo : xhi) + (size_t)mn * DM + 4 * F.lane;
#pragma unroll
            for (int j = 0; j < 8; ++j) vn[j] = *(const f32x4*)(xr + 256 * j); }
        float ss = 0.f;
        if (part && m >= MP) {
            for (int k = 0; k < 16; ++k) { const float* pp = part + ((size_t)k * MS + (m - MP)) * DM + 4 * F.lane;
#pragma unroll
                for (int j = 0; j < 8; ++j) v[j] += *(const f32x4*)(pp + 256 * j); }
#pragma unroll
            for (int j = 0; j < 8; ++j) *(f32x4*)(ycopy + (size_t)m * DM + 4 * F.lane + 256 * j) = v[j];
        }
#pragma unroll
        for (int j = 0; j < 8; ++j) ss += (v[j].x * v[j].x + v[j].y * v[j].y) + (v[j].z * v[j].z + v[j].w * v[j].w);
        const float rstd = 1.0f / sqrtf(wave_sum(ss) * (1.0f / DM) + EPS);
        if (!part && ycopy && m >= MP) {
#pragma unroll
            for (int j = 0; j < 8; ++j) *(f32x4*)(ycopy + (size_t)m * DM + 4 * F.lane + 256 * j) = v[j]; }
        bf16_t* orow = XN + (size_t)m * DM + 4 * F.lane;
        float ga[8];
#pragma unroll
        for (int q = 0; q < 8; ++q) ga[q] = 0.f;
#pragma unroll
        for (int j = 0; j < 8; ++j) { const f32x4 hv = v[j] * rstd * gv[j];
            u32x2 w; w.x = pkbf(hv.x, hv.y); w.y = pkbf(hv.z, hv.w); *(u32x2*)(orow + 256 * j) = w;
            if (GATES) {
#pragma unroll
                for (int e = 0; e < 4; ++e) { const f32x4 wa = WG[((j * 4 + e) * 2 + 0) * 64 + F.lane], wb = WG[((j * 4 + e) * 2 + 1) * 64 + F.lane]; const float hx = hv[e];
                    ga[0] += hx * wa.x; ga[1] += hx * wa.y; ga[2] += hx * wa.z; ga[3] += hx * wa.w; ga[4] += hx * wb.x; ga[5] += hx * wb.y; ga[6] += hx * wb.z; ga[7] += hx * wb.w; } } }
        if (GATES) {
#pragma unroll
            for (int q = 0; q < 8; ++q) ga[q] = wave_sum(ga[q]);
            if (F.lane == 0) { f32x4 o0, o1;
#pragma unroll
                for (int h = 0; h < 4; ++h) { o0[h] = ga[h] + bi[h]; const float z = ga[4 + h] + bfv[h]; o1[h] = fminf(z, 0.f) - log1pf(expf(-fabsf(z))); }
                *(f32x4*)(GT + (size_t)m * 8) = o0; *(f32x4*)(GT + (size_t)m * 8 + 4) = o1; } }
#pragma unroll
        for (int j = 0; j < 8; ++j) v[j] = vn[j];
    }
    if (GATES) __syncthreads();
}

namespace ml {
constexpr int QS = 272, TS = 144;
constexpr int OFF_Q = 0, OFF_K = 17408, OFF_CB = 34816, OFF_KT = 52224  , OFF_VT = 89088  , OFF_W = 107520, OFF_SC = 116736  ,
              OFF_DEN = 118784, OFF_NQ = 119296, OFF_N = 119552;
}
struct MReg { u32x4 q[2], k[2], v; u32x2 mo[2]; float ig, lf; };
__device__ __forceinline__ void ml_load(MReg& R, const bf16_t* PROJ, const float* GT, int row0, int nvalid, int h, int vs, int tid, int lane, int w) {
    const u32x4 z = {0u, 0u, 0u, 0u};
#pragma unroll
    for (int j = 0; j < 2; ++j) { const int r = (tid >> 4) + 32 * j; R.q[j] = (r < nvalid) ? *(const u32x4*)(PROJ + (size_t)(row0 + r) * NPJ + PJ_MQ + h * 128 + (tid & 15) * 8) : z; }
    const bool ok = lane < nvalid; const size_t rb = (size_t)(row0 + lane) * NPJ;
#pragma unroll
    for (int j = 0; j < 2; ++j) R.k[j] = ok ? *(const u32x4*)(PROJ + rb + PJ_MK + h * 128 + (w + 8 * j) * 8) : z;
    R.v = ok ? *(const u32x4*)(PROJ + rb + PJ_MV + h * 256 + vs * 64 + w * 8) : z;
    R.ig = ok ? GT[(size_t)(row0 + lane) * 8 + h] : -1e30f; R.lf = ok ? GT[(size_t)(row0 + lane) * 8 + 4 + h] : 0.f;
    { const int t = (w >> 1) * 16 + (lane & 15);
#pragma unroll
        for (int j = 0; j < 2; ++j) R.mo[j] = (t < nvalid) ? *(const u32x2*)(PROJ + (size_t)(row0 + t) * NPJ + PJ_MO + h * 256 + vs * 64 + ((w & 1) * 2 + j) * 16 + 4 * (lane >> 4)) : (u32x2){0u, 0u}; }
}
__device__ __forceinline__ float ml_stage(const MReg& R, LAS unsigned char* lds, int buf, float& m_prev, int tid, int lane, int w) {
    using namespace ml;
    float b = R.lf;
#pragma unroll
    for (int o = 1; o < 64; o <<= 1) { const float t = __shfl_up(b, o); if (lane >= o) b += t; }
    const float a = R.ig - b; float pm = a;
#pragma unroll
    for (int o = 1; o < 64; o <<= 1) { const float t = __shfl_up(pm, o); if (lane >= o) pm = fmaxf(pm, t); }
    const float M = fmaxf(m_prev, pm), M63 = __shfl(M, 63), b63 = __shfl(b, 63);
    const float wk = __expf(a - M63), decay = __expf(m_prev - M63), gt = __expf(m_prev - M), emt = __expf(-(b + M));
    if (w == 0) { LAS float* sc = (LAS float*)(lds + OFF_SC) + buf * 256; sc[lane] = a; sc[64 + lane] = M; sc[128 + lane] = gt; sc[192 + lane] = emt; }
    m_prev = b63 + M63;
#pragma unroll
    for (int j = 0; j < 2; ++j) *(LAS u32x4*)(lds + OFF_Q + ((tid >> 4) + 32 * j) * QS + (tid & 15) * 16) = R.q[j];
#pragma unroll
    for (int j = 0; j < 2; ++j) { *(LAS u32x4*)(lds + OFF_K + lane * QS + (w + 8 * j) * 16) = R.k[j];
        float f[8]; unpack8(R.k[j], f);
#pragma unroll
        for (int e = 0; e < 8; ++e) *(LAS bf16_t*)(lds + OFF_KT + buf * 18432 + ((w + 8 * j) * 8 + e) * TS + lane * 2) = (bf16_t)f2bf(f[e] * wk); }
    { const unsigned vw[4] = {R.v.x, R.v.y, R.v.z, R.v.w};
#pragma unroll
        for (int e = 0; e < 8; ++e) *(LAS bf16_t*)(lds + OFF_VT + buf * 9216 + (w * 8 + e) * TS + lane * 2) = (bf16_t)((e & 1) ? (vw[e >> 1] >> 16) : (vw[e >> 1] & 0xffffu)); }
    return decay;
}
__device__ __forceinline__ void mlstm_chain(Ctx& F, const Args& a, const float* C0, const float* n0, const float* m0, float* Cout, float* nout, float* mout,
                                            int row0, int nchunks, int nvalid, int h, int vs, float* hsq, const float* gmo) {
    using namespace ml;
    LAS unsigned char* lds = F.lds;
    const bf16_t* PROJ = (const bf16_t*)(FWS + WS_PROJ); const float* GT = (const float*)(FWS + WS_GATES); bf16_t* MIX = (bf16_t*)(FWS + WS_MIX);
    const int tid = F.tid, lane = F.lane, w = F.wave, c16 = lane & 15, g = lane >> 4, tt = w >> 1, half = w & 1;
    __syncthreads();
    f32x4 accC[4];
#pragma unroll
    for (int vt = 0; vt < 4; ++vt) { accC[vt] = C0 ? *(const f32x4*)(C0 + (size_t)(vs * 64 + vt * 16 + c16) * 128 + 16 * w + 4 * g) : (f32x4){0.f, 0.f, 0.f, 0.f};
        u32x2 o; o.x = pkbf(accC[vt][0], accC[vt][1]); o.y = pkbf(accC[vt][2], accC[vt][3]); *(LAS u32x2*)(lds + OFF_CB + (vt * 16 + c16) * QS + (16 * w + 4 * g) * 2) = o; }
    if (tid < 128) ((LAS float*)(lds + OFF_N))[tid] = n0 ? n0[tid] : 0.f;
    float m_prev = m0 ? m0[0] : 0.f;
    f32x4 gmv[2];
#pragma unroll
    for (int j = 0; j < 2; ++j) gmv[j] = *(const f32x4*)(gmo + h * 256 + vs * 64 + ((w & 1) * 2 + j) * 16 + 4 * (lane >> 4));
    MReg RA, RB; ml_load(RA, PROJ, GT, row0, nvalid, h, vs, tid, lane, w);
    if (nchunks > 1) ml_load(RB, PROJ, GT, row0 + 64, nvalid, h, vs, tid, lane, w);
    float decay = ml_stage(RA, lds, 0, m_prev, tid, lane, w);
    u32x2 mocur[2] = {RA.mo[0], RA.mo[1]};
    if (nchunks > 2) ml_load(RA, PROJ, GT, row0 + 128, nvalid, h, vs, tid, lane, w);
    auto step = [&](const int c, MReg& R) __attribute__((always_inline)) {
        const int buf = c & 1; const int rbase = row0 + c * 64;
        __syncthreads();
        const LAS float* sc = (const LAS float*)(lds + OFF_SC) + buf * 256;
        bf16x8 qf[4];
#pragma unroll
        for (int ks = 0; ks < 4; ++ks) qf[ks] = *(const LAS bf16x8*)(lds + OFF_Q + (tt * 16 + c16) * QS + (g * 8 + 32 * ks) * 2);
        const int t = tt * 16 + c16; const float Mt = sc[64 + t];
        float dsum = 0.f;
#pragma unroll
        for (int j = 0; j < 2; ++j) { const int st = half * 2 + j; f32x4 wv = {0.f, 0.f, 0.f, 0.f};
            if (st <= tt) { f32x4 acc = {0.f, 0.f, 0.f, 0.f};
#pragma unroll
                for (int ks = 0; ks < 4; ++ks) { const bf16x8 kf = *(const LAS bf16x8*)(lds + OFF_K + (st * 16 + c16) * QS + (g * 8 + 32 * ks) * 2); acc = MFMA16(kf, qf[ks], acc); }
                const f32x4 as = *(const LAS f32x4*)(sc + st * 16 + 4 * g);
#pragma unroll
                for (int r = 0; r < 4; ++r) { const int s = st * 16 + 4 * g + r; wv[r] = (s <= t) ? __expf(as[r] - Mt) * acc[r] : 0.f; } }
            dsum += (wv[0] + wv[1]) + (wv[2] + wv[3]);
            u32x2 o; o.x = pkbf(wv[0], wv[1]); o.y = pkbf(wv[2], wv[3]); *(LAS u32x2*)(lds + OFF_W + t * TS + (st * 16 + 4 * g) * 2) = o; }
        dsum += __shfl_xor(dsum, 16); dsum += __shfl_xor(dsum, 32);
        if (g == 0) ((LAS float*)(lds + OFF_DEN))[t * 2 + half] = dsum;
        f32x4 acc2[2];
#pragma unroll
        for (int j = 0; j < 2; ++j) { const int vt = half * 2 + j; acc2[j] = (f32x4){0.f, 0.f, 0.f, 0.f};
#pragma unroll
            for (int ks = 0; ks < 4; ++ks) { const bf16x8 cf = *(const LAS bf16x8*)(lds + OFF_CB + (vt * 16 + c16) * QS + (g * 8 + 32 * ks) * 2); acc2[j] = MFMA16(cf, qf[ks], acc2[j]); } }
        { const int tq = tid >> 3, part = tid & 7; float s = 0.f;
#pragma unroll
            for (int i = 0; i < 2; ++i) { const u32x4 qq = *(const LAS u32x4*)(lds + OFF_Q + tq * QS + (part * 16 + i * 8) * 2); float f[8]; unpack8(qq, f);
                const LAS float* nn = (const LAS float*)(lds + OFF_N) + part * 16 + i * 8;
#pragma unroll
                for (int e = 0; e < 8; ++e) s += f[e] * nn[e]; }
            s += __shfl_xor(s, 1); s += __shfl_xor(s, 2); s += __shfl_xor(s, 4);
            if (part == 0) ((LAS float*)(lds + OFF_NQ))[tq] = s; }
        __syncthreads();
        bf16x8 wf[2];
#pragma unroll
        for (int ks = 0; ks < 2; ++ks) wf[ks] = *(const LAS bf16x8*)(lds + OFF_W + (tt * 16 + c16) * TS + (g * 8 + 32 * ks) * 2);
        const float gtt = sc[128 + t], emt = sc[192 + t];
        const float den = ((const LAS float*)(lds + OFF_DEN))[t * 2] + ((const LAS float*)(lds + OFF_DEN))[t * 2 + 1] + gtt * ((const LAS float*)(lds + OFF_NQ))[t];
        const float inv = 1.0f / fmaxf(fabsf(den), emt);
        const LAS unsigned char* vtb = lds + OFF_VT + buf * 9216; const LAS unsigned char* ktb = lds + OFF_KT + buf * 18432;
        float hq2 = 0.f;
#pragma unroll
        for (int j = 0; j < 2; ++j) { const int vt = half * 2 + j; f32x4 a1 = {0.f, 0.f, 0.f, 0.f};
#pragma unroll
            for (int ks = 0; ks < 2; ++ks) { const bf16x8 vf = *(const LAS bf16x8*)(vtb + (vt * 16 + c16) * TS + (g * 8 + 32 * ks) * 2); a1 = MFMA16(vf, wf[ks], a1); }
            const f32x4 hv = (a1 + gtt * acc2[j]) * inv;
            hq2 += (hv[0] * hv[0] + hv[1] * hv[1]) + (hv[2] * hv[2] + hv[3] * hv[3]);
            if (t < nvalid) { const u32x2 mo = mocur[j];
                const f32x4 mf = {bflo(mo.x), bfhi(mo.x), bflo(mo.y), bfhi(mo.y)}; f32x4 ov;
#pragma unroll
                for (int r = 0; r < 4; ++r) ov[r] = hv[r] * gmv[j][r] * (1.0f / (1.0f + __expf(-mf[r])));
                u32x2 o; o.x = pkbf(ov[0], ov[1]); o.y = pkbf(ov[2], ov[3]); *(u32x2*)(MIX + (size_t)(rbase + t) * DM + h * 256 + vs * 64 + vt * 16 + 4 * g) = o; } }
        hq2 += __shfl_xor(hq2, 16); hq2 += __shfl_xor(hq2, 32);
        if (g == 0 && t < nvalid) unsafeAtomicAdd(hsq + (size_t)(rbase + t) * 8 + h, hq2);
        bf16x8 kf2[2];
#pragma unroll
        for (int ks = 0; ks < 2; ++ks) kf2[ks] = *(const LAS bf16x8*)(ktb + (w * 16 + c16) * TS + (g * 8 + 32 * ks) * 2);
#pragma unroll
        for (int vt = 0; vt < 4; ++vt) { accC[vt] = accC[vt] * decay;
#pragma unroll
            for (int ks = 0; ks < 2; ++ks) { const bf16x8 vf = *(const LAS bf16x8*)(vtb + (vt * 16 + c16) * TS + (g * 8 + 32 * ks) * 2); accC[vt] = MFMA16(kf2[ks], vf, accC[vt]); }
            u32x2 o; o.x = pkbf_mfma(accC[vt][0], accC[vt][1]); o.y = pkbf_mfma(accC[vt][2], accC[vt][3]); *(LAS u32x2*)(lds + OFF_CB + (vt * 16 + c16) * QS + (16 * w + 4 * g) * 2) = o; }
        { float s = 0.f;
#pragma unroll
            for (int i = 0; i < 2; ++i) { const u32x4 kk = *(const LAS u32x4*)(ktb + (w * 16 + c16) * TS + (g * 16 + i * 8) * 2); float f[8]; unpack8(kk, f);
#pragma unroll
                for (int e = 0; e < 8; ++e) s += f[e]; }
            s += __shfl_xor(s, 16); s += __shfl_xor(s, 32);
            if (g == 0) { LAS float* nn = (LAS float*)(lds + OFF_N) + w * 16 + c16; *nn = decay * (*nn) + s; } }
        if (c + 1 < nchunks) { decay = ml_stage(R, lds, buf ^ 1, m_prev, tid, lane, w); mocur[0] = R.mo[0]; mocur[1] = R.mo[1];
            if (c + 3 < nchunks) ml_load(R, PROJ, GT, rbase + 192, nvalid, h, vs, tid, lane, w); }
    };
    for (int c = 0; c < nchunks; c += 2) { step(c, RB); if (c + 1 < nchunks) step(c + 1, RA); }
    __syncthreads();
#pragma unroll
    for (int vt = 0; vt < 4; ++vt) *(f32x4*)(Cout + (size_t)(vs * 64 + vt * 16 + c16) * 128 + 16 * w + 4 * g) = accC[vt];
    if (vs == 0 && tid < 128) nout[tid] = ((const LAS float*)(lds + OFF_N))[tid];
    if (vs == 0 && tid == 0) mout[0] = m_prev;
}

namespace at {
constexpr int KS = 144, VS = 400;
constexpr int OFF_KN = 0, OFF_VT = 27648, OFF_BT = 53248;
}
__device__ __forceinline__ int t5_bucket(int rel) {
    const int n = rel < 0 ? -rel : rel; int v;
    if (n < 8) v = n; else if (n <= 11) v = 8; else if (n <= 15) v = 9; else if (n <= 22) v = 10; else if (n <= 31) v = 11; else if (n <= 45) v = 12; else if (n <= 63) v = 13; else if (n <= 90) v = 14; else v = 15;
    return v + (rel > 0 ? 16 : 0);
}
__device__ __forceinline__ void knorm8(float (&f)[8], const float* gk, int ch) {
    float ss = 0.f;
#pragma unroll
    for (int e = 0; e < 8; ++e) ss += f[e] * f[e];
    ss += __shfl_xor(ss, 1); ss += __shfl_xor(ss, 2); ss += __shfl_xor(ss, 4);
    const float rn = 1.0f / sqrtf(ss * (1.0f / 64.0f) + EPS);
#pragma unroll
    for (int e = 0; e < 8; ++e) f[e] = f[e] * rn * gk[ch * 8 + e];
}
__device__ __forceinline__ void attn_unit(Ctx& F, const Args& a, int l, bool prompt, int b, int c, int kvh) {
    using namespace at;
    LAS unsigned char* lds = F.lds;
    const bf16_t* PROJ = (const bf16_t*)(FWS + WS_PROJ); bf16_t* MIX = (bf16_t*)(FWS + WS_MIX);
    const int tid = F.tid, lane = F.lane, w = F.wave, c16 = lane & 15, g = lane >> 4;
    const float* gq = FIN(12) + l * 64; const float* gk = FIN(13) + l * 64;
    float* hsq = (float*)(FWS + WS_HSQ) + (size_t)l * MT * 8; const float* gao = FIN(16) + l * 1024;
    __syncthreads();
    int nkeys, nprev;
    if (prompt) {
        const int nkc = (c < 2 ? c : 2) + 1; nkeys = nkc * 64; nprev = nkeys - 64; const int p0 = (c - (nkc - 1)) * 64;
        for (int kc = 0; kc < nkc; ++kc) {
            const bool own = (kc == nkc - 1) && (c >= 30);
            { const int key = tid >> 3, ch = tid & 7; const size_t row = (size_t)b * SEQ + p0 + kc * 64 + key;
                const u32x4 kk = *(const u32x4*)(PROJ + row * NPJ + PJ_AK + kvh * 64 + ch * 8); float f[8]; unpack8(kk, f); knorm8(f, gk, ch);
                u32x4 o; o.x = pkbf(f[0], f[1]); o.y = pkbf(f[2], f[3]); o.z = pkbf(f[4], f[5]); o.w = pkbf(f[6], f[7]);
                *(LAS u32x4*)(lds + OFF_KN + (kc * 64 + key) * KS + ch * 16) = o;
                if (own) { float* dst = FOUT + O_PCK + ((size_t)(l * 16 + b) * 128 + (c * 64 + key - 1920)) * 256 + kvh * 64 + ch * 8;
                    *(f32x4*)dst = (f32x4){f[0], f[1], f[2], f[3]}; *(f32x4*)(dst + 4) = (f32x4){f[4], f[5], f[6], f[7]}; } }
            { const size_t row = (size_t)b * SEQ + p0 + kc * 64 + lane;
                const u32x4 vv = *(const u32x4*)(PROJ + row * NPJ + PJ_AV + kvh * 64 + w * 8); float f[8]; unpack8(vv, f);
#pragma unroll
                for (int e = 0; e < 8; ++e) *(LAS bf16_t*)(lds + OFF_VT + (w * 8 + e) * VS + (kc * 64 + lane) * 2) = (bf16_t)(__builtin_bit_cast(unsigned, f[e]) >> 16);
                if (own) { float* dst = FOUT + O_PCV + ((size_t)(l * 16 + b) * 128 + (c * 64 + lane - 1920)) * 256 + kvh * 64 + w * 8;
                    *(f32x4*)dst = (f32x4){f[0], f[1], f[2], f[3]}; *(f32x4*)(dst + 4) = (f32x4){f[4], f[5], f[6], f[7]}; } }
        }
    } else {
        nkeys = 160; nprev = 128;
        const float* ck = FIN(2) + (size_t)(l * 16 + b) * 128 * 256; const float* cv = FIN(3) + (size_t)(l * 16 + b) * 128 * 256;
        float* sk = FOUT + O_SCK + (size_t)(l * 16 + b) * 128 * 256; float* sv = FOUT + O_SCV + (size_t)(l * 16 + b) * 128 * 256;
#pragma unroll
        for (int j = 0; j < 2; ++j) {
            { const int key = (tid >> 3) + 64 * j, ch = tid & 7; const float* src = ck + (size_t)key * 256 + kvh * 64 + ch * 8;
                const f32x4 va = *(const f32x4*)src, bb = *(const f32x4*)(src + 4);
                u32x4 o; o.x = pkbf(va.x, va.y); o.y = pkbf(va.z, va.w); o.z = pkbf(bb.x, bb.y); o.w = pkbf(bb.z, bb.w);
                *(LAS u32x4*)(lds + OFF_KN + key * KS + ch * 16) = o;
                if (key >= 32) { float* dst = sk + (size_t)(key - 32) * 256 + kvh * 64 + ch * 8; *(f32x4*)dst = va; *(f32x4*)(dst + 4) = bb; } }
            { const int key = lane + 64 * j; const float* src = cv + (size_t)key * 256 + kvh * 64 + w * 8;
                const f32x4 va = *(const f32x4*)src, bb = *(const f32x4*)(src + 4); const float f[8] = {va.x, va.y, va.z, va.w, bb.x, bb.y, bb.z, bb.w};
#pragma unroll
                for (int e = 0; e < 8; ++e) *(LAS bf16_t*)(lds + OFF_VT + (w * 8 + e) * VS + key * 2) = (bf16_t)f2bf(f[e]);
                if (key >= 32) { float* dst = sv + (size_t)(key - 32) * 256 + kvh * 64 + w * 8; *(f32x4*)dst = va; *(f32x4*)(dst + 4) = bb; } }
        }
        if (tid < 256) { const int key = tid >> 3, ch = tid & 7; const size_t row = (size_t)MP + b * SL + key;
            const u32x4 kk = *(const u32x4*)(PROJ + row * NPJ + PJ_AK + kvh * 64 + ch * 8); float f[8]; unpack8(kk, f); knorm8(f, gk, ch);
            u32x4 o; o.x = pkbf(f[0], f[1]); o.y = pkbf(f[2], f[3]); o.z = pkbf(f[4], f[5]); o.w = pkbf(f[6], f[7]);
            *(LAS u32x4*)(lds + OFF_KN + (128 + key) * KS + ch * 16) = o;
            float* dst = sk + (size_t)(96 + key) * 256 + kvh * 64 + ch * 8; *(f32x4*)dst = (f32x4){f[0], f[1], f[2], f[3]}; *(f32x4*)(dst + 4) = (f32x4){f[4], f[5], f[6], f[7]}; }
        if (lane < 32) { const size_t row = (size_t)MP + b * SL + lane;
            const u32x4 vv = *(const u32x4*)(PROJ + row * NPJ + PJ_AV + kvh * 64 + w * 8); float f[8]; unpack8(vv, f);
#pragma unroll
            for (int e = 0; e < 8; ++e) *(LAS bf16_t*)(lds + OFF_VT + (w * 8 + e) * VS + (128 + lane) * 2) = (bf16_t)(__builtin_bit_cast(unsigned, f[e]) >> 16);
            float* dst = sv + (size_t)(96 + lane) * 256 + kvh * 64 + w * 8; *(f32x4*)dst = (f32x4){f[0], f[1], f[2], f[3]}; *(f32x4*)(dst + 4) = (f32x4){f[4], f[5], f[6], f[7]}; }
    }
    __syncthreads();
    const int hl = w >> 1, hq = kvh * 4 + hl; const float sink = FIN(14)[l * 16 + hq];
    const LAS float* BT = (const LAS float*)(lds + OFF_BT) + hq * 256;
    const int nqt = prompt ? 2 : 1, nkb = nkeys >> 5;
    for (int qt = 0; qt < nqt; ++qt) {
        const int qin = prompt ? (w & 1) * 32 + qt * 16 + c16 : (w & 1) * 16 + c16;
        const size_t row = prompt ? (size_t)b * SEQ + c * 64 + qin : (size_t)MP + b * SL + qin;
        bf16x8 qf[2];
        { float f[2][8]; float ss = 0.f;
#pragma unroll
            for (int ks = 0; ks < 2; ++ks) { const u32x4 qq = *(const u32x4*)(PROJ + row * NPJ + PJ_AQ + hq * 64 + g * 8 + 32 * ks); unpack8(qq, f[ks]);
#pragma unroll
                for (int e = 0; e < 8; ++e) ss += f[ks][e] * f[ks][e]; }
            ss += __shfl_xor(ss, 16); ss += __shfl_xor(ss, 32);
            const float rn = 0.125f / sqrtf(ss * (1.0f / 64.0f) + EPS);
#pragma unroll
            for (int ks = 0; ks < 2; ++ks) { u32x4 o; const float* gg = gq + g * 8 + 32 * ks;
                o.x = pkbf(f[ks][0] * rn * gg[0], f[ks][1] * rn * gg[1]); o.y = pkbf(f[ks][2] * rn * gg[2], f[ks][3] * rn * gg[3]);
                o.z = pkbf(f[ks][4] * rn * gg[4], f[ks][5] * rn * gg[5]); o.w = pkbf(f[ks][6] * rn * gg[6], f[ks][7] * rn * gg[7]);
                qf[ks] = __builtin_bit_cast(bf16x8, o); } }
        float mrun = sink, lsum = (g == 0) ? 1.0f : 0.0f;
        f32x4 O[4];
#pragma unroll
        for (int dt = 0; dt < 4; ++dt) O[dt] = (f32x4){0.f, 0.f, 0.f, 0.f};
        for (int kb = 0; kb < nkb; ++kb) {
            f32x4 s[2];
#pragma unroll
            for (int j = 0; j < 2; ++j) { s[j] = (f32x4){0.f, 0.f, 0.f, 0.f};
#pragma unroll
                for (int ks = 0; ks < 2; ++ks) { const bf16x8 kf = *(const LAS bf16x8*)(lds + OFF_KN + (kb * 32 + 16 * j + c16) * KS + (g * 8 + 32 * ks) * 2); s[j] = MFMA16(kf, qf[ks], s[j]); }
                const int ib = kb * 32 + 16 * j + 4 * g - nprev - qin + 191;
#pragma unroll
                for (int r = 0; r < 4; ++r) s[j][r] += BT[ib + r]; }
            float mx = fmaxf(fmaxf(fmaxf(s[0][0], s[0][1]), fmaxf(s[0][2], s[0][3])), fmaxf(fmaxf(s[1][0], s[1][1]), fmaxf(s[1][2], s[1][3])));
            mx = fmaxf(mx, __shfl_xor(mx, 16)); mx = fmaxf(mx, __shfl_xor(mx, 32));
            const float mnew = fmaxf(mrun, mx), alpha = __expf(mrun - mnew); mrun = mnew;
            float ps = 0.f;
#pragma unroll
            for (int j = 0; j < 2; ++j)
#pragma unroll
                for (int r = 0; r < 4; ++r) { s[j][r] = __expf(s[j][r] - mnew); ps += s[j][r]; }
            lsum = lsum * alpha + ps;
            u32x4 pw; pw.x = pkbf(s[0][0], s[0][1]); pw.y = pkbf(s[0][2], s[0][3]); pw.z = pkbf(s[1][0], s[1][1]); pw.w = pkbf(s[1][2], s[1][3]);
            const bf16x8 pf = __builtin_bit_cast(bf16x8, pw);
#pragma unroll
            for (int dt = 0; dt < 4; ++dt) { const LAS unsigned char* vp = lds + OFF_VT + (dt * 16 + c16) * VS + (kb * 32 + 4 * g) * 2;
                const u32x2 v0 = *(const LAS u32x2*)vp, v1 = *(const LAS u32x2*)(vp + 32);
                u32x4 vw; vw.x = v0.x; vw.y = v0.y; vw.z = v1.x; vw.w = v1.y;
                O[dt] = O[dt] * alpha; O[dt] = MFMA16(__builtin_bit_cast(bf16x8, vw), pf, O[dt]); }
        }
        lsum += __shfl_xor(lsum, 16); lsum += __shfl_xor(lsum, 32);
        const float inv = 1.0f / lsum; float aq2 = 0.f;
#pragma unroll
        for (int dt = 0; dt < 4; ++dt) { const f32x4 ov = O[dt] * inv; const f32x4 gg = *(const f32x4*)(gao + hq * 64 + dt * 16 + 4 * g);
            aq2 += (ov[0] * ov[0] + ov[1] * ov[1]) + (ov[2] * ov[2] + ov[3] * ov[3]);
            u32x2 o; o.x = pkbf(ov[0] * gg[0], ov[1] * gg[1]); o.y = pkbf(ov[2] * gg[2], ov[3] * gg[3]);
            *(u32x2*)(MIX + row * DM + 1024 + hq * 64 + dt * 16 + 4 * g) = o; }
        aq2 += __shfl_xor(aq2, 16); aq2 += __shfl_xor(aq2, 32);
        if (g == 0) unsafeAtomicAdd(hsq + row * 8 + 4, aq2);
    }
}


struct AReg { u32x4 kk[3], vv[3], q[2][2]; };
__device__ __forceinline__ void attn_loadp(AReg& R, const bf16_t* PROJ, int b, int c, int kvh, int tid, int lane, int w) {
    const int nkc = (c < 2 ? c : 2) + 1, p0 = (c - (nkc - 1)) * 64, c16 = lane & 15, g = lane >> 4, hq = kvh * 4 + (w >> 1);
#pragma unroll
    for (int kc = 0; kc < 3; ++kc) if (kc < nkc) {
        R.kk[kc] = *(const u32x4*)(PROJ + ((size_t)b * SEQ + p0 + kc * 64 + (tid >> 3)) * NPJ + PJ_AK + kvh * 64 + (tid & 7) * 8);
        R.vv[kc] = *(const u32x4*)(PROJ + ((size_t)b * SEQ + p0 + kc * 64 + lane) * NPJ + PJ_AV + kvh * 64 + w * 8); }
#pragma unroll
    for (int qt = 0; qt < 2; ++qt) { const size_t row = (size_t)b * SEQ + c * 64 + (w & 1) * 32 + qt * 16 + c16;
#pragma unroll
        for (int ks = 0; ks < 2; ++ks) R.q[qt][ks] = *(const u32x4*)(PROJ + row * NPJ + PJ_AQ + hq * 64 + g * 8 + 32 * ks); }
}
__device__ __forceinline__ void attn_prompt_unit(Ctx& F, const Args& a, int l, int b, int c, int kvh, AReg& R, bool has_next, int nb, int nc, int nkvh) {
    using namespace at;
    LAS unsigned char* lds = F.lds;
    const bf16_t* PROJ = (const bf16_t*)(FWS + WS_PROJ); bf16_t* MIX = (bf16_t*)(FWS + WS_MIX);
    const int tid = F.tid, lane = F.lane, w = F.wave, c16 = lane & 15, g = lane >> 4;
    const float* gq = FIN(12) + l * 64; const float* gk = FIN(13) + l * 64;
    float* hsq = (float*)(FWS + WS_HSQ) + (size_t)l * MT * 8; const float* gao = FIN(16) + l * 1024;
    const int nkc = (c < 2 ? c : 2) + 1, nkeys = nkc * 64, nprev = nkeys - 64;
    __syncthreads();
#pragma unroll
    for (int kc = 0; kc < 3; ++kc) if (kc < nkc) {
        const bool own = (kc == nkc - 1) && (c >= 30);
        { const int key = tid >> 3, ch = tid & 7; float f[8]; unpack8(R.kk[kc], f); knorm8(f, gk, ch);
            u32x4 o; o.x = pkbf(f[0], f[1]); o.y = pkbf(f[2], f[3]); o.z = pkbf(f[4], f[5]); o.w = pkbf(f[6], f[7]);
            *(LAS u32x4*)(lds + OFF_KN + (kc * 64 + key) * KS + ch * 16) = o;
            if (own) { float* dst = FOUT + O_PCK + ((size_t)(l * 16 + b) * 128 + (c * 64 + key - 1920)) * 256 + kvh * 64 + ch * 8;
                *(f32x4*)dst = (f32x4){f[0], f[1], f[2], f[3]}; *(f32x4*)(dst + 4) = (f32x4){f[4], f[5], f[6], f[7]}; } }
        { float f[8]; unpack8(R.vv[kc], f);
#pragma unroll
            for (int e = 0; e < 8; ++e) *(LAS bf16_t*)(lds + OFF_VT + (w * 8 + e) * VS + (kc * 64 + lane) * 2) = (bf16_t)(__builtin_bit_cast(unsigned, f[e]) >> 16);
            if (own) { float* dst = FOUT + O_PCV + ((size_t)(l * 16 + b) * 128 + (c * 64 + lane - 1920)) * 256 + kvh * 64 + w * 8;
                *(f32x4*)dst = (f32x4){f[0], f[1], f[2], f[3]}; *(f32x4*)(dst + 4) = (f32x4){f[4], f[5], f[6], f[7]}; } }
    }
    const int hl = w >> 1, hq = kvh * 4 + hl; const float sink = FIN(14)[l * 16 + hq];
    bf16x8 qf[2][2];
#pragma unroll
    for (int qt = 0; qt < 2; ++qt) { float f[2][8]; float ss = 0.f;
#pragma unroll
        for (int ks = 0; ks < 2; ++ks) { unpack8(R.q[qt][ks], f[ks]);
#pragma unroll
            for (int e = 0; e < 8; ++e) ss += f[ks][e] * f[ks][e]; }
        ss += __shfl_xor(ss, 16); ss += __shfl_xor(ss, 32);
        const float rn = 0.125f / sqrtf(ss * (1.0f / 64.0f) + EPS);
#pragma unroll
        for (int ks = 0; ks < 2; ++ks) { u32x4 o; const float* gg = gq + g * 8 + 32 * ks;
            o.x = pkbf(f[ks][0] * rn * gg[0], f[ks][1] * rn * gg[1]); o.y = pkbf(f[ks][2] * rn * gg[2], f[ks][3] * rn * gg[3]);
            o.z = pkbf(f[ks][4] * rn * gg[4], f[ks][5] * rn * gg[5]); o.w = pkbf(f[ks][6] * rn * gg[6], f[ks][7] * rn * gg[7]);
            qf[qt][ks] = __builtin_bit_cast(bf16x8, o); } }
    __syncthreads();
    if (has_next) attn_loadp(R, PROJ, nb, nc, nkvh, tid, lane, w);
    const LAS float* BT = (const LAS float*)(lds + OFF_BT) + hq * 256;
    const int nkb = nkeys >> 5;
    const int qin0 = (w & 1) * 32 + c16;
    float mrun[2] = {sink, sink}, lsum[2] = {(g == 0) ? 1.0f : 0.0f, (g == 0) ? 1.0f : 0.0f};
    f32x4 O[2][4];
#pragma unroll
    for (int qt = 0; qt < 2; ++qt)
#pragma unroll
        for (int dt = 0; dt < 4; ++dt) O[qt][dt] = (f32x4){0.f, 0.f, 0.f, 0.f};
    for (int kb = 0; kb < nkb; ++kb) {
        bf16x8 kf[2][2];
#pragma unroll
        for (int j = 0; j < 2; ++j)
#pragma unroll
            for (int ks = 0; ks < 2; ++ks) kf[j][ks] = *(const LAS bf16x8*)(lds + OFF_KN + (kb * 32 + 16 * j + c16) * KS + (g * 8 + 32 * ks) * 2);
        f32x4 s[2][2];
#pragma unroll
        for (int qt = 0; qt < 2; ++qt)
#pragma unroll
            for (int j = 0; j < 2; ++j) { s[qt][j] = (f32x4){0.f, 0.f, 0.f, 0.f};
#pragma unroll
                for (int ks = 0; ks < 2; ++ks) s[qt][j] = MFMA16(kf[j][ks], qf[qt][ks], s[qt][j]); }
        bf16x8 pf[2];
#pragma unroll
        for (int qt = 0; qt < 2; ++qt) {
#pragma unroll
            for (int j = 0; j < 2; ++j) { const int ib = kb * 32 + 16 * j + 4 * g - nprev - (qin0 + 16 * qt) + 191;
#pragma unroll
                for (int r = 0; r < 4; ++r) s[qt][j][r] += BT[ib + r]; }
            float mx = fmaxf(fmaxf(fmaxf(s[qt][0][0], s[qt][0][1]), fmaxf(s[qt][0][2], s[qt][0][3])), fmaxf(fmaxf(s[qt][1][0], s[qt][1][1]), fmaxf(s[qt][1][2], s[qt][1][3])));
            mx = fmaxf(mx, __shfl_xor(mx, 16)); mx = fmaxf(mx, __shfl_xor(mx, 32));
            const float mnew = fmaxf(mrun[qt], mx), alpha = __expf(mrun[qt] - mnew); mrun[qt] = mnew;
            float ps = 0.f;
#pragma unroll
            for (int j = 0; j < 2; ++j)
#pragma unroll
                for (int r = 0; r < 4; ++r) { s[qt][j][r] = __expf(s[qt][j][r] - mnew); ps += s[qt][j][r]; }
            lsum[qt] = lsum[qt] * alpha + ps;
            u32x4 pw; pw.x = pkbf(s[qt][0][0], s[qt][0][1]); pw.y = pkbf(s[qt][0][2], s[qt][0][3]); pw.z = pkbf(s[qt][1][0], s[qt][1][1]); pw.w = pkbf(s[qt][1][2], s[qt][1][3]);
            pf[qt] = __builtin_bit_cast(bf16x8, pw);
#pragma unroll
            for (int dt = 0; dt < 4; ++dt) O[qt][dt] = O[qt][dt] * alpha;
        }
#pragma unroll
        for (int dt = 0; dt < 4; ++dt) { const LAS unsigned char* vp = lds + OFF_VT + (dt * 16 + c16) * VS + (kb * 32 + 4 * g) * 2;
            const u32x2 v0 = *(const LAS u32x2*)vp, v1 = *(const LAS u32x2*)(vp + 32);
            u32x4 vw; vw.x = v0.x; vw.y = v0.y; vw.z = v1.x; vw.w = v1.y; const bf16x8 vf = __builtin_bit_cast(bf16x8, vw);
            O[0][dt] = MFMA16(vf, pf[0], O[0][dt]); O[1][dt] = MFMA16(vf, pf[1], O[1][dt]); }
    }
#pragma unroll
    for (int qt = 0; qt < 2; ++qt) {
        const size_t row = (size_t)b * SEQ + c * 64 + qin0 + 16 * qt;
        float ls = lsum[qt]; ls += __shfl_xor(ls, 16); ls += __shfl_xor(ls, 32);
        const float inv = 1.0f / ls; float aq2 = 0.f;
#pragma unroll
        for (int dt = 0; dt < 4; ++dt) { const f32x4 ov = O[qt][dt] * inv; const f32x4 gg = *(const f32x4*)(gao + hq * 64 + dt * 16 + 4 * g);
            aq2 += (ov[0] * ov[0] + ov[1] * ov[1]) + (ov[2] * ov[2] + ov[3] * ov[3]);
            u32x2 o; o.x = pkbf(ov[0] * gg[0], ov[1] * gg[1]); o.y = pkbf(ov[2] * gg[2], ov[3] * gg[3]);
            *(u32x2*)(MIX + row * DM + 1024 + hq * 64 + dt * 16 + 4 * g) = o; }
        aq2 += __shfl_xor(aq2, 16); aq2 += __shfl_xor(aq2, 32);
        if (g == 0) unsafeAtomicAdd(hsq + row * 8 + 4, aq2);
    }
}

template <int WHICH>
__device__ __forceinline__ void phase_mixers(Ctx& F, const Args& a, int l) {
    float* hsq = (float*)(FWS + WS_HSQ) + (size_t)l * MT * 8; const float* gmo = FIN(15) + l * 1024;
#ifndef DBG_NO_ML
    if (WHICH & 1) for (int u = F.bid; u < 512; u += F.G) {
        const bool smp = u >= 256; const int uu = u & 255, b = uu >> 4, h = (uu >> 2) & 3, vs = uu & 3; const size_t so = (size_t)((l * 16 + b) * 4 + h);
        if (!smp) mlstm_chain(F, a, nullptr, nullptr, nullptr, FOUT + O_PC + so * 32768, FOUT + O_PN + so * 128, FOUT + O_PM + so, b * SEQ, 32, 64, h, vs, hsq, gmo);
        else mlstm_chain(F, a, FIN(4) + so * 32768, FIN(5) + so * 128, FIN(6) + so, FOUT + O_SC + so * 32768, FOUT + O_SN + so * 128, FOUT + O_SM + so, MP + b * SL, 1, 32, h, vs, hsq, gmo);
    }
#endif
#ifndef DBG_NO_ATTN
    if (WHICH & 2) {
        __syncthreads();
        { LAS float* BT = (LAS float*)(F.lds + at::OFF_BT); const float* rb = FIN(7);
            for (int i = F.tid; i < 4096; i += 512) { const int hh = i >> 8, idx = i & 255; BT[i] = (idx < 255) ? rb[t5_bucket(idx - 191) * 16 + hh] : 0.f; } }
        const bf16_t* PROJ = (const bf16_t*)(FWS + WS_PROJ);
        AReg R; int u = F.bid;
        if (u < 2048) attn_loadp(R, PROJ, u >> 7, (u >> 2) & 31, u & 3, F.tid, F.lane, F.wave);
        for (; u < 2048; u += F.G) { const int un = u + F.G;
            attn_prompt_unit(F, a, l, u >> 7, (u >> 2) & 31, u & 3, R, un < 2048, un >> 7, (un >> 2) & 31, un & 3); }
        for (int v = F.bid; v < 64; v += F.G) attn_unit(F, a, l, false, v >> 2, 0, v & 3);
    }
#endif
    __syncthreads();
}

__device__ __forceinline__ void phase_finalize(Ctx& F, const Args& a, int l) {
    const bf16_t* PROJ = (const bf16_t*)(FWS + WS_PROJ); bf16_t* MIX = (bf16_t*)(FWS + WS_MIX);
    const float* gmo = FIN(15) + l * 1024; const float* gao = FIN(16) + l * 1024;
    const int gw = F.bid * 8 + F.wave, NGW = F.G * 8, lane = F.lane;
    u32x4 raw[4], mo[2], rawn[4], mon[2];
    if (gw < MT) {
#pragma unroll
        for (int j = 0; j < 4; ++j) raw[j] = *(const u32x4*)(MIX + (size_t)gw * DM + (lane + 64 * j) * 8);
#pragma unroll
        for (int j = 0; j < 2; ++j) mo[j] = *(const u32x4*)(PROJ + (size_t)gw * NPJ + PJ_MO + (lane + 64 * j) * 8); }
    for (int m = gw; m < MT; m += NGW) {
        bf16_t* mr = MIX + (size_t)m * DM; const int mn = m + NGW;
        if (mn < MT) {
#pragma unroll
            for (int j = 0; j < 4; ++j) rawn[j] = *(const u32x4*)(MIX + (size_t)mn * DM + (lane + 64 * j) * 8);
#pragma unroll
            for (int j = 0; j < 2; ++j) mon[j] = *(const u32x4*)(PROJ + (size_t)mn * NPJ + PJ_MO + (lane + 64 * j) * 8); }
        float f[4][8];
#pragma unroll
        for (int j = 0; j < 4; ++j) unpack8(raw[j], f[j]);
        float sa = 0.f;
#pragma unroll
        for (int j = 0; j < 2; ++j) { float ss = 0.f;
#pragma unroll
            for (int e = 0; e < 8; ++e) ss += f[j][e] * f[j][e];
            ss += __shfl_xor(ss, 1); ss += __shfl_xor(ss, 2); ss += __shfl_xor(ss, 4); ss += __shfl_xor(ss, 8); ss += __shfl_xor(ss, 16);
            const float rn = 1.0f / sqrtf(ss * (1.0f / 256.0f) + EPS);
            float o[8], mf[8]; unpack8(mo[j], mf); const float* gg = gmo + (lane + 64 * j) * 8;
#pragma unroll
            for (int e = 0; e < 8; ++e) o[e] = f[j][e] * rn * gg[e] * (1.0f / (1.0f + __expf(-mf[e])));
            u32x4 ow; ow.x = pkbf(o[0], o[1]); ow.y = pkbf(o[2], o[3]); ow.z = pkbf(o[4], o[5]); ow.w = pkbf(o[6], o[7]);
            *(u32x4*)(mr + (lane + 64 * j) * 8) = ow; }
#pragma unroll
        for (int j = 2; j < 4; ++j)
#pragma unroll
            for (int e = 0; e < 8; ++e) sa += f[j][e] * f[j][e];
        sa = wave_sum(sa);
        const float ra = 1.0f / sqrtf(sa * (1.0f / 1024.0f) + EPS);
#pragma unroll
        for (int j = 2; j < 4; ++j) { float o[8]; const float* gg = gao + (lane + 64 * (j - 2)) * 8;
#pragma unroll
            for (int e = 0; e < 8; ++e) o[e] = f[j][e] * ra * gg[e];
            u32x4 ow; ow.x = pkbf(o[0], o[1]); ow.y = pkbf(o[2], o[3]); ow.z = pkbf(o[4], o[5]); ow.w = pkbf(o[6], o[7]);
            *(u32x4*)(mr + (lane + 64 * j) * 8) = ow; }
#pragma unroll
        for (int j = 0; j < 4; ++j) raw[j] = rawn[j];
#pragma unroll
        for (int j = 0; j < 2; ++j) mo[j] = mon[j];
    }
}

#define XB_TMO      128
#define XB_XCNT(j)  (256  + 64 * (j))
#define XB_XSUB(j)  (1280 + 64 * (j))
#define XB_XGEN(j)  (2304 + 64 * (j))
#define XB_TOP      3328
#define XB_TOPGEN   3392
#define XCD_BAR_WORDS 3456
#define XB_SPIN_CAP (1u << 18)

__device__ __forceinline__ unsigned xb_ld(unsigned* p)              { return __hip_atomic_load(p, __ATOMIC_RELAXED, __HIP_MEMORY_SCOPE_AGENT); }
__device__ __forceinline__ unsigned xb_add(unsigned* p, unsigned v) { return __hip_atomic_fetch_add(p, v, __ATOMIC_RELAXED, __HIP_MEMORY_SCOPE_AGENT); }
__device__ __forceinline__ unsigned xb_xcc_id() { return (unsigned)__builtin_amdgcn_s_getreg((3 << 11) | 20) & 0xFu; }
#define XB_SPIN(cond, bar) do { unsigned _sp = 0; while (cond) { __builtin_amdgcn_s_sleep(1); \
    if ((++_sp & 255u) == 0u) { if (xb_ld(&(bar)[XB_TMO])) break; if (_sp > XB_SPIN_CAP) { atomicAdd(&(bar)[XB_TMO], 1u); break; } } } } while (0)

struct XcdBarrier {
    unsigned* bar; unsigned x;
    volatile LAS unsigned* st;
};

__device__ __forceinline__ XcdBarrier xcd_barrier_post(unsigned* bar, volatile LAS unsigned* st) {
    XcdBarrier b; b.bar = bar; b.x = xb_xcc_id(); b.st = st;
    if (threadIdx.x == 0) (void)xb_add(&bar[XB_XCNT(b.x)], 1u);
    return b;
}
__device__ __forceinline__ void xcd_barrier_complete(unsigned* bar, unsigned x, unsigned& nloc, unsigned& nx) {
    const unsigned G = gridDim.x * gridDim.y * gridDim.z;
    unsigned sum, cnt, mine, sp = 0u;
    for (;;) {
        sum = 0u; cnt = 0u; mine = 0u;
#pragma unroll
        for (unsigned j = 0; j < 16; ++j) { const unsigned c = xb_ld(&bar[XB_XCNT(j)]); sum += c; cnt += (c > 0u) ? 1u : 0u; mine = (j == x) ? c : mine; }
        if (sum == G) break;
        __builtin_amdgcn_s_sleep(1);
        if ((++sp & 255u) == 0u) { if (xb_ld(&bar[XB_TMO])) break; if (sp > XB_SPIN_CAP) { atomicAdd(&bar[XB_TMO], 1u); break; } }
    }
    nloc = mine > 0u ? mine : 1u; nx = cnt > 0u ? cnt : 1u;
}

__device__ __forceinline__ void xcd_barrier(const XcdBarrier& b) {
    asm volatile("s_waitcnt vmcnt(0)" ::: "memory");
    __syncthreads();
    if (threadIdx.x == 0) {
        unsigned* bar = b.bar;
        __builtin_amdgcn_s_waitcnt(0);
        unsigned nloc = b.st[0], nx = b.st[1];
        if (nloc == 0u) { xcd_barrier_complete(bar, b.x, nloc, nx); b.st[0] = nloc; b.st[1] = nx; }
        const unsigned old = xb_add(&bar[XB_XSUB(b.x)], 1u);
        const unsigned gen = old / nloc;
        if (old + 1u == (gen + 1u) * nloc) {
            __builtin_amdgcn_fence(__ATOMIC_RELEASE, "agent");
            asm volatile("s_waitcnt vmcnt(0)" ::: "memory");
            const unsigned og = xb_add(&bar[XB_TOP], 1u);
            const unsigned tg = og / nx;
            if (og + 1u == (tg + 1u) * nx) xb_add(&bar[XB_TOPGEN], 1u);
            else XB_SPIN(xb_ld(&bar[XB_TOPGEN]) == tg, bar);
            __builtin_amdgcn_fence(__ATOMIC_ACQUIRE, "agent");
            xb_add(&bar[XB_XGEN(b.x)], 1u);
            asm volatile("s_waitcnt vmcnt(0)" ::: "memory");
        } else {
            XB_SPIN(xb_ld(&bar[XB_XGEN(b.x)]) == gen, bar);
            __builtin_amdgcn_fence(__ATOMIC_ACQUIRE, "agent");
            asm volatile("s_waitcnt vmcnt(0)" ::: "memory");
        }
    }
    __syncthreads();
}

constexpr int N_PHASES = 16;

__global__ void __launch_bounds__(512, 2) hymba_fwd(Args a) {
    extern __shared__ __attribute__((aligned(16))) unsigned char lds_raw[];
    cg::grid_group grid = cg::this_grid();
    Ctx F;
    F.lds = (LAS unsigned char*)lds_raw;
    F.tid = threadIdx.x; F.lane = F.tid & 63; F.wave = __builtin_amdgcn_readfirstlane(F.tid >> 6); F.G = gridDim.x; F.bid = blockIdx.x;
    float* Y = a.out;
    bf16_t* XN = (bf16_t*)(FWS + WS_XN); bf16_t* PROJ = (bf16_t*)(FWS + WS_PROJ); bf16_t* MIX = (bf16_t*)(FWS + WS_MIX); bf16_t* U = (bf16_t*)(FWS + WS_BIG);
    if (blockIdx.x == 0) for (int i = threadIdx.x; i < XCD_BAR_WORDS; i += 512) ((unsigned*)FWS)[i] = 0u;
    if (threadIdx.x < 4) ((LAS unsigned*)(F.lds + 131072 + 64))[threadIdx.x] = 0u;
    __syncthreads();
    XcdBarrier bar; bar.bar = (unsigned*)FWS; bar.x = 0; bar.st = nullptr; bool census = false;
    for (int ph = a.ph_lo; ph < a.ph_hi; ++ph) {
        if (ph > a.ph_lo && ph != 1) {
            if (!census) { grid.sync();
                bar = xcd_barrier_post((unsigned*)FWS, (volatile LAS unsigned*)(F.lds + 131072 + 64)); census = true; }
            else xcd_barrier(bar);
        }
        { int t_ = threadIdx.x; asm volatile("" : "+v"(t_)); F.tid = t_; F.lane = t_ & 63; F.wave = __builtin_amdgcn_readfirstlane(t_ >> 6); }
        if (ph == 0) {
#ifndef NO_W
#ifdef PROBE_W2
 phase_weights(F, a); __syncthreads(); phase_weights(F, a); __syncthreads();
#endif
 phase_weights(F, a);
#endif
 __syncthreads(); continue; }
        if (ph == 1) { phase_convert(F, a); __syncthreads(); continue; }
        const int l = (ph - 2) / 7, s = (ph - 2) % 7;
        bf16_t* XB = XN; float* SSQ = (float*)(FWS + WS_SSQ); float* HSQ = (float*)(FWS + WS_HSQ) + (size_t)l * MT * 8;
        float* ssq_in = SSQ + (l == 0 ? 0 : 2 * MT);
        float* ssq_mid = SSQ + (l == 0 ? MT : 3 * MT);
        if (s == 0) { pg8::Gemm g{XB, (const bf16_t*)(FWS + WS_WIN) + (size_t)l * NPW * DM, MT, NPW, DM, DM}; pg8::StaticOrder S; S.init(MT, NPW, F.G, F.bid);
            pg8::EpiScale<0, true> E{PROJ, NPJ, ssq_in, 1.0f / DM, EPS, (float*)(FWS + WS_GATES), FIN(10) + l * 4, FIN(11) + l * 4, NPJ / 256};
            pg8::gemm_phase<pg8::EpiScale<0, true>, pg8::StaticOrder, false, true>(F.lds, g, S, E); }
        else if (s == 1) phase_mixers<3>(F, a, l);
        else if (s == 2 || s == 5) {
            pg8::Gemm g;
            if (s == 2) g = pg8::Gemm{MIX, (const bf16_t*)(FWS + WS_WOUT) + (size_t)l * DM * DM, MP, DM, DM, DM};
            else g = pg8::Gemm{U, (const bf16_t*)(FWS + WS_WDN) + (size_t)l * DM * FF, MP, DM, FF, FF};
            pg8::StaticOrder S; S.init(MP, DM, F.G, F.bid);
            if (s == 2) { pg8::EpiResBK E{XB, DM, ssq_mid, HSQ, EPS}; pg8::gemm_phase<pg8::EpiResBK, pg8::StaticOrder, false, true>(F.lds, g, S, E); }
            else if (l == 1) { pg8::EpiResF E{XB, Y, DM}; pg8::gemm_phase<pg8::EpiResF, pg8::StaticOrder, false, true>(F.lds, g, S, E); }
            else { pg8::EpiResB E{XB, DM, SSQ + 2 * MT}; pg8::gemm_phase<pg8::EpiResB, pg8::StaticOrder, false, true>(F.lds, g, S, E); }
            __syncthreads();
            const int kfull = (s == 2) ? DM : FF; pg8::Gemm g2 = g; g2.K = kfull / 16;
            pg8::SplitKOrder S2; S2.init(DM, 16, kfull / 16, MP / 256, F.G, F.bid);
            pg8::EpiPartial E2{(float*)(FWS + WS_PART), DM, kfull / 16, MP, MS};
            pg8::gemm_phase<pg8::EpiPartial, pg8::SplitKOrder, true, true>(F.lds, g2, S2, E2); }
        else if (s == 3) phase_fold(F, a, ssq_mid, nullptr, HSQ);
        else if (s == 4) { pg8::Gemm g{XB, (const bf16_t*)(FWS + WS_WUP) + (size_t)l * FF * DM, MT, FF, DM, DM}; pg8::StaticOrder S; S.init(MT, FF, F.G, F.bid);
            pg8::EpiScale<2, false> E{U, FF, ssq_mid, 1.0f / DM, EPS, nullptr, nullptr, nullptr, -1};
            pg8::gemm_phase<pg8::EpiScale<2, false>, pg8::StaticOrder, false, true>(F.lds, g, S, E); }
        else { if (l == 0) phase_fold(F, a, SSQ + 2 * MT, nullptr, nullptr); else phase_fold(F, a, nullptr, Y, nullptr); }
        __syncthreads();
    }
#ifdef DBG_STOP
    grid.sync();
#ifdef DBG_F32
    { const float* src = (const float*)(FWS + DBG_SRC); const size_t n = (size_t)DBG_F32;
      for (size_t i = (size_t)blockIdx.x * 512 + threadIdx.x; i < n; i += (size_t)gridDim.x * 512) Y[i] = src[i]; }
#else
    { const bf16_t* src = (const bf16_t*)(FWS + DBG_SRC); const size_t n = (size_t)MT * DM;
      for (size_t i = (size_t)blockIdx.x * 512 + threadIdx.x; i < n; i += (size_t)gridDim.x * 512) Y[i] = __builtin_bit_cast(float, (unsigned)src[i] << 16); }
#endif
#endif
}

#ifndef N_LAUNCH_MODE
#define N_LAUNCH_MODE 0
#endif
extern "C" void kernel_launch(void* const* d_in, const int* in_sizes, int n_in, void* d_out, int out_size, void* d_ws, size_t ws_size, hipStream_t stream) {
    static int grid = 0;
    if (grid == 0) {
        if (n_in != 21 || out_size != 80773376 || ws_size < WS_END) { fprintf(stderr, "kernel_launch: unexpected shapes (n_in %d out %d ws %zu need %zu)\n", n_in, out_size, ws_size, (size_t)WS_END); grid = -1; return; }
        int dev = 0, cus = 0, per_cu = 0;
        hipGetDevice(&dev); hipDeviceGetAttribute(&cus, hipDeviceAttributeMultiprocessorCount, dev);
        if (hipFuncSetAttribute((const void*)hymba_fwd, hipFuncAttributeMaxDynamicSharedMemorySize, LDS_BYTES) != hipSuccess) { fprintf(stderr, "kernel_launch: hipFuncSetAttribute failed\n"); grid = -1; return; }
        if (hipOccupancyMaxActiveBlocksPerMultiprocessor(&per_cu, (const void*)hymba_fwd, 512, LDS_BYTES) != hipSuccess || per_cu < 1) { fprintf(stderr, "kernel_launch: occupancy query gave %d\n", per_cu); per_cu = 1; }
        (void)hipGetLastError();
        grid = cus * per_cu;
        fprintf(stderr, "kernel_launch: grid %d (cus %d x %d)\n", grid, cus, per_cu);
    }
    if (grid < 0) return;
#ifdef DBG_MEMSET
    (void)hipMemsetAsync(d_ws, 0, WS_END, stream); (void)hipMemsetAsync(d_out, 0, (size_t)out_size * 4, stream);
#endif
    Args a{};
    for (int i = 0; i < 21; ++i) a.in[i] = (const float*)d_in[i];
    a.out = (float*)d_out; a.ws = (unsigned char*)d_ws;
#if N_LAUNCH_MODE == 0
#ifdef DBG_STOP
    a.ph_lo = 0; a.ph_hi = DBG_STOP;
#else
    a.ph_lo = 0; a.ph_hi = N_PHASES;
#endif
    { void* args[] = {&a}; hipError_t e = hipLaunchCooperativeKernel((const void*)hymba_fwd, dim3(grid), dim3(512), args, LDS_BYTES, stream);
        if (e != hipSuccess) fprintf(stderr, "cooperative launch failed: %s (grid %d)\n", hipGetErrorString(e), grid); }
#else
    for (int p = 0; p < N_PHASES; ++p) { a.ph_lo = p; a.ph_hi = p + 1; void* args[] = {&a};
        hipError_t e = hipLaunchCooperativeKernel((const void*)hymba_fwd, dim3(grid), dim3(512), args, LDS_BYTES, stream);
        if (e != hipSuccess) { fprintf(stderr, "cooperative launch %d failed: %s (grid %d)\n", p, hipGetErrorString(e), grid); break; } }
#endif
}
```

```cpp
#include <hip/hip_runtime.h>
#include <hip/hip_cooperative_groups.h>
#include <cstdio>
#include <cstdint>
namespace cg = cooperative_groups;
namespace pg8 {
#define PG8_LAS __attribute__((address_space(3)))
typedef unsigned short bf16_t;
typedef short bf16x8 __attribute__((ext_vector_type(8)));
typedef float f32x4 __attribute__((ext_vector_type(4)));
typedef unsigned u32x4 __attribute__((ext_vector_type(4)));
constexpr int BM = 256, BK = 64, HALF = 128, HTB = HALF * BK * 2  , STAGE_BYTES = 8 * HTB, NXCD = 8, WGM = 8;

__host__ __device__ __forceinline__ int lds_byte(int r, int c) { const int st = (r >> 4) * 2 + (c >> 5), rr = r & 15, cc = c & 31, ob = rr * 64 + cc * 2; return st * 1024 + (ob ^ (((ob >> 9) & 1) << 5)); }
__host__ __device__ __forceinline__ void stage_rc(int b, int& R, int& C) { const int st = b / 1024, sb = b % 1024, swz = sb ^ (((sb >> 9) & 1) << 5); R = (st >> 1) * 16 + swz / 64; C = (st & 1) * 32 + (swz % 64) / 2; }
__host__ __device__ __forceinline__ int perm32(int rho) { const int n = rho >> 4, i = rho & 15; return 8 * (i >> 2) + 4 * n + (i & 3); }

struct Unit { int pm, pn, ko; };
struct Gemm { const bf16_t* A; const bf16_t* Bt; int M, N, K, ld; };

struct StaticOrder {
    int nM, nN, nwg, G, c;
    __host__ __device__ void init(int M, int N, int G_, int c_) { nM = M / BM; nN = N / BM; nwg = nM * nN; G = G_; c = c_; }
    __host__ __device__ bool next(int i, Unit& u) const {
        const long L = (long)i * G + c; if (L >= nwg) return false;
        int wgid = (int)L; { const int q = nwg / NXCD, r = nwg % NXCD, xcd = wgid % NXCD, off = wgid / NXCD; wgid = (xcd < r ? xcd * (q + 1) : r * (q + 1) + (xcd - r) * q) + off; }
        const int nig = WGM * nN, gid = wgid / nig, fm = gid * WGM, gsz = (nM - fm) < WGM ? (nM - fm) : WGM;
        u.pm = fm + ((wgid % nig) % gsz); u.pn = (wgid % nig) / gsz; u.ko = 0; return true;
    }
    __device__ __forceinline__ void a_ready(const Unit&) const {}
    __device__ __forceinline__ void done(const Unit&) const {}
};

__device__ __forceinline__ unsigned cvt_pk_bf16(float lo, float hi) { unsigned r; asm volatile("v_cvt_pk_bf16_f32 %0, %1, %2" : "=v"(r) : "v"(lo), "v"(hi)); return r; }
typedef unsigned u32x2 __attribute__((ext_vector_type(2)));
template <int ACT> struct EpiBf16 {
    static constexpr bool PERM = true, AFTER_DRAIN = false, KSCALE = false;
    bf16_t* O; int ldc;
    __device__ __forceinline__ void operator()(const f32x4 (&acc)[2][2][4][2], const Unit& u, int wr, int wc, int fr, int fq) const {
        const int row0 = u.pm * BM + wr * 64 + fr; const int col0 = u.pn * BM + wc * 32 + 8 * fq;
#pragma unroll
        for (int ai = 0; ai < 2; ++ai)
#pragma unroll
            for (int m = 0; m < 4; ++m) { bf16_t* rowp = O + (size_t)(row0 + ai * HALF + m * 16) * ldc + col0;
#pragma unroll
                for (int bj = 0; bj < 2; ++bj) { f32x4 v0 = acc[ai][bj][m][0], v1 = acc[ai][bj][m][1];
                    if (ACT == 2) {
#pragma unroll
                        for (int e = 0; e < 4; ++e) { float a = fmaxf(v0[e], 0.f), b = fmaxf(v1[e], 0.f); v0[e] = a * a; v1[e] = b * b; } }
                    u32x4 w; w.x = cvt_pk_bf16(v0[0], v0[1]); w.y = cvt_pk_bf16(v0[2], v0[3]); w.z = cvt_pk_bf16(v1[0], v1[1]); w.w = cvt_pk_bf16(v1[2], v1[3]);
                    *(u32x4*)(rowp + bj * HALF) = w; } }
    }
};
struct EpiRes {
    static constexpr bool PERM = false, AFTER_DRAIN = false, KSCALE = false;
    const float* base_lo; const float* base_hi; float* out; int ldc; int split_pm;
    __device__ __forceinline__ void operator()(const f32x4 (&acc)[2][2][4][2], const Unit& u, int wr, int wc, int fr, int fq) const {
        const float* base = (u.pm < split_pm) ? base_lo : base_hi;
        const int col0 = u.pn * BM + wc * 32 + 4 * fq;
#pragma unroll
        for (int ai = 0; ai < 2; ++ai)
#pragma unroll
            for (int m = 0; m < 4; ++m) { const size_t off = (size_t)(u.pm * BM + ai * HALF + wr * 64 + m * 16 + fr) * ldc + col0;
                f32x4 bs[2][2];
#pragma unroll
                for (int bj = 0; bj < 2; ++bj)
#pragma unroll
                    for (int n = 0; n < 2; ++n) bs[bj][n] = *(const f32x4*)(base + off + bj * HALF + n * 16);
#pragma unroll
                for (int bj = 0; bj < 2; ++bj)
#pragma unroll
                    for (int n = 0; n < 2; ++n) *(f32x4*)(out + off + bj * HALF + n * 16) = bs[bj][n] + acc[ai][bj][m][n];
                asm volatile("" ::: "memory"); }
    }
};

struct SplitKOrder {
    int nN, nsplit, kslice, pm0, G, c;
    __host__ __device__ void init(int N, int nsplit_, int kslice_, int pm0_, int G_, int c_) { nN = N / BM; nsplit = nsplit_; kslice = kslice_; pm0 = pm0_; G = G_; c = c_; }
    __host__ __device__ bool next(int i, Unit& u) const {
        const int L = i * G + c; if (L >= 2 * nN * nsplit) return false;
        const int ks = L % nsplit, t = L / nsplit; u.pn = t % nN; u.pm = pm0 + t / nN; u.ko = ks * kslice; return true; }
    __device__ __forceinline__ void a_ready(const Unit&) const {}
    __device__ __forceinline__ void done(const Unit&) const {}
};
struct EpiPartial {
    static constexpr bool PERM = false, AFTER_DRAIN = false, KSCALE = false;
    float* P; int ldc, kslice, row0, rows;
    __device__ __forceinline__ void operator()(const f32x4 (&acc)[2][2][4][2], const Unit& u, int wr, int wc, int fr, int fq) const {
        const int col0 = u.pn * BM + wc * 32 + 4 * fq; float* base = P + (size_t)(u.ko / kslice) * rows * ldc;
#pragma unroll
        for (int ai = 0; ai < 2; ++ai)
#pragma unroll
            for (int m = 0; m < 4; ++m) { float* p = base + (size_t)(u.pm * BM + ai * HALF + wr * 64 + m * 16 + fr - row0) * ldc + col0;
#pragma unroll
                for (int bj = 0; bj < 2; ++bj)
#pragma unroll
                    for (int n = 0; n < 2; ++n) *(f32x4*)(p + bj * HALF + n * 16) = acc[ai][bj][m][n]; }
    }
};

__device__ __forceinline__ float bf_lo(unsigned w) { return __builtin_bit_cast(float, w << 16); }
__device__ __forceinline__ float bf_hi(unsigned w) { return __builtin_bit_cast(float, w & 0xffff0000u); }
template <int ACT, bool GATES> struct EpiScale {
    static constexpr bool PERM = true, AFTER_DRAIN = false, KSCALE = false;
    bf16_t* O; int ldc; const float* ssq; float inv_k, eps; float* gt; const float* bi; const float* bf; int gate_pn;
    __device__ __forceinline__ void operator()(const f32x4 (&acc)[2][2][4][2], const Unit& u, int wr, int wc, int fr, int fq) const {
        const int row0 = u.pm * BM + wr * 64 + fr; const int col0 = u.pn * BM + wc * 32 + 8 * fq;
        if (GATES && u.pn == gate_pn) {
            if (wc == 0 && fq == 0) { const f32x4 vbi = *(const f32x4*)bi, vbf = *(const f32x4*)bf;
#pragma unroll
                for (int ai = 0; ai < 2; ++ai)
#pragma unroll
                    for (int m = 0; m < 4; ++m) { const int row = row0 + ai * HALF + m * 16; const float r = 1.0f / sqrtf(ssq[row] * inv_k + eps);
                        const f32x4 gi = acc[ai][0][m][0] * r + vbi; const f32x4 z = acc[ai][0][m][1] * r + vbf; f32x4 lf;
#pragma unroll
                        for (int e2 = 0; e2 < 4; ++e2) lf[e2] = fminf(z[e2], 0.f) - log1pf(expf(-fabsf(z[e2])));
                        *(f32x4*)(gt + (size_t)row * 8) = gi; *(f32x4*)(gt + (size_t)row * 8 + 4) = lf; } }
            return; }
        float rr[2][4];
#pragma unroll
        for (int ai = 0; ai < 2; ++ai)
#pragma unroll
            for (int m = 0; m < 4; ++m) rr[ai][m] = ssq[row0 + ai * HALF + m * 16];
        asm volatile("" : "+v"(rr[0][0]), "+v"(rr[0][1]), "+v"(rr[0][2]), "+v"(rr[0][3]), "+v"(rr[1][0]), "+v"(rr[1][1]), "+v"(rr[1][2]), "+v"(rr[1][3]));
#pragma unroll
        for (int ai = 0; ai < 2; ++ai)
#pragma unroll
            for (int m = 0; m < 4; ++m) rr[ai][m] = 1.0f / sqrtf(rr[ai][m] * inv_k + eps);
#pragma unroll
        for (int ai = 0; ai < 2; ++ai)
#pragma unroll
            for (int m = 0; m < 4; ++m) asm volatile("" : "+v"(rr[ai][m]));
#pragma unroll
        for (int ai = 0; ai < 2; ++ai)
#pragma unroll
            for (int m = 0; m < 4; ++m) { const int row = row0 + ai * HALF + m * 16; const float r = rr[ai][m];
                bf16_t* rowp = O + (size_t)row * ldc + col0;
#pragma unroll
                for (int bj = 0; bj < 2; ++bj) { f32x4 v0 = acc[ai][bj][m][0] * r, v1 = acc[ai][bj][m][1] * r;
                    if (ACT == 2) {
#pragma unroll
                        for (int e2 = 0; e2 < 4; ++e2) { float p = fmaxf(v0[e2], 0.f), q = fmaxf(v1[e2], 0.f); v0[e2] = p * p; v1[e2] = q * q; } }
                    u32x4 w; w.x = cvt_pk_bf16(v0[0], v0[1]); w.y = cvt_pk_bf16(v0[2], v0[3]); w.z = cvt_pk_bf16(v1[0], v1[1]); w.w = cvt_pk_bf16(v1[2], v1[3]);
                    *(u32x4*)(rowp + bj * HALF) = w; } }
    }
};
struct EpiResB {
    static constexpr bool PERM = true, AFTER_DRAIN = false, KSCALE = false;
    bf16_t* X; int ldc; float* ssq;
    __device__ __forceinline__ void operator()(const f32x4 (&acc)[2][2][4][2], const Unit& u, int wr, int wc, int fr, int fq) const {
        const int row0 = u.pm * BM + wr * 64 + fr; const int col0 = u.pn * BM + wc * 32 + 8 * fq;
        u32x4 b[2][4][2];
#pragma unroll
        for (int ai = 0; ai < 2; ++ai)
#pragma unroll
            for (int m = 0; m < 4; ++m)
#pragma unroll
                for (int bj = 0; bj < 2; ++bj) b[ai][m][bj] = *(const u32x4*)(X + (size_t)(row0 + ai * HALF + m * 16) * ldc + col0 + bj * HALF);
        __builtin_amdgcn_s_waitcnt(0x0F70); asm volatile("" ::: "memory");
#pragma unroll
        for (int ai = 0; ai < 2; ++ai)
#pragma unroll
            for (int m = 0; m < 4; ++m) { const int row = row0 + ai * HALF + m * 16; bf16_t* rowp = X + (size_t)row * ldc + col0; float q = 0.f;
#pragma unroll
                for (int bj = 0; bj < 2; ++bj) { const u32x4 bb = b[ai][m][bj];
                    const f32x4 v0 = acc[ai][bj][m][0] + (f32x4){bf_lo(bb.x), bf_hi(bb.x), bf_lo(bb.y), bf_hi(bb.y)};
                    const f32x4 v1 = acc[ai][bj][m][1] + (f32x4){bf_lo(bb.z), bf_hi(bb.z), bf_lo(bb.w), bf_hi(bb.w)};
                    q += (v0[0] * v0[0] + v0[1] * v0[1]) + (v0[2] * v0[2] + v0[3] * v0[3]) + (v1[0] * v1[0] + v1[1] * v1[1]) + (v1[2] * v1[2] + v1[3] * v1[3]);
                    u32x4 w; w.x = cvt_pk_bf16(v0[0], v0[1]); w.y = cvt_pk_bf16(v0[2], v0[3]); w.z = cvt_pk_bf16(v1[0], v1[1]); w.w = cvt_pk_bf16(v1[2], v1[3]);
                    *(u32x4*)(rowp + bj * HALF) = w; }
                q += __shfl_xor(q, 16); q += __shfl_xor(q, 32);
                if (fq == 0) unsafeAtomicAdd(ssq + row, q); }
    }
};
struct EpiResF {
    static constexpr bool PERM = true, AFTER_DRAIN = false, KSCALE = false;
    const bf16_t* X; float* Y; int ldc;
    __device__ __forceinline__ void operator()(const f32x4 (&acc)[2][2][4][2], const Unit& u, int wr, int wc, int fr, int fq) const {
        const int row0 = u.pm * BM + wr * 64 + fr; const int col0 = u.pn * BM + wc * 32 + 8 * fq;
        u32x4 b[2][4][2];
#pragma unroll
        for (int ai = 0; ai < 2; ++ai)
#pragma unroll
            for (int m = 0; m < 4; ++m)
#pragma unroll
                for (int bj = 0; bj < 2; ++bj) b[ai][m][bj] = *(const u32x4*)(X + (size_t)(row0 + ai * HALF + m * 16) * ldc + col0 + bj * HALF);
        __builtin_amdgcn_s_waitcnt(0x0F70); asm volatile("" ::: "memory");
#pragma unroll
        for (int ai = 0; ai < 2; ++ai)
#pragma unroll
            for (int m = 0; m < 4; ++m) { const size_t off = (size_t)(row0 + ai * HALF + m * 16) * ldc + col0;
#pragma unroll
                for (int bj = 0; bj < 2; ++bj) { const u32x4 bb = b[ai][m][bj];
                    *(f32x4*)(Y + off + bj * HALF) = acc[ai][bj][m][0] + (f32x4){bf_lo(bb.x), bf_hi(bb.x), bf_lo(bb.y), bf_hi(bb.y)};
                    *(f32x4*)(Y + off + bj * HALF + 4) = acc[ai][bj][m][1] + (f32x4){bf_lo(bb.z), bf_hi(bb.z), bf_lo(bb.w), bf_hi(bb.w)}; } }
    }
};

struct EpiResBK {
    static constexpr bool PERM = true, AFTER_DRAIN = false, KSCALE = true;
    static constexpr int TBL_OFF = 131072 + 256, TBL_BYTES = 256 * 5 * 4;
    bf16_t* X; int ldc; float* ssq; const float* hsq; float eps;
    __device__ __forceinline__ void unit_begin(PG8_LAS unsigned char* lds, const Unit& u, int ui, int tid) const {
        if (tid < 256) { const float* hp = hsq + (size_t)(u.pm * BM + tid) * 8; const f32x4 h4 = *(const f32x4*)hp; const float ha = hp[4];
            const float x0 = h4[0] * (1.0f / 256.0f) + eps, x1 = h4[1] * (1.0f / 256.0f) + eps, x2 = h4[2] * (1.0f / 256.0f) + eps, x3 = h4[3] * (1.0f / 256.0f) + eps, xa = ha * (1.0f / 1024.0f) + eps;
            PG8_LAS float* T = (PG8_LAS float*)(lds + TBL_OFF + (ui & 1) * TBL_BYTES) + tid * 5;
            T[0] = __builtin_sqrtf(x1 * __builtin_amdgcn_rcpf(x0)); T[1] = __builtin_sqrtf(x2 * __builtin_amdgcn_rcpf(x1)); T[2] = __builtin_sqrtf(x3 * __builtin_amdgcn_rcpf(x2));
            T[3] = __builtin_sqrtf(xa * __builtin_amdgcn_rcpf(x3)); T[4] = 1.0f / sqrtf(xa); }
    }
    __device__ __forceinline__ void kscale(f32x4 (&acc)[2][2][4][2], PG8_LAS unsigned char* lds, int ui, int seg, int wr, int fr) const {
        const PG8_LAS float* T = (const PG8_LAS float*)(lds + TBL_OFF + (ui & 1) * TBL_BYTES) + (wr * 64 + fr) * 5 + seg - 1;
#pragma unroll
        for (int ai = 0; ai < 2; ++ai)
#pragma unroll
            for (int m = 0; m < 4; ++m) { const float f = T[(ai * HALF + m * 16) * 5];
#pragma unroll
                for (int bj = 0; bj < 2; ++bj)
#pragma unroll
                    for (int n = 0; n < 2; ++n) acc[ai][bj][m][n] = acc[ai][bj][m][n] * f; }
    }
    __device__ __forceinline__ void epi(const f32x4 (&acc)[2][2][4][2], const Unit& u, PG8_LAS unsigned char* lds, int ui, int wr, int wc, int fr, int fq) const {
        const int row0 = u.pm * BM + wr * 64 + fr; const int col0 = u.pn * BM + wc * 32 + 8 * fq;
        const PG8_LAS float* T = (const PG8_LAS float*)(lds + TBL_OFF + (ui & 1) * TBL_BYTES) + (wr * 64 + fr) * 5 + 4;
        u32x4 b[2][4][2];
#pragma unroll
        for (int ai = 0; ai < 2; ++ai)
#pragma unroll
            for (int m = 0; m < 4; ++m)
#pragma unroll
                for (int bj = 0; bj < 2; ++bj) b[ai][m][bj] = *(const u32x4*)(X + (size_t)(row0 + ai * HALF + m * 16) * ldc + col0 + bj * HALF);
        __builtin_amdgcn_s_waitcnt(0x0F70); asm volatile("" ::: "memory");
#pragma unroll
        for (int ai = 0; ai < 2; ++ai)
#pragma unroll
            for (int m = 0; m < 4; ++m) { const int row = row0 + ai * HALF + m * 16; bf16_t* rowp = X + (size_t)row * ldc + col0; float q = 0.f; const float ra = T[(ai * HALF + m * 16) * 5];
#pragma unroll
                for (int bj = 0; bj < 2; ++bj) { const u32x4 bb = b[ai][m][bj];
                    const f32x4 v0 = acc[ai][bj][m][0] * ra + (f32x4){bf_lo(bb.x), bf_hi(bb.x), bf_lo(bb.y), bf_hi(bb.y)};
                    const f32x4 v1 = acc[ai][bj][m][1] * ra + (f32x4){bf_lo(bb.z), bf_hi(bb.z), bf_lo(bb.w), bf_hi(bb.w)};
                    q += (v0[0] * v0[0] + v0[1] * v0[1]) + (v0[2] * v0[2] + v0[3] * v0[3]) + (v1[0] * v1[0] + v1[1] * v1[1]) + (v1[2] * v1[2] + v1[3] * v1[3]);
                    u32x4 w; w.x = cvt_pk_bf16(v0[0], v0[1]); w.y = cvt_pk_bf16(v0[2], v0[3]); w.z = cvt_pk_bf16(v1[0], v1[1]); w.w = cvt_pk_bf16(v1[2], v1[3]);
                    *(u32x4*)(rowp + bj * HALF) = w; }
                q += __shfl_xor(q, 16); q += __shfl_xor(q, 32);
                if (fq == 0) unsafeAtomicAdd(ssq + row, q); }
    }
};

template <class Epi, class Sched, bool ALIGN_EPI = false, bool SP2 = false>
__device__ __forceinline__ void gemm_phase(PG8_LAS unsigned char* lds, const Gemm g, const Sched& S, const Epi& E) {
    int tid_ = threadIdx.x; asm volatile("" : "+v"(tid_)); const int tid = tid_, wid = __builtin_amdgcn_readfirstlane(tid >> 6), lane = tid & 63, wr = wid >> 2, wc = wid & 3, fr = lane & 15, fq = lane >> 4;
    const int K = g.ld, nt = g.K / BK;
    unsigned voffA[2], voffB[2];
#pragma unroll
    for (int i = 0; i < 2; ++i) { int R, C; stage_rc(tid * 16 + i * 8192, R, C); const int Rb = Epi::PERM ? ((R & ~31) + perm32(R & 31)) : R;
        voffA[i] = (unsigned)(R * K + C) * 2u; voffB[i] = (unsigned)(Rb * K + C) * 2u; }
    const size_t kstep = (size_t)(BK * 2);
    const size_t hstep = (size_t)HALF * K * 2;
    const size_t tstep = 2 * hstep;
    const unsigned ldsw = (unsigned)wid * 1024u;
    const int aoff = lds_byte(wr * 64 + fr, fq * 8), boff = lds_byte(wc * 32 + fr, fq * 8);
#define PG8_SA(b, h) (((b) * 2 + (h)) * HTB)
#define PG8_SB(b, h) ((4 + (b) * 2 + (h)) * HTB)
#define PG8_STAGE(bufoff, gbase, voff) do { _Pragma("unroll") for (int _i = 0; _i < 2; ++_i) \
        __builtin_amdgcn_global_load_lds((const unsigned*)((const char*)(gbase) + (voff)[_i]), (PG8_LAS unsigned*)(lds + (bufoff) + ldsw + _i * 8192), 16, 0, 0); } while (0)
#define PG8_LDA(dst, b, h) do { _Pragma("unroll") for (int m = 0; m < 4; ++m) _Pragma("unroll") for (int k = 0; k < 2; ++k) dst[m][k] = *(const PG8_LAS bf16x8*)(lds + PG8_SA(b, h) + aoff + m * 2048 + k * 1024); } while (0)
#define PG8_LDB(dst, b, h) do { _Pragma("unroll") for (int n = 0; n < 2; ++n) _Pragma("unroll") for (int k = 0; k < 2; ++k) dst[n][k] = *(const PG8_LAS bf16x8*)(lds + PG8_SB(b, h) + boff + n * 2048 + k * 1024); } while (0)
#define PG8_MMA(ai, bj, At, Bt) do { __builtin_amdgcn_s_setprio(1); _Pragma("unroll") for (int m = 0; m < 4; ++m) _Pragma("unroll") for (int n = 0; n < 2; ++n) _Pragma("unroll") for (int k = 0; k < 2; ++k) \
        acc[ai][bj][m][n] = __builtin_amdgcn_mfma_f32_16x16x32_bf16(Bt[n][k], At[m][k], acc[ai][bj][m][n], 0, 0, 0); __builtin_amdgcn_s_setprio(0); } while (0)
#define PG8_WAIT_V(n) asm volatile("s_waitcnt vmcnt(" #n ")" ::: "memory")
#define PG8_WAIT_L(n) asm volatile("s_waitcnt lgkmcnt(" #n ")" ::: "memory")
#define PG8_BAR __builtin_amdgcn_s_barrier()
#define PG8_SCHED __builtin_amdgcn_sched_barrier(0)
    Unit cur, nxt; int ui = 0;
    if (!S.next(0, cur)) return;
    f32x4 acc[2][2][4][2];
#pragma unroll
    for (int a = 0; a < 2; ++a)
#pragma unroll
        for (int b = 0; b < 2; ++b)
#pragma unroll
            for (int m = 0; m < 4; ++m)
#pragma unroll
                for (int n = 0; n < 2; ++n) acc[a][b][m][n] = (f32x4){0.f, 0.f, 0.f, 0.f};
    bf16x8 At[4][2], B0[2][2], B1[2][2];
    const char* cA = (const char*)g.A + (size_t)cur.pm * tstep + (size_t)cur.ko * 2; const char* cB = (const char*)g.Bt + (size_t)cur.pn * tstep + (size_t)cur.ko * 2;
    S.a_ready(cur);
    if constexpr (Epi::KSCALE) E.unit_begin(lds, cur, ui, tid);
    if constexpr (SP2) {
        PG8_STAGE(PG8_SB(0, 0), cB, voffB); PG8_STAGE(PG8_SB(0, 1), cB + hstep, voffB); PG8_STAGE(PG8_SA(0, 0), cA, voffA); PG8_STAGE(PG8_SA(0, 1), cA + hstep, voffA);
        if (wr == 1) PG8_BAR;
        PG8_WAIT_V(2); PG8_BAR;
        PG8_STAGE(PG8_SB(1, 0), cB + kstep, voffB); PG8_STAGE(PG8_SA(1, 0), cA + kstep, voffA); PG8_STAGE(PG8_SB(1, 1), cB + hstep + kstep, voffB);
        PG8_WAIT_V(6); PG8_BAR;
    } else {
        PG8_STAGE(PG8_SB(0, 0), cB, voffB); PG8_STAGE(PG8_SA(0, 0), cA, voffA); PG8_STAGE(PG8_SB(0, 1), cB + hstep, voffB); PG8_STAGE(PG8_SA(0, 1), cA + hstep, voffA);
        if (wr == 1) PG8_BAR;
        PG8_WAIT_V(4); PG8_BAR;
        PG8_STAGE(PG8_SB(1, 0), cB + kstep, voffB); PG8_STAGE(PG8_SA(1, 0), cA + kstep, voffA); PG8_STAGE(PG8_SB(1, 1), cB + hstep + kstep, voffB);
        PG8_WAIT_V(6); PG8_BAR;
    }
    for (;;) {
        const bool has_next = S.next(ui + 1, nxt);
        const char* nA = has_next ? (const char*)g.A + (size_t)nxt.pm * tstep + (size_t)nxt.ko * 2 : cA; const char* nB = has_next ? (const char*)g.Bt + (size_t)nxt.pn * tstep + (size_t)nxt.ko * 2 : cB;
        for (int t = 0; t < nt; t += 2) {
            const bool last = (t == nt - 2);
            if constexpr (Epi::KSCALE) { if (t == 4 || t == 8 || t == 12 || t == 16) E.kscale(acc, lds, ui, t >> 2, wr, fr); }
            const char* a1 = cA + (size_t)(t + 1) * kstep;
            const char* a2 = last ? nA : cA + (size_t)(t + 2) * kstep; const char* b2 = last ? nB : cB + (size_t)(t + 2) * kstep;
            const char* a3 = a2 + kstep; const char* b3 = b2 + kstep;
            if (last && has_next) S.a_ready(nxt);
            if constexpr (SP2) {
            PG8_LDB(B0, 0, 0); PG8_LDB(B1, 0, 1); PG8_SCHED; PG8_LDA(At, 0, 0); PG8_STAGE(PG8_SA(1, 1), a1 + hstep, voffA);
            PG8_WAIT_V(8); PG8_WAIT_L(0); PG8_BAR; PG8_MMA(0, 0, At, B0); PG8_MMA(0, 1, At, B1); PG8_BAR; PG8_SCHED;
            PG8_LDA(At, 0, 1); PG8_STAGE(PG8_SB(0, 0), b2, voffB); PG8_STAGE(PG8_SB(0, 1), b2 + hstep, voffB); PG8_STAGE(PG8_SA(0, 0), a2, voffA);
            PG8_WAIT_V(8); PG8_WAIT_L(0); PG8_BAR; PG8_MMA(1, 0, At, B0); PG8_MMA(1, 1, At, B1); PG8_BAR; PG8_SCHED;
            PG8_LDB(B0, 1, 0); PG8_LDB(B1, 1, 1); PG8_SCHED; PG8_LDA(At, 1, 0); PG8_STAGE(PG8_SA(0, 1), a2 + hstep, voffA);
            PG8_WAIT_V(8); PG8_WAIT_L(0); PG8_BAR; PG8_MMA(0, 0, At, B0); PG8_MMA(0, 1, At, B1); PG8_BAR; PG8_SCHED;
            PG8_LDA(At, 1, 1); PG8_STAGE(PG8_SB(1, 0), b3, voffB); PG8_STAGE(PG8_SB(1, 1), b3 + hstep, voffB); PG8_STAGE(PG8_SA(1, 0), a3, voffA);
            PG8_WAIT_V(8); PG8_WAIT_L(0); PG8_BAR; PG8_MMA(1, 0, At, B0); PG8_MMA(1, 1, At, B1); PG8_BAR; PG8_SCHED;
            } else {
            PG8_LDB(B0, 0, 0); PG8_SCHED; PG8_LDA(At, 0, 0); PG8_STAGE(PG8_SA(1, 1), a1 + hstep, voffA);
            PG8_WAIT_L(8); PG8_BAR; PG8_WAIT_L(0); PG8_MMA(0, 0, At, B0); PG8_BAR; PG8_SCHED;
            PG8_LDB(B1, 0, 1); PG8_STAGE(PG8_SB(0, 0), b2, voffB);
            PG8_BAR; PG8_WAIT_L(0); PG8_MMA(0, 1, At, B1); PG8_BAR;
            PG8_LDA(At, 0, 1); PG8_STAGE(PG8_SA(0, 0), a2, voffA);
            PG8_BAR; PG8_WAIT_L(0); PG8_MMA(1, 0, At, B0); PG8_BAR; PG8_SCHED;
            PG8_STAGE(PG8_SB(0, 1), b2 + hstep, voffB);
            PG8_WAIT_V(6); PG8_BAR; PG8_MMA(1, 1, At, B1); PG8_BAR;
            PG8_LDB(B0, 1, 0); PG8_SCHED; PG8_LDA(At, 1, 0); PG8_STAGE(PG8_SA(0, 1), a2 + hstep, voffA);
            PG8_WAIT_L(8); PG8_BAR; PG8_WAIT_L(0); PG8_MMA(0, 0, At, B0); PG8_BAR; PG8_SCHED;
            PG8_LDB(B1, 1, 1); PG8_STAGE(PG8_SB(1, 0), b3, voffB);
            PG8_BAR; PG8_WAIT_L(0); PG8_MMA(0, 1, At, B1); PG8_BAR;
            PG8_LDA(At, 1, 1); PG8_STAGE(PG8_SA(1, 0), a3, voffA);
            PG8_BAR; PG8_WAIT_L(0); PG8_MMA(1, 0, At, B0); PG8_BAR; PG8_SCHED;
            PG8_STAGE(PG8_SB(1, 1), b3 + hstep, voffB);
            PG8_WAIT_V(6); PG8_BAR; PG8_MMA(1, 1, At, B1); PG8_BAR;
            }
        }
        if constexpr (ALIGN_EPI) { if (wr == 0) PG8_BAR; }
        if constexpr (Epi::KSCALE) { E.epi(acc, cur, lds, ui, wr, wc, fr, fq); S.done(cur); } else
        if constexpr (!Epi::AFTER_DRAIN) { E(acc, cur, wr, wc, fr, fq); S.done(cur); }
        if (!has_next) break;
#pragma unroll
        for (int a = 0; a < 2; ++a)
#pragma unroll
            for (int b = 0; b < 2; ++b)
#pragma unroll
                for (int m = 0; m < 4; ++m)
#pragma unroll
                    for (int n = 0; n < 2; ++n) acc[a][b][m][n] = (f32x4){0.f, 0.f, 0.f, 0.f};
        cur = nxt; cA = nA; cB = nB; ++ui;
        if constexpr (Epi::KSCALE) E.unit_begin(lds, cur, ui, tid);
        if constexpr (ALIGN_EPI) { if (wr == 1) PG8_BAR; }
    }
    PG8_WAIT_V(0);
    if constexpr (!ALIGN_EPI) { if (wr == 0) PG8_BAR; }
    PG8_BAR;
    if constexpr (Epi::AFTER_DRAIN) { E.fused(acc, cur, wr, wc, fr, fq, lds, wid, lane); S.done(cur); }
#undef PG8_SA
#undef PG8_SB
#undef PG8_STAGE
#undef PG8_LDA
#undef PG8_LDB
#undef PG8_MMA
#undef PG8_WAIT_V
#undef PG8_WAIT_L
#undef PG8_BAR
#undef PG8_SCHED
}
}
#define LAS __attribute__((address_space(3)))
typedef unsigned short bf16_t;
typedef short bf16x8 __attribute__((ext_vector_type(8)));
typedef float f32x4 __attribute__((ext_vector_type(4)));
typedef unsigned u32x4 __attribute__((ext_vector_type(4)));
typedef unsigned u32x2 __attribute__((ext_vector_type(2)));

constexpr int DM = 2048, NB = 16, SEQ = 2048, SB = 16, SL = 32, FF = 8192;
constexpr int MP = NB * SEQ;
constexpr int MS = SB * SL;
constexpr int MT = MP + MS;
constexpr int DIN = 4616, NPJ = 4608, NPW = 4864;
constexpr int DIN_UNUSED = 0;
constexpr int PJ_MQ = 0, PJ_MK = 512, PJ_MV = 1024, PJ_MO = 2048, PJ_AQ = 3072, PJ_AK = 4096, PJ_AV = 4352;
constexpr float EPS = 1e-6f;
constexpr size_t O_YP = 0, O_YS = 67108864, O_PCK = 68157440, O_PCV = 69206016, O_PC = 70254592, O_PN = 74448896, O_PM = 74465280,
                 O_SCK = 74465408, O_SCV = 75513984, O_SC = 76562560, O_SN = 80756864, O_SM = 80773248;
constexpr size_t MiB = 1u << 20;
constexpr size_t WS_WIN = 1 * MiB;
constexpr size_t WS_SSQ = 64 * 1024;
constexpr size_t WS_WOUT = WS_WIN + 38 * MiB;
constexpr size_t WS_WUP = WS_WOUT + 16 * MiB;
constexpr size_t WS_WDN = WS_WUP + 64 * MiB;
constexpr size_t WS_XN = WS_WDN + 64 * MiB;
constexpr size_t WS_GATES = WS_XN + 130 * MiB;
constexpr size_t WS_BIG = WS_GATES + 2 * MiB;
constexpr size_t WS_PROJ = WS_BIG, WS_MIX = WS_BIG + 293 * MiB;
constexpr size_t WS_PART = WS_BIG + 520 * MiB;
constexpr size_t WS_HSQ = WS_PART + 64 * MiB;
constexpr size_t WS_END = WS_HSQ + 3 * MiB;
constexpr int LDS_BYTES = 147456;

__device__ __forceinline__ unsigned f2bf(float f) { unsigned u = __builtin_bit_cast(unsigned, f); return (u + 0x7fffu + ((u >> 16) & 1u)) >> 16; }
__device__ __forceinline__ float bflo(unsigned w) { return __builtin_bit_cast(float, w << 16); }
__device__ __forceinline__ float bfhi(unsigned w) { return __builtin_bit_cast(float, w & 0xffff0000u); }
typedef float f32x2_t __attribute__((ext_vector_type(2)));
typedef __bf16 bf16x2_t __attribute__((ext_vector_type(2)));
__device__ __forceinline__ unsigned pkbf(float lo, float hi) { unsigned r; asm volatile("v_cvt_pk_bf16_f32 %0, %1, %2" : "=v"(r) : "v"(lo), "v"(hi)); return r; }
__device__ __forceinline__ unsigned pkbf_mfma(float lo, float hi) { const f32x2_t v = {lo, hi}; const bf16x2_t b = __builtin_convertvector(v, bf16x2_t); return __builtin_bit_cast(unsigned, b); }
__device__ __forceinline__ void unpack8(const u32x4 w, float (&f)[8]) { f[0] = bflo(w.x); f[1] = bfhi(w.x); f[2] = bflo(w.y); f[3] = bfhi(w.y); f[4] = bflo(w.z); f[5] = bfhi(w.z); f[6] = bflo(w.w); f[7] = bfhi(w.w); }
__device__ __forceinline__ float wave_sum(float v) {
#pragma unroll
    for (int o = 1; o < 64; o <<= 1) v += __shfl_xor(v, o);
    return v;
}
#define LDS_WAIT() asm volatile("s_waitcnt lgkmcnt(0)" ::: "memory")
#define MFMA16(a, b, c) __builtin_amdgcn_mfma_f32_16x16x32_bf16((a), (b), (c), 0, 0, 0)

struct Args { const float* in[21]; float* out; unsigned char* ws; int ph_lo, ph_hi; };
struct Ctx {
    LAS unsigned char* lds;
    int tid, lane, wave, G, bid;
};
#define FIN(i) (a.in[i])
#define FOUT (a.out)
#define FWS (a.ws)

__device__ __forceinline__ void transpose_item(const float* W, int ldw, int c0, int nvalid, int k0, bf16_t* WT, int Kdst, int r0, float scale, const float* gk, LAS float* scr, int lane) {
#pragma unroll 8
    for (int i = 0; i < 32; ++i) { const int kk = 2 * i + (lane >> 5); scr[kk * 33 + (lane & 31)] = ((lane & 31) < nvalid) ? W[(size_t)(k0 + kk) * ldw + c0 + (lane & 31)] : 0.f; }
    LDS_WAIT(); asm volatile("" ::: "memory");
    const int c = lane & 7;
    float sk[8];
#pragma unroll
    for (int e = 0; e < 8; ++e) sk[e] = gk ? scale * gk[k0 + 8 * c + e] : scale;
#pragma unroll
    for (int j = 0; j < 4; ++j) { const int n = (lane >> 3) + 8 * j; const LAS float* s = scr + (8 * c) * 33 + n;
        u32x4 o; o.x = pkbf(s[0 * 33] * sk[0], s[1 * 33] * sk[1]); o.y = pkbf(s[2 * 33] * sk[2], s[3 * 33] * sk[3]); o.z = pkbf(s[4 * 33] * sk[4], s[5 * 33] * sk[5]); o.w = pkbf(s[6 * 33] * sk[6], s[7 * 33] * sk[7]);
        *(u32x4*)(WT + (size_t)(r0 + n) * Kdst + k0 + 8 * c) = o; }
    LDS_WAIT(); asm volatile("" ::: "memory");
}
__device__ __forceinline__ void phase_weights(Ctx& F, const Args& a) {
    LAS float* scr = (LAS float*)(F.lds + F.wave * 16384);
    const int gw = F.bid * 8 + F.wave, NGW = F.G * 8;
    constexpr int I_IN = 32 * 152, I_OUT = 32 * 64, I_UP = 32 * 256, I_DN = 128 * 64, I_L = I_IN + I_OUT + I_UP + I_DN;
    for (int it = gw; it < 2 * I_L; it += NGW) {
        const int l = it / I_L; int r = it % I_L;
        if (r < I_IN) { const int kb = r / 152, nb = r % 152, n0 = nb * 32;
            const int c0 = n0 < 3072 ? n0 : (n0 < 4608 ? n0 + 8 : 3072); const int nvalid = n0 < 4608 ? 32 : (n0 == 4608 ? 8 : 0);
            const float sc = (n0 >= PJ_MK && n0 < PJ_MV) ? 0.08838834764831845f : 1.0f;
            transpose_item(FIN(9) + (size_t)l * DM * DIN, DIN, c0, nvalid, kb * 64, (bf16_t*)(FWS + WS_WIN) + (size_t)l * NPW * DM, DM, n0, sc, FIN(8) + l * DM, scr, F.lane); continue; }
        r -= I_IN;
        if (r < I_OUT) { const int kb = r / 64, nb = r % 64;
            transpose_item(FIN(17) + (size_t)l * DM * DM, DM, nb * 32, 32, kb * 64, (bf16_t*)(FWS + WS_WOUT) + (size_t)l * DM * DM, DM, nb * 32, 1.0f, nullptr, scr, F.lane); continue; }
        r -= I_OUT;
        if (r < I_UP) { const int kb = r / 256, nb = r % 256;
            transpose_item(FIN(19) + (size_t)l * DM * FF, FF, nb * 32, 32, kb * 64, (bf16_t*)(FWS + WS_WUP) + (size_t)l * FF * DM, DM, nb * 32, 1.0f, FIN(18) + l * DM, scr, F.lane); continue; }
        r -= I_UP;
        { const int kb = r / 64, nb = r % 64;
            transpose_item(FIN(20) + (size_t)l * FF * DM, DM, nb * 32, 32, kb * 64, (bf16_t*)(FWS + WS_WDN) + (size_t)l * DM * FF, FF, nb * 32, 1.0f, nullptr, scr, F.lane); }
    }
}

__device__ __forceinline__ void phase_convert(Ctx& F, const Args& a) {
    bf16_t* XB = (bf16_t*)(FWS + WS_XN); float* SSQ = (float*)(FWS + WS_SSQ);
    const float* xlo = FIN(0); const float* xhi = FIN(1) - (size_t)MP * DM;
    const int gw = F.bid * 8 + F.wave, NGW = F.G * 8;
    f32x4 v[8], vn[8];
    if (gw < MT) { const float* xr = (gw < MP ? xlo : xhi) + (size_t)gw * DM + 4 * F.lane;
#pragma unroll
        for (int j = 0; j < 8; ++j) v[j] = *(const f32x4*)(xr + 256 * j); }
    for (int m = gw; m < MT; m += NGW) {
        const int mn = m + NGW;
        if (mn < MT) { const float* xr = (mn < MP ? xlo : xhi) + (size_t)mn * DM + 4 * F.lane;
#pragma unroll
            for (int j = 0; j < 8; ++j) vn[j] = *(const f32x4*)(xr + 256 * j); }
        float ss = 0.f; bf16_t* orow = XB + (size_t)m * DM + 4 * F.lane;
#pragma unroll
        for (int j = 0; j < 8; ++j) { ss += (v[j].x * v[j].x + v[j].y * v[j].y) + (v[j].z * v[j].z + v[j].w * v[j].w);
            u32x2 w; w.x = pkbf(v[j].x, v[j].y); w.y = pkbf(v[j].z, v[j].w); *(u32x2*)(orow + 256 * j) = w; }
        ss = wave_sum(ss);
        if (F.lane == 0) { SSQ[m] = ss; SSQ[MT + m] = 0.f; SSQ[2 * MT + m] = 0.f; SSQ[3 * MT + m] = 0.f; }
        if (F.lane < 16) ((float*)(FWS + WS_HSQ))[(size_t)(F.lane >> 3) * MT * 8 + (size_t)m * 8 + (F.lane & 7)] = 0.f;
#pragma unroll
        for (int j = 0; j < 8; ++j) v[j] = vn[j];
    }
}
__device__ __forceinline__ void phase_fold(Ctx& F, const Args& a, float* ssq, float* yout, const float* hsq) {
    bf16_t* XB = (bf16_t*)(FWS + WS_XN); const float* part = (const float*)(FWS + WS_PART);
    for (int m = MP + F.bid * 8 + F.wave; m < MT; m += F.G * 8) {
        bf16_t* xr = XB + (size_t)m * DM; f32x4 v[8];
#pragma unroll
        for (int j = 0; j < 4; ++j) { const u32x4 b = *(const u32x4*)(xr + (F.lane + 64 * j) * 8); float f[8]; unpack8(b, f);
            v[2 * j] = (f32x4){f[0], f[1], f[2], f[3]}; v[2 * j + 1] = (f32x4){f[4], f[5], f[6], f[7]}; }
        for (int k = 0; k < 16; ++k) { const float* pp = part + ((size_t)k * MS + (m - MP)) * DM;
            float sc = 1.0f;
            if (hsq) { const int sg = k < 8 ? (k >> 1) : 4; sc = 1.0f / sqrtf(hsq[(size_t)m * 8 + sg] * (sg < 4 ? (1.0f / 256.0f) : (1.0f / 1024.0f)) + EPS); }
#pragma unroll
            for (int j = 0; j < 4; ++j) { v[2 * j] += *(const f32x4*)(pp + (F.lane + 64 * j) * 8) * sc; v[2 * j + 1] += *(const f32x4*)(pp + (F.lane + 64 * j) * 8 + 4) * sc; } }
        if (yout) {
#pragma unroll
            for (int j = 0; j < 4; ++j) { *(f32x4*)(yout + (size_t)m * DM + (F.lane + 64 * j) * 8) = v[2 * j]; *(f32x4*)(yout + (size_t)m * DM + (F.lane + 64 * j) * 8 + 4) = v[2 * j + 1]; }
        } else { float ss = 0.f;
#pragma unroll
            for (int j = 0; j < 4; ++j) { const f32x4 p = v[2 * j], q = v[2 * j + 1];
                ss += (p.x * p.x + p.y * p.y) + (p.z * p.z + p.w * p.w) + (q.x * q.x + q.y * q.y) + (q.z * q.z + q.w * q.w);
                u32x4 w; w.x = pkbf(p.x, p.y); w.y = pkbf(p.z, p.w); w.z = pkbf(q.x, q.y); w.w = pkbf(q.z, q.w); *(u32x4*)(xr + (F.lane + 64 * j) * 8) = w; }
            ss = wave_sum(ss); if (F.lane == 0) ssq[m] = ss; }
    }
}

template <bool GATES>
__device__ __forceinline__ void phase_norm(Ctx& F, const Args& a, const float* xlo, const float* xhi  , const float* gvec, int l, float* ycopy, const float* part) {
    bf16_t* XN = (bf16_t*)(FWS + WS_XN);
    float* GT = (float*)(FWS + WS_GATES);
    LAS f32x4* WG = (LAS f32x4*)F.lds;
    if (GATES) {
        const float* win = FIN(9) + (size_t)l * DM * DIN;
        for (int k = F.tid; k < DM; k += 512) { const int j = k >> 8, ln = (k & 255) >> 2, e = k & 3;
            const f32x4 wa = *(const f32x4*)(win + (size_t)k * DIN + 3072), wb = *(const f32x4*)(win + (size_t)k * DIN + 3076);
            WG[((j * 4 + e) * 2 + 0) * 64 + ln] = wa; WG[((j * 4 + e) * 2 + 1) * 64 + ln] = wb; }
        __syncthreads();
    }
    f32x4 gv[8];
#pragma unroll
    for (int j = 0; j < 8; ++j) gv[j] = *(const f32x4*)(gvec + 4 * F.lane + 256 * j);
    float bi[4], bfv[4];
    if (GATES) {
#pragma unroll
        for (int h = 0; h < 4; ++h) { bi[h] = FIN(10)[l * 4 + h]; bfv[h] = FIN(11)[l * 4 + h]; } }
    const int gw = F.bid * 8 + F.wave, NGW = F.G * 8;
    f32x4 v[8], vn[8];
    if (gw < MT) { const float* xr = (gw < MP ? xlo : xhi) + (size_t)gw * DM + 4 * F.lane;
#pragma unroll
        for (int j = 0; j < 8; ++j) v[j] = *(const f32x4*)(xr + 256 * j); }
    for (int m = gw; m < MT; m += NGW) {
        const int mn = m + NGW;
        if (mn < MT) { const float* xr = (mn < MP ? xlo : xhi) + (size_t)mn * DM + 4 * F.lane;
#pragma unroll
            for (int j = 0; j < 8; ++j) vn[j] = *(const f32x4*)(xr + 256 * j); }
        float ss = 0.f;
        if (part && m >= MP) {
            for (int k = 0; k < 16; ++k) { const float* pp = part + ((size_t)k * MS + (m - MP)) * DM + 4 * F.lane;
#pragma unroll
                for (int j = 0; j < 8; ++j) v[j] += *(const f32x4*)(pp + 256 * j); }
#pragma unroll
            for (int j = 0; j < 8; ++j) *(f32x4*)(ycopy + (size_t)m * DM + 4 * F.lane + 256 * j) = v[j];
        }
#pragma unroll
        for (int j = 0; j < 8; ++j) ss += (v[j].x * v[j].x + v[j].y * v[j].y) + (v[j].z * v[j].z + v[j].w * v[j].w);
        const float rstd = 1.0f / sqrtf(wave_sum(ss) * (1.0f / DM) + EPS);
        if (!part && ycopy && m >= MP) {
#pragma unroll
            for (int j = 0; j < 8; ++j) *(f32x4*)(ycopy + (size_t)m * DM + 4 * F.lane + 256 * j) = v[j]; }
        bf16_t* orow = XN + (size_t)m * DM + 4 * F.lane;
        float ga[8];
#pragma unroll
        for (int q = 0; q < 8; ++q) ga[q] = 0.f;
#pragma unroll
        for (int j = 0; j < 8; ++j) { const f32x4 hv = v[j] * rstd * gv[j];
            u32x2 w; w.x = pkbf(hv.x, hv.y); w.y = pkbf(hv.z, hv.w); *(u32x2*)(orow + 256 * j) = w;
            if (GATES) {
#pragma unroll
                for (int e = 0; e < 4; ++e) { const f32x4 wa = WG[((j * 4 + e) * 2 + 0) * 64 + F.lane], wb = WG[((j * 4 + e) * 2 + 1) * 64 + F.lane]; const float hx = hv[e];
                    ga[0] += hx * wa.x; ga[1] += hx * wa.y; ga[2] += hx * wa.z; ga[3] += hx * wa.w; ga[4] += hx * wb.x; ga[5] += hx * wb.y; ga[6] += hx * wb.z; ga[7] += hx * wb.w; } } }
        if (GATES) {
#pragma unroll
            for (int q = 0; q < 8; ++q) ga[q] = wave_sum(ga[q]);
            if (F.lane == 0) { f32x4 o0, o1;
#pragma unroll
                for (int h = 0; h < 4; ++h) { o0[h] = ga[h] + bi[h]; const float z = ga[4 + h] + bfv[h]; o1[h] = fminf(z, 0.f) - log1pf(expf(-fabsf(z))); }
                *(f32x4*)(GT + (size_t)m * 8) = o0; *(f32x4*)(GT + (size_t)m * 8 + 4) = o1; } }
#pragma unroll
        for (int j = 0; j < 8; ++j) v[j] = vn[j];
    }
    if (GATES) __syncthreads();
}

namespace ml {
constexpr int QS = 272, TS = 144;
constexpr int OFF_Q = 0, OFF_K = 17408, OFF_CB = 34816, OFF_KT = 52224  , OFF_VT = 89088  , OFF_W = 107520, OFF_SC = 116736  ,
              OFF_DEN = 118784, OFF_NQ = 119296, OFF_N = 119552;
}
struct MReg { u32x4 q[2], k[2], v; u32x2 mo[2]; float ig, lf; };
__device__ __forceinline__ void ml_load(MReg& R, const bf16_t* PROJ, const float* GT, int row0, int nvalid, int h, int vs, int tid, int lane, int w) {
    const u32x4 z = {0u, 0u, 0u, 0u};
#pragma unroll
    for (int j = 0; j < 2; ++j) { const int r = (tid >> 4) + 32 * j; R.q[j] = (r < nvalid) ? *(const u32x4*)(PROJ + (size_t)(row0 + r) * NPJ + PJ_MQ + h * 128 + (tid & 15) * 8) : z; }
    const bool ok = lane < nvalid; const size_t rb = (size_t)(row0 + lane) * NPJ;
#pragma unroll
    for (int j = 0; j < 2; ++j) R.k[j] = ok ? *(const u32x4*)(PROJ + rb + PJ_MK + h * 128 + (w + 8 * j) * 8) : z;
    R.v = ok ? *(const u32x4*)(PROJ + rb + PJ_MV + h * 256 + vs * 64 + w * 8) : z;
    R.ig = ok ? GT[(size_t)(row0 + lane) * 8 + h] : -1e30f; R.lf = ok ? GT[(size_t)(row0 + lane) * 8 + 4 + h] : 0.f;
    { const int t = (w >> 1) * 16 + (lane & 15);
#pragma unroll
        for (int j = 0; j < 2; ++j) R.mo[j] = (t < nvalid) ? *(const u32x2*)(PROJ + (size_t)(row0 + t) * NPJ + PJ_MO + h * 256 + vs * 64 + ((w & 1) * 2 + j) * 16 + 4 * (lane >> 4)) : (u32x2){0u, 0u}; }
}
__device__ __forceinline__ float ml_stage(const MReg& R, LAS unsigned char* lds, int buf, float& m_prev, int tid, int lane, int w) {
    using namespace ml;
    float b = R.lf;
#pragma unroll
    for (int o = 1; o < 64; o <<= 1) { const float t = __shfl_up(b, o); if (lane >= o) b += t; }
    const float a = R.ig - b; float pm = a;
#pragma unroll
    for (int o = 1; o < 64; o <<= 1) { const float t = __shfl_up(pm, o); if (lane >= o) pm = fmaxf(pm, t); }
    const float M = fmaxf(m_prev, pm), M63 = __shfl(M, 63), b63 = __shfl(b, 63);
    const float wk = __expf(a - M63), decay = __expf(m_prev - M63), gt = __expf(m_prev - M), emt = __expf(-(b + M));
    if (w == 0) { LAS float* sc = (LAS float*)(lds + OFF_SC) + buf * 256; sc[lane] = a; sc[64 + lane] = M; sc[128 + lane] = gt; sc[192 + lane] = emt; }
    m_prev = b63 + M63;
#pragma unroll
    for (int j = 0; j < 2; ++j) *(LAS u32x4*)(lds + OFF_Q + ((tid >> 4) + 32 * j) * QS + (tid & 15) * 16) = R.q[j];
#pragma unroll
    for (int j = 0; j < 2; ++j) { *(LAS u32x4*)(lds + OFF_K + lane * QS + (w + 8 * j) * 16) = R.k[j];
        float f[8]; unpack8(R.k[j], f);
#pragma unroll
        for (int e = 0; e < 8; ++e) *(LAS bf16_t*)(lds + OFF_KT + buf * 18432 + ((w + 8 * j) * 8 + e) * TS + lane * 2) = (bf16_t)f2bf(f[e] * wk); }
    { const unsigned vw[4] = {R.v.x, R.v.y, R.v.z, R.v.w};
#pragma unroll
        for (int e = 0; e < 8; ++e) *(LAS bf16_t*)(lds + OFF_VT + buf * 9216 + (w * 8 + e) * TS + lane * 2) = (bf16_t)((e & 1) ? (vw[e >> 1] >> 16) : (vw[e >> 1] & 0xffffu)); }
    return decay;
}
__device__ __forceinline__ void mlstm_chain(Ctx& F, const Args& a, const float* C0, const float* n0, const float* m0, float* Cout, float* nout, float* mout,
                                            int row0, int nchunks, int nvalid, int h, int vs, float* hsq, const float* gmo) {
    using namespace ml;
    LAS unsigned char* lds = F.lds;
    const bf16_t* PROJ = (const bf16_t*)(FWS + WS_PROJ); const float* GT = (const float*)(FWS + WS_GATES); bf16_t* MIX = (bf16_t*)(FWS + WS_MIX);
    const int tid = F.tid, lane = F.lane, w = F.wave, c16 = lane & 15, g = lane >> 4, tt = w >> 1, half = w & 1;
    __syncthreads();
    f32x4 accC[4];
#pragma unroll
    for (int vt = 0; vt < 4; ++vt) { accC[vt] = C0 ? *(const f32x4*)(C0 + (size_t)(vs * 64 + vt * 16 + c16) * 128 + 16 * w + 4 * g) : (f32x4){0.f, 0.f, 0.f, 0.f};
        u32x2 o; o.x = pkbf(accC[vt][0], accC[vt][1]); o.y = pkbf(accC[vt][2], accC[vt][3]); *(LAS u32x2*)(lds + OFF_CB + (vt * 16 + c16) * QS + (16 * w + 4 * g) * 2) = o; }
    if (tid < 128) ((LAS float*)(lds + OFF_N))[tid] = n0 ? n0[tid] : 0.f;
    float m_prev = m0 ? m0[0] : 0.f;
    f32x4 gmv[2];
#pragma unroll
    for (int j = 0; j < 2; ++j) gmv[j] = *(const f32x4*)(gmo + h * 256 + vs * 64 + ((w & 1) * 2 + j) * 16 + 4 * (lane >> 4));
    MReg RA, RB; ml_load(RA, PROJ, GT, row0, nvalid, h, vs, tid, lane, w);
    if (nchunks > 1) ml_load(RB, PROJ, GT, row0 + 64, nvalid, h, vs, tid, lane, w);
    float decay = ml_stage(RA, lds, 0, m_prev, tid, lane, w);
    u32x2 mocur[2] = {RA.mo[0], RA.mo[1]};
    if (nchunks > 2) ml_load(RA, PROJ, GT, row0 + 128, nvalid, h, vs, tid, lane, w);
    auto step = [&](const int c, MReg& R) __attribute__((always_inline)) {
        const int buf = c & 1; const int rbase = row0 + c * 64;
        __syncthreads();
        const LAS float* sc = (const LAS float*)(lds + OFF_SC) + buf * 256;
        bf16x8 qf[4];
#pragma unroll
        for (int ks = 0; ks < 4; ++ks) qf[ks] = *(const LAS bf16x8*)(lds + OFF_Q + (tt * 16 + c16) * QS + (g * 8 + 32 * ks) * 2);
        const int t = tt * 16 + c16; const float Mt = sc[64 + t];
        float dsum = 0.f;
#pragma unroll
        for (int j = 0; j < 2; ++j) { const int st = half * 2 + j; f32x4 wv = {0.f, 0.f, 0.f, 0.f};
            if (st <= tt) { f32x4 acc = {0.f, 0.f, 0.f, 0.f};
#pragma unroll
                for (int ks = 0; ks < 4; ++ks) { const bf16x8 kf = *(const LAS bf16x8*)(lds + OFF_K + (st * 16 + c16) * QS + (g * 8 + 32 * ks) * 2); acc = MFMA16(kf, qf[ks], acc); }
                const f32x4 as = *(const LAS f32x4*)(sc + st * 16 + 4 * g);
#pragma unroll
                for (int r = 0; r < 4; ++r) { const int s = st * 16 + 4 * g + r; wv[r] = (s <= t) ? __expf(as[r] - Mt) * acc[r] : 0.f; } }
            dsum += (wv[0] + wv[1]) + (wv[2] + wv[3]);
            u32x2 o; o.x = pkbf(wv[0], wv[1]); o.y = pkbf(wv[2], wv[3]); *(LAS u32x2*)(lds + OFF_W + t * TS + (st * 16 + 4 * g) * 2) = o; }
        dsum += __shfl_xor(dsum, 16); dsum += __shfl_xor(dsum, 32);
        if (g == 0) ((LAS float*)(lds + OFF_DEN))[t * 2 + half] = dsum;
        f32x4 acc2[2];
#pragma unroll
        for (int j = 0; j < 2; ++j) { const int vt = half * 2 + j; acc2[j] = (f32x4){0.f, 0.f, 0.f, 0.f};
#pragma unroll
            for (int ks = 0; ks < 4; ++ks) { const bf16x8 cf = *(const LAS bf16x8*)(lds + OFF_CB + (vt * 16 + c16) * QS + (g * 8 + 32 * ks) * 2); acc2[j] = MFMA16(cf, qf[ks], acc2[j]); } }
        { const int tq = tid >> 3, part = tid & 7; float s = 0.f;
#pragma unroll
            for (int i = 0; i < 2; ++i) { const u32x4 qq = *(const LAS u32x4*)(lds + OFF_Q + tq * QS + (part * 16 + i * 8) * 2); float f[8]; unpack8(qq, f);
                const LAS float* nn = (const LAS float*)(lds + OFF_N) + part * 16 + i * 8;
#pragma unroll
                for (int e = 0; e < 8; ++e) s += f[e] * nn[e]; }
            s += __shfl_xor(s, 1); s += __shfl_xor(s, 2); s += __shfl_xor(s, 4);
            if (part == 0) ((LAS float*)(lds + OFF_NQ))[tq] = s; }
        __syncthreads();
        bf16x8 wf[2];
#pragma unroll
        for (int ks = 0; ks < 2; ++ks) wf[ks] = *(const LAS bf16x8*)(lds + OFF_W + (tt * 16 + c16) * TS + (g * 8 + 32 * ks) * 2);
        const float gtt = sc[128 + t], emt = sc[192 + t];
        const float den = ((const LAS float*)(lds + OFF_DEN))[t * 2] + ((const LAS float*)(lds + OFF_DEN))[t * 2 + 1] + gtt * ((const LAS float*)(lds + OFF_NQ))[t];
        const float inv = 1.0f / fmaxf(fabsf(den), emt);
        const LAS unsigned char* vtb = lds + OFF_VT + buf * 9216; const LAS unsigned char* ktb = lds + OFF_KT + buf * 18432;
        float hq2 = 0.f;
#pragma unroll
        for (int j = 0; j < 2; ++j) { const int vt = half * 2 + j; f32x4 a1 = {0.f, 0.f, 0.f, 0.f};
#pragma unroll
            for (int ks = 0; ks < 2; ++ks) { const bf16x8 vf = *(const LAS bf16x8*)(vtb + (vt * 16 + c16) * TS + (g * 8 + 32 * ks) * 2); a1 = MFMA16(vf, wf[ks], a1); }
            const f32x4 hv = (a1 + gtt * acc2[j]) * inv;
            hq2 += (hv[0] * hv[0] + hv[1] * hv[1]) + (hv[2] * hv[2] + hv[3] * hv[3]);
            if (t < nvalid) { const u32x2 mo = mocur[j];
                const f32x4 mf = {bflo(mo.x), bfhi(mo.x), bflo(mo.y), bfhi(mo.y)}; f32x4 ov;
#pragma unroll
                for (int r = 0; r < 4; ++r) ov[r] = hv[r] * gmv[j][r] * (1.0f / (1.0f + __expf(-mf[r])));
                u32x2 o; o.x = pkbf(ov[0], ov[1]); o.y = pkbf(ov[2], ov[3]); *(u32x2*)(MIX + (size_t)(rbase + t) * DM + h * 256 + vs * 64 + vt * 16 + 4 * g) = o; } }
        hq2 += __shfl_xor(hq2, 16); hq2 += __shfl_xor(hq2, 32);
        if (g == 0 && t < nvalid) unsafeAtomicAdd(hsq + (size_t)(rbase + t) * 8 + h, hq2);
        bf16x8 kf2[2];
#pragma unroll
        for (int ks = 0; ks < 2; ++ks) kf2[ks] = *(const LAS bf16x8*)(ktb + (w * 16 + c16) * TS + (g * 8 + 32 * ks) * 2);
#pragma unroll
        for (int vt = 0; vt < 4; ++vt) { accC[vt] = accC[vt] * decay;
#pragma unroll
            for (int ks = 0; ks < 2; ++ks) { const bf16x8 vf = *(const LAS bf16x8*)(vtb + (vt * 16 + c16) * TS + (g * 8 + 32 * ks) * 2); accC[vt] = MFMA16(kf2[ks], vf, accC[vt]); }
            u32x2 o; o.x = pkbf_mfma(accC[vt][0], accC[vt][1]); o.y = pkbf_mfma(accC[vt][2], accC[vt][3]); *(LAS u32x2*)(lds + OFF_CB + (vt * 16 + c16) * QS + (16 * w + 4 * g) * 2) = o; }
        { float s = 0.f;
#pragma unroll
            for (int i = 0; i < 2; ++i) { const u32x4 kk = *(const LAS u32x4*)(ktb + (w * 16 + c16) * TS + (g * 16 + i * 8) * 2); float f[8]; unpack8(kk, f);
#pragma unroll
                for (int e = 0; e < 8; ++e) s += f[e]; }
            s += __shfl_xor(s, 16); s += __shfl_xor(s, 32);
            if (g == 0) { LAS float* nn = (LAS float*)(lds + OFF_N) + w * 16 + c16; *nn = decay * (*nn) + s; } }
        if (c + 1 < nchunks) { decay = ml_stage(R, lds, buf ^ 1, m_prev, tid, lane, w); mocur[0] = R.mo[0]; mocur[1] = R.mo[1];
            if (c + 3 < nchunks) ml_load(R, PROJ, GT, rbase + 192, nvalid, h, vs, tid, lane, w); }
    };
    for (int c = 0; c < nchunks; c += 2) { step(c, RB); if (c + 1 < nchunks) step(c + 1, RA); }
    __syncthreads();
#pragma unroll
    for (int vt = 0; vt < 4; ++vt) *(f32x4*)(Cout + (size_t)(vs * 64 + vt * 16 + c16) * 128 + 16 * w + 4 * g) = accC[vt];
    if (vs == 0 && tid < 128) nout[tid] = ((const LAS float*)(lds + OFF_N))[tid];
    if (vs == 0 && tid == 0) mout[0] = m_prev;
}

namespace at {
constexpr int KS = 144, VS = 400;
constexpr int OFF_KN = 0, OFF_VT = 27648, OFF_BT = 53248;
}
__device__ __forceinline__ int t5_bucket(int rel) {
    const int n = rel < 0 ? -rel : rel; int v;
    if (n < 8) v = n; else if (n <= 11) v = 8; else if (n <= 15) v = 9; else if (n <= 22) v = 10; else if (n <= 31) v = 11; else if (n <= 45) v = 12; else if (n <= 63) v = 13; else if (n <= 90) v = 14; else v = 15;
    return v + (rel > 0 ? 16 : 0);
}
__device__ __forceinline__ void knorm8(float (&f)[8], const float* gk, int ch) {
    float ss = 0.f;
#pragma unroll
    for (int e = 0; e < 8; ++e) ss += f[e] * f[e];
    ss += __shfl_xor(ss, 1); ss += __shfl_xor(ss, 2); ss += __shfl_xor(ss, 4);
    const float rn = 1.0f / sqrtf(ss * (1.0f / 64.0f) + EPS);
#pragma unroll
    for (int e = 0; e < 8; ++e) f[e] = f[e] * rn * gk[ch * 8 + e];
}
__device__ __forceinline__ void attn_unit(Ctx& F, const Args& a, int l, bool prompt, int b, int c, int kvh) {
    using namespace at;
    LAS unsigned char* lds = F.lds;
    const bf16_t* PROJ = (const bf16_t*)(FWS + WS_PROJ); bf16_t* MIX = (bf16_t*)(FWS + WS_MIX);
    const int tid = F.tid, lane = F.lane, w = F.wave, c16 = lane & 15, g = lane >> 4;
    const float* gq = FIN(12) + l * 64; const float* gk = FIN(13) + l * 64;
    float* hsq = (float*)(FWS + WS_HSQ) + (size_t)l * MT * 8; const float* gao = FIN(16) + l * 1024;
    __syncthreads();
    int nkeys, nprev;
    if (prompt) {
        const int nkc = (c < 2 ? c : 2) + 1; nkeys = nkc * 64; nprev = nkeys - 64; const int p0 = (c - (nkc - 1)) * 64;
        for (int kc = 0; kc < nkc; ++kc) {
            const bool own = (kc == nkc - 1) && (c >= 30);
            { const int key = tid >> 3, ch = tid & 7; const size_t row = (size_t)b * SEQ + p0 + kc * 64 + key;
                const u32x4 kk = *(const u32x4*)(PROJ + row * NPJ + PJ_AK + kvh * 64 + ch * 8); float f[8]; unpack8(kk, f); knorm8(f, gk, ch);
                u32x4 o; o.x = pkbf(f[0], f[1]); o.y = pkbf(f[2], f[3]); o.z = pkbf(f[4], f[5]); o.w = pkbf(f[6], f[7]);
                *(LAS u32x4*)(lds + OFF_KN + (kc * 64 + key) * KS + ch * 16) = o;
                if (own) { float* dst = FOUT + O_PCK + ((size_t)(l * 16 + b) * 128 + (c * 64 + key - 1920)) * 256 + kvh * 64 + ch * 8;
                    *(f32x4*)dst = (f32x4){f[0], f[1], f[2], f[3]}; *(f32x4*)(dst + 4) = (f32x4){f[4], f[5], f[6], f[7]}; } }
            { const size_t row = (size_t)b * SEQ + p0 + kc * 64 + lane;
                const u32x4 vv = *(const u32x4*)(PROJ + row * NPJ + PJ_AV + kvh * 64 + w * 8); float f[8]; unpack8(vv, f);
#pragma unroll
                for (int e = 0; e < 8; ++e) *(LAS bf16_t*)(lds + OFF_VT + (w * 8 + e) * VS + (kc * 64 + lane) * 2) = (bf16_t)(__builtin_bit_cast(unsigned, f[e]) >> 16);
                if (own) { float* dst = FOUT + O_PCV + ((size_t)(l * 16 + b) * 128 + (c * 64 + lane - 1920)) * 256 + kvh * 64 + w * 8;
                    *(f32x4*)dst = (f32x4){f[0], f[1], f[2], f[3]}; *(f32x4*)(dst + 4) = (f32x4){f[4], f[5], f[6], f[7]}; } }
        }
    } else {
        nkeys = 160; nprev = 128;
        const float* ck = FIN(2) + (size_t)(l * 16 + b) * 128 * 256; const float* cv = FIN(3) + (size_t)(l * 16 + b) * 128 * 256;
        float* sk = FOUT + O_SCK + (size_t)(l * 16 + b) * 128 * 256; float* sv = FOUT + O_SCV + (size_t)(l * 16 + b) * 128 * 256;
#pragma unroll
        for (int j = 0; j < 2; ++j) {
            { const int key = (tid >> 3) + 64 * j, ch = tid & 7; const float* src = ck + (size_t)key * 256 + kvh * 64 + ch * 8;
                const f32x4 va = *(const f32x4*)src, bb = *(const f32x4*)(src + 4);
                u32x4 o; o.x = pkbf(va.x, va.y); o.y = pkbf(va.z, va.w); o.z = pkbf(bb.x, bb.y); o.w = pkbf(bb.z, bb.w);
                *(LAS u32x4*)(lds + OFF_KN + key * KS + ch * 16) = o;
                if (key >= 32) { float* dst = sk + (size_t)(key - 32) * 256 + kvh * 64 + ch * 8; *(f32x4*)dst = va; *(f32x4*)(dst + 4) = bb; } }
            { const int key = lane + 64 * j; const float* src = cv + (size_t)key * 256 + kvh * 64 + w * 8;
                const f32x4 va = *(const f32x4*)src, bb = *(const f32x4*)(src + 4); const float f[8] = {va.x, va.y, va.z, va.w, bb.x, bb.y, bb.z, bb.w};
#pragma unroll
                for (int e = 0; e < 8; ++e) *(LAS bf16_t*)(lds + OFF_VT + (w * 8 + e) * VS + key * 2) = (bf16_t)f2bf(f[e]);
                if (key >= 32) { float* dst = sv + (size_t)(key - 32) * 256 + kvh * 64 + w * 8; *(f32x4*)dst = va; *(f32x4*)(dst + 4) = bb; } }
        }
        if (tid < 256) { const int key = tid >> 3, ch = tid & 7; const size_t row = (size_t)MP + b * SL + key;
            const u32x4 kk = *(const u32x4*)(PROJ + row * NPJ + PJ_AK + kvh * 64 + ch * 8); float f[8]; unpack8(kk, f); knorm8(f, gk, ch);
            u32x4 o; o.x = pkbf(f[0], f[1]); o.y = pkbf(f[2], f[3]); o.z = pkbf(f[4], f[5]); o.w = pkbf(f[6], f[7]);
            *(LAS u32x4*)(lds + OFF_KN + (128 + key) * KS + ch * 16) = o;
            float* dst = sk + (size_t)(96 + key) * 256 + kvh * 64 + ch * 8; *(f32x4*)dst = (f32x4){f[0], f[1], f[2], f[3]}; *(f32x4*)(dst + 4) = (f32x4){f[4], f[5], f[6], f[7]}; }
        if (lane < 32) { const size_t row = (size_t)MP + b * SL + lane;
            const u32x4 vv = *(const u32x4*)(PROJ + row * NPJ + PJ_AV + kvh * 64 + w * 8); float f[8]; unpack8(vv, f);
#pragma unroll
            for (int e = 0; e < 8; ++e) *(LAS bf16_t*)(lds + OFF_VT + (w * 8 + e) * VS + (128 + lane) * 2) = (bf16_t)(__builtin_bit_cast(unsigned, f[e]) >> 16);
            float* dst = sv + (size_t)(96 + lane) * 256 + kvh * 64 + w * 8; *(f32x4*)dst = (f32x4){f[0], f[1], f[2], f[3]}; *(f32x4*)(dst + 4) = (f32x4){f[4], f[5], f[6], f[7]}; }
    }
    __syncthreads();
    const int hl = w >> 1, hq = kvh * 4 + hl; const float sink = FIN(14)[l * 16 + hq];
    const LAS float* BT = (const LAS float*)(lds + OFF_BT) + hq * 256;
    const int nqt = prompt ? 2 : 1, nkb = nkeys >> 5;
    for (int qt = 0; qt < nqt; ++qt) {
        const int qin = prompt ? (w & 1) * 32 + qt * 16 + c16 : (w & 1) * 16 + c16;
        const size_t row = prompt ? (size_t)b * SEQ + c * 64 + qin : (size_t)MP + b * SL + qin;
        bf16x8 qf[2];
        { float f[2][8]; float ss = 0.f;
#pragma unroll
            for (int ks = 0; ks < 2; ++ks) { const u32x4 qq = *(const u32x4*)(PROJ + row * NPJ + PJ_AQ + hq * 64 + g * 8 + 32 * ks); unpack8(qq, f[ks]);
#pragma unroll
                for (int e = 0; e < 8; ++e) ss += f[ks][e] * f[ks][e]; }
            ss += __shfl_xor(ss, 16); ss += __shfl_xor(ss, 32);
            const float rn = 0.125f / sqrtf(ss * (1.0f / 64.0f) + EPS);
#pragma unroll
            for (int ks = 0; ks < 2; ++ks) { u32x4 o; const float* gg = gq + g * 8 + 32 * ks;
                o.x = pkbf(f[ks][0] * rn * gg[0], f[ks][1] * rn * gg[1]); o.y = pkbf(f[ks][2] * rn * gg[2], f[ks][3] * rn * gg[3]);
                o.z = pkbf(f[ks][4] * rn * gg[4], f[ks][5] * rn * gg[5]); o.w = pkbf(f[ks][6] * rn * gg[6], f[ks][7] * rn * gg[7]);
                qf[ks] = __builtin_bit_cast(bf16x8, o); } }
        float mrun = sink, lsum = (g == 0) ? 1.0f : 0.0f;
        f32x4 O[4];
#pragma unroll
        for (int dt = 0; dt < 4; ++dt) O[dt] = (f32x4){0.f, 0.f, 0.f, 0.f};
        for (int kb = 0; kb < nkb; ++kb) {
            f32x4 s[2];
#pragma unroll
            for (int j = 0; j < 2; ++j) { s[j] = (f32x4){0.f, 0.f, 0.f, 0.f};
#pragma unroll
                for (int ks = 0; ks < 2; ++ks) { const bf16x8 kf = *(const LAS bf16x8*)(lds + OFF_KN + (kb * 32 + 16 * j + c16) * KS + (g * 8 + 32 * ks) * 2); s[j] = MFMA16(kf, qf[ks], s[j]); }
                const int ib = kb * 32 + 16 * j + 4 * g - nprev - qin + 191;
#pragma unroll
                for (int r = 0; r < 4; ++r) s[j][r] += BT[ib + r]; }
            float mx = fmaxf(fmaxf(fmaxf(s[0][0], s[0][1]), fmaxf(s[0][2], s[0][3])), fmaxf(fmaxf(s[1][0], s[1][1]), fmaxf(s[1][2], s[1][3])));
            mx = fmaxf(mx, __shfl_xor(mx, 16)); mx = fmaxf(mx, __shfl_xor(mx, 32));
            const float mnew = fmaxf(mrun, mx), alpha = __expf(mrun - mnew); mrun = mnew;
            float ps = 0.f;
#pragma unroll
            for (int j = 0; j < 2; ++j)
#pragma unroll
                for (int r = 0; r < 4; ++r) { s[j][r] = __expf(s[j][r] - mnew); ps += s[j][r]; }
            lsum = lsum * alpha + ps;
            u32x4 pw; pw.x = pkbf(s[0][0], s[0][1]); pw.y = pkbf(s[0][2], s[0][3]); pw.z = pkbf(s[1][0], s[1][1]); pw.w = pkbf(s[1][2], s[1][3]);
            const bf16x8 pf = __builtin_bit_cast(bf16x8, pw);
#pragma unroll
            for (int dt = 0; dt < 4; ++dt) { const LAS unsigned char* vp = lds + OFF_VT + (dt * 16 + c16) * VS + (kb * 32 + 4 * g) * 2;
                const u32x2 v0 = *(const LAS u32x2*)vp, v1 = *(const LAS u32x2*)(vp + 32);
                u32x4 vw; vw.x = v0.x; vw.y = v0.y; vw.z = v1.x; vw.w = v1.y;
                O[dt] = O[dt] * alpha; O[dt] = MFMA16(__builtin_bit_cast(bf16x8, vw), pf, O[dt]); }
        }
        lsum += __shfl_xor(lsum, 16); lsum += __shfl_xor(lsum, 32);
        const float inv = 1.0f / lsum; float aq2 = 0.f;
#pragma unroll
        for (int dt = 0; dt < 4; ++dt) { const f32x4 ov = O[dt] * inv; const f32x4 gg = *(const f32x4*)(gao + hq * 64 + dt * 16 + 4 * g);
            aq2 += (ov[0] * ov[0] + ov[1] * ov[1]) + (ov[2] * ov[2] + ov[3] * ov[3]);
            u32x2 o; o.x = pkbf(ov[0] * gg[0], ov[1] * gg[1]); o.y = pkbf(ov[2] * gg[2], ov[3] * gg[3]);
            *(u32x2*)(MIX + row * DM + 1024 + hq * 64 + dt * 16 + 4 * g) = o; }
        aq2 += __shfl_xor(aq2, 16); aq2 += __shfl_xor(aq2, 32);
        if (g == 0) unsafeAtomicAdd(hsq + row * 8 + 4, aq2);
    }
}


struct AReg { u32x4 kk[3], vv[3], q[2][2]; };
__device__ __forceinline__ void attn_loadp(AReg& R, const bf16_t* PROJ, int b, int c, int kvh, int tid, int lane, int w) {
    const int nkc = (c < 2 ? c : 2) + 1, p0 = (c - (nkc - 1)) * 64, c16 = lane & 15, g = lane >> 4, hq = kvh * 4 + (w >> 1);
#pragma unroll
    for (int kc = 0; kc < 3; ++kc) if (kc < nkc) {
        R.kk[kc] = *(const u32x4*)(PROJ + ((size_t)b * SEQ + p0 + kc * 64 + (tid >> 3)) * NPJ + PJ_AK + kvh * 64 + (tid & 7) * 8);
        R.vv[kc] = *(const u32x4*)(PROJ + ((size_t)b * SEQ + p0 + kc * 64 + lane) * NPJ + PJ_AV + kvh * 64 + w * 8); }
#pragma unroll
    for (int qt = 0; qt < 2; ++qt) { const size_t row = (size_t)b * SEQ + c * 64 + (w & 1) * 32 + qt * 16 + c16;
#pragma unroll
        for (int ks = 0; ks < 2; ++ks) R.q[qt][ks] = *(const u32x4*)(PROJ + row * NPJ + PJ_AQ + hq * 64 + g * 8 + 32 * ks); }
}
__device__ __forceinline__ void attn_prompt_unit(Ctx& F, const Args& a, int l, int b, int c, int kvh, AReg& R, bool has_next, int nb, int nc, int nkvh) {
    using namespace at;
    LAS unsigned char* lds = F.lds;
    const bf16_t* PROJ = (const bf16_t*)(FWS + WS_PROJ); bf16_t* MIX = (bf16_t*)(FWS + WS_MIX);
    const int tid = F.tid, lane = F.lane, w = F.wave, c16 = lane & 15, g = lane >> 4;
    const float* gq = FIN(12) + l * 64; const float* gk = FIN(13) + l * 64;
    float* hsq = (float*)(FWS + WS_HSQ) + (size_t)l * MT * 8; const float* gao = FIN(16) + l * 1024;
    const int nkc = (c < 2 ? c : 2) + 1, nkeys = nkc * 64, nprev = nkeys - 64;
    __syncthreads();
#pragma unroll
    for (int kc = 0; kc < 3; ++kc) if (kc < nkc) {
        const bool own = (kc == nkc - 1) && (c >= 30);
        { const int key = tid >> 3, ch = tid & 7; float f[8]; unpack8(R.kk[kc], f); knorm8(f, gk, ch);
            u32x4 o; o.x = pkbf(f[0], f[1]); o.y = pkbf(f[2], f[3]); o.z = pkbf(f[4], f[5]); o.w = pkbf(f[6], f[7]);
            *(LAS u32x4*)(lds + OFF_KN + (kc * 64 + key) * KS + ch * 16) = o;
            if (own) { float* dst = FOUT + O_PCK + ((size_t)(l * 16 + b) * 128 + (c * 64 + key - 1920)) * 256 + kvh * 64 + ch * 8;
                *(f32x4*)dst = (f32x4){f[0], f[1], f[2], f[3]}; *(f32x4*)(dst + 4) = (f32x4){f[4], f[5], f[6], f[7]}; } }
        { float f[8]; unpack8(R.vv[kc], f);
#pragma unroll
            for (int e = 0; e < 8; ++e) *(LAS bf16_t*)(lds + OFF_VT + (w * 8 + e) * VS + (kc * 64 + lane) * 2) = (bf16_t)(__builtin_bit_cast(unsigned, f[e]) >> 16);
            if (own) { float* dst = FOUT + O_PCV + ((size_t)(l * 16 + b) * 128 + (c * 64 + lane - 1920)) * 256 + kvh * 64 + w * 8;
                *(f32x4*)dst = (f32x4){f[0], f[1], f[2], f[3]}; *(f32x4*)(dst + 4) = (f32x4){f[4], f[5], f[6], f[7]}; } }
    }
    const int hl = w >> 1, hq = kvh * 4 + hl; const float sink = FIN(14)[l * 16 + hq];
    bf16x8 qf[2][2];
#pragma unroll
    for (int qt = 0; qt < 2; ++qt) { float f[2][8]; float ss = 0.f;
#pragma unroll
        for (int ks = 0; ks < 2; ++ks) { unpack8(R.q[qt][ks], f[ks]);
#pragma unroll
            for (int e = 0; e < 8; ++e) ss += f[ks][e] * f[ks][e]; }
        ss += __shfl_xor(ss, 16); ss += __shfl_xor(ss, 32);
        const float rn = 0.125f / sqrtf(ss * (1.0f / 64.0f) + EPS);
#pragma unroll
        for (int ks = 0; ks < 2; ++ks) { u32x4 o; const float* gg = gq + g * 8 + 32 * ks;
            o.x = pkbf(f[ks][0] * rn * gg[0], f[ks][1] * rn * gg[1]); o.y = pkbf(f[ks][2] * rn * gg[2], f[ks][3] * rn * gg[3]);
            o.z = pkbf(f[ks][4] * rn * gg[4], f[ks][5] * rn * gg[5]); o.w = pkbf(f[ks][6] * rn * gg[6], f[ks][7] * rn * gg[7]);
            qf[qt][ks] = __builtin_bit_cast(bf16x8, o); } }
    __syncthreads();
    if (has_next) attn_loadp(R, PROJ, nb, nc, nkvh, tid, lane, w);
    const LAS float* BT = (const LAS float*)(lds + OFF_BT) + hq * 256;
    const int nkb = nkeys >> 5;
    const int qin0 = (w & 1) * 32 + c16;
    float mrun[2] = {sink, sink}, lsum[2] = {(g == 0) ? 1.0f : 0.0f, (g == 0) ? 1.0f : 0.0f};
    f32x4 O[2][4];
#pragma unroll
    for (int qt = 0; qt < 2; ++qt)
#pragma unroll
        for (int dt = 0; dt < 4; ++dt) O[qt][dt] = (f32x4){0.f, 0.f, 0.f, 0.f};
    for (int kb = 0; kb < nkb; ++kb) {
        bf16x8 kf[2][2];
#pragma unroll
        for (int j = 0; j < 2; ++j)
#pragma unroll
            for (int ks = 0; ks < 2; ++ks) kf[j][ks] = *(const LAS bf16x8*)(lds + OFF_KN + (kb * 32 + 16 * j + c16) * KS + (g * 8 + 32 * ks) * 2);
        f32x4 s[2][2];
#pragma unroll
        for (int qt = 0; qt < 2; ++qt)
#pragma unroll
            for (int j = 0; j < 2; ++j) { s[qt][j] = (f32x4){0.f, 0.f, 0.f, 0.f};
#pragma unroll
                for (int ks = 0; ks < 2; ++ks) s[qt][j] = MFMA16(kf[j][ks], qf[qt][ks], s[qt][j]); }
        bf16x8 pf[2];
#pragma unroll
        for (int qt = 0; qt < 2; ++qt) {
#pragma unroll
            for (int j = 0; j < 2; ++j) { const int ib = kb * 32 + 16 * j + 4 * g - nprev - (qin0 + 16 * qt) + 191;
#pragma unroll
                for (int r = 0; r < 4; ++r) s[qt][j][r] += BT[ib + r]; }
            float mx = fmaxf(fmaxf(fmaxf(s[qt][0][0], s[qt][0][1]), fmaxf(s[qt][0][2], s[qt][0][3])), fmaxf(fmaxf(s[qt][1][0], s[qt][1][1]), fmaxf(s[qt][1][2], s[qt][1][3])));
            mx = fmaxf(mx, __shfl_xor(mx, 16)); mx = fmaxf(mx, __shfl_xor(mx, 32));
            const float mnew = fmaxf(mrun[qt], mx), alpha = __expf(mrun[qt] - mnew); mrun[qt] = mnew;
            float ps = 0.f;
#pragma unroll
            for (int j = 0; j < 2; ++j)
#pragma unroll
                for (int r = 0; r < 4; ++r) { s[qt][j][r] = __expf(s[qt][j][r] - mnew); ps += s[qt][j][r]; }
            lsum[qt] = lsum[qt] * alpha + ps;
            u32x4 pw; pw.x = pkbf(s[qt][0][0], s[qt][0][1]); pw.y = pkbf(s[qt][0][2], s[qt][0][3]); pw.z = pkbf(s[qt][1][0], s[qt][1][1]); pw.w = pkbf(s[qt][1][2], s[qt][1][3]);
            pf[qt] = __builtin_bit_cast(bf16x8, pw);
#pragma unroll
            for (int dt = 0; dt < 4; ++dt) O[qt][dt] = O[qt][dt] * alpha;
        }
#pragma unroll
        for (int dt = 0; dt < 4; ++dt) { const LAS unsigned char* vp = lds + OFF_VT + (dt * 16 + c16) * VS + (kb * 32 + 4 * g) * 2;
            const u32x2 v0 = *(const LAS u32x2*)vp, v1 = *(const LAS u32x2*)(vp + 32);
            u32x4 vw; vw.x = v0.x; vw.y = v0.y; vw.z = v1.x; vw.w = v1.y; const bf16x8 vf = __builtin_bit_cast(bf16x8, vw);
            O[0][dt] = MFMA16(vf, pf[0], O[0][dt]); O[1][dt] = MFMA16(vf, pf[1], O[1][dt]); }
    }
#pragma unroll
    for (int qt = 0; qt < 2; ++qt) {
        const size_t row = (size_t)b * SEQ + c * 64 + qin0 + 16 * qt;
        float ls = lsum[qt]; ls += __shfl_xor(ls, 16); ls += __shfl_xor(ls, 32);
        const float inv = 1.0f / ls; float aq2 = 0.f;
#pragma unroll
        for (int dt = 0; dt < 4; ++dt) { const f32x4 ov = O[qt][dt] * inv; const f32x4 gg = *(const f32x4*)(gao + hq * 64 + dt * 16 + 4 * g);
            aq2 += (ov[0] * ov[0] + ov[1] * ov[1]) + (ov[2] * ov[2] + ov[3] * ov[3]);
            u32x2 o; o.x = pkbf(ov[0] * gg[0], ov[1] * gg[1]); o.y = pkbf(ov[2] * gg[2], ov[3] * gg[3]);
            *(u32x2*)(MIX + row * DM + 1024 + hq * 64 + dt * 16 + 4 * g) = o; }
        aq2 += __shfl_xor(aq2, 16); aq2 += __shfl_xor(aq2, 32);
        if (g == 0) unsafeAtomicAdd(hsq + row * 8 + 4, aq2);
    }
}

template <int WHICH>
__device__ __forceinline__ void phase_mixers(Ctx& F, const Args& a, int l) {
    float* hsq = (float*)(FWS + WS_HSQ) + (size_t)l * MT * 8; const float* gmo = FIN(15) + l * 1024;
#ifndef DBG_NO_ML
    if (WHICH & 1) for (int u = F.bid; u < 512; u += F.G) {
        const bool smp = u >= 256; const int uu = u & 255, b = uu >> 4, h = (uu >> 2) & 3, vs = uu & 3; const size_t so = (size_t)((l * 16 + b) * 4 + h);
        if (!smp) mlstm_chain(F, a, nullptr, nullptr, nullptr, FOUT + O_PC + so * 32768, FOUT + O_PN + so * 128, FOUT + O_PM + so, b * SEQ, 32, 64, h, vs, hsq, gmo);
        else mlstm_chain(F, a, FIN(4) + so * 32768, FIN(5) + so * 128, FIN(6) + so, FOUT + O_SC + so * 32768, FOUT + O_SN + so * 128, FOUT + O_SM + so, MP + b * SL, 1, 32, h, vs, hsq, gmo);
    }
#endif
#ifndef DBG_NO_ATTN
    if (WHICH & 2) {
        __syncthreads();
        { LAS float* BT = (LAS float*)(F.lds + at::OFF_BT); const float* rb = FIN(7);
            for (int i = F.tid; i < 4096; i += 512) { const int hh = i >> 8, idx = i & 255; BT[i] = (idx < 255) ? rb[t5_bucket(idx - 191) * 16 + hh] : 0.f; } }
        const bf16_t* PROJ = (const bf16_t*)(FWS + WS_PROJ);
        AReg R; int u = F.bid;
        if (u < 2048) attn_loadp(R, PROJ, u >> 7, (u >> 2) & 31, u & 3, F.tid, F.lane, F.wave);
        for (; u < 2048; u += F.G) { const int un = u + F.G;
            attn_prompt_unit(F, a, l, u >> 7, (u >> 2) & 31, u & 3, R, un < 2048, un >> 7, (un >> 2) & 31, un & 3); }
        for (int v = F.bid; v < 64; v += F.G) attn_unit(F, a, l, false, v >> 2, 0, v & 3);
    }
#endif
    __syncthreads();
}

__device__ __forceinline__ void phase_finalize(Ctx& F, const Args& a, int l) {
    const bf16_t* PROJ = (const bf16_t*)(FWS + WS_PROJ); bf16_t* MIX = (bf16_t*)(FWS + WS_MIX);
    const float* gmo = FIN(15) + l * 1024; const float* gao = FIN(16) + l * 1024;
    const int gw = F.bid * 8 + F.wave, NGW = F.G * 8, lane = F.lane;
    u32x4 raw[4], mo[2], rawn[4], mon[2];
    if (gw < MT) {
#pragma unroll
        for (int j = 0; j < 4; ++j) raw[j] = *(const u32x4*)(MIX + (size_t)gw * DM + (lane + 64 * j) * 8);
#pragma unroll
        for (int j = 0; j < 2; ++j) mo[j] = *(const u32x4*)(PROJ + (size_t)gw * NPJ + PJ_MO + (lane + 64 * j) * 8); }
    for (int m = gw; m < MT; m += NGW) {
        bf16_t* mr = MIX + (size_t)m * DM; const int mn = m + NGW;
        if (mn < MT) {
#pragma unroll
            for (int j = 0; j < 4; ++j) rawn[j] = *(const u32x4*)(MIX + (size_t)mn * DM + (lane + 64 * j) * 8);
#pragma unroll
            for (int j = 0; j < 2; ++j) mon[j] = *(const u32x4*)(PROJ + (size_t)mn * NPJ + PJ_MO + (lane + 64 * j) * 8); }
        float f[4][8];
#pragma unroll
        for (int j = 0; j < 4; ++j) unpack8(raw[j], f[j]);
        float sa = 0.f;
#pragma unroll
        for (int j = 0; j < 2; ++j) { float ss = 0.f;
#pragma unroll
            for (int e = 0; e < 8; ++e) ss += f[j][e] * f[j][e];
            ss += __shfl_xor(ss, 1); ss += __shfl_xor(ss, 2); ss += __shfl_xor(ss, 4); ss += __shfl_xor(ss, 8); ss += __shfl_xor(ss, 16);
            const float rn = 1.0f / sqrtf(ss * (1.0f / 256.0f) + EPS);
            float o[8], mf[8]; unpack8(mo[j], mf); const float* gg = gmo + (lane + 64 * j) * 8;
#pragma unroll
            for (int e = 0; e < 8; ++e) o[e] = f[j][e] * rn * gg[e] * (1.0f / (1.0f + __expf(-mf[e])));
            u32x4 ow; ow.x = pkbf(o[0], o[1]); ow.y = pkbf(o[2], o[3]); ow.z = pkbf(o[4], o[5]); ow.w = pkbf(o[6], o[7]);
            *(u32x4*)(mr + (lane + 64 * j) * 8) = ow; }
#pragma unroll
        for (int j = 2; j < 4; ++j)
#pragma unroll
            for (int e = 0; e < 8; ++e) sa += f[j][e] * f[j][e];
        sa = wave_sum(sa);
        const float ra = 1.0f / sqrtf(sa * (1.0f / 1024.0f) + EPS);
#pragma unroll
        for (int j = 2; j < 4; ++j) { float o[8]; const float* gg = gao + (lane + 64 * (j - 2)) * 8;
#pragma unroll
            for (int e = 0; e < 8; ++e) o[e] = f[j][e] * ra * gg[e];
            u32x4 ow; ow.x = pkbf(o[0], o[1]); ow.y = pkbf(o[2], o[3]); ow.z = pkbf(o[4], o[5]); ow.w = pkbf(o[6], o[7]);
            *(u32x4*)(mr + (lane + 64 * j) * 8) = ow; }
#pragma unroll
        for (int j = 0; j < 4; ++j) raw[j] = rawn[j];
#pragma unroll
        for (int j = 0; j < 2; ++j) mo[j] = mon[j];
    }
}

#define XB_TMO      128
#define XB_XCNT(j)  (256  + 64 * (j))
#define XB_XSUB(j)  (1280 + 64 * (j))
#define XB_XGEN(j)  (2304 + 64 * (j))
#define XB_TOP      3328
#define XB_TOPGEN   3392
#define XCD_BAR_WORDS 3456
#define XB_SPIN_CAP (1u << 18)

__device__ __forceinline__ unsigned xb_ld(unsigned* p)              { return __hip_atomic_load(p, __ATOMIC_RELAXED, __HIP_MEMORY_SCOPE_AGENT); }
__device__ __forceinline__ unsigned xb_add(unsigned* p, unsigned v) { return __hip_atomic_fetch_add(p, v, __ATOMIC_RELAXED, __HIP_MEMORY_SCOPE_AGENT); }
__device__ __forceinline__ unsigned xb_xcc_id() { return (unsigned)__builtin_amdgcn_s_getreg((3 << 11) | 20) & 0xFu; }
#define XB_SPIN(cond, bar) do { unsigned _sp = 0; while (cond) { __builtin_amdgcn_s_sleep(1); \
    if ((++_sp & 255u) == 0u) { if (xb_ld(&(bar)[XB_TMO])) break; if (_sp > XB_SPIN_CAP) { atomicAdd(&(bar)[XB_TMO], 1u); break; } } } } while (0)

struct XcdBarrier {
    unsigned* bar; unsigned x;
    volatile LAS unsigned* st;
};

__device__ __forceinline__ XcdBarrier xcd_barrier_post(unsigned* bar, volatile LAS unsigned* st) {
    XcdBarrier b; b.bar = bar; b.x = xb_xcc_id(); b.st = st;
    if (threadIdx.x == 0) (void)xb_add(&bar[XB_XCNT(b.x)], 1u);
    return b;
}
__device__ __forceinline__ void xcd_barrier_complete(unsigned* bar, unsigned x, unsigned& nloc, unsigned& nx) {
    const unsigned G = gridDim.x * gridDim.y * gridDim.z;
    unsigned sum, cnt, mine, sp = 0u;
    for (;;) {
        sum = 0u; cnt = 0u; mine = 0u;
#pragma unroll
        for (unsigned j = 0; j < 16; ++j) { const unsigned c = xb_ld(&bar[XB_XCNT(j)]); sum += c; cnt += (c > 0u) ? 1u : 0u; mine = (j == x) ? c : mine; }
        if (sum == G) break;
        __builtin_amdgcn_s_sleep(1);
        if ((++sp & 255u) == 0u) { if (xb_ld(&bar[XB_TMO])) break; if (sp > XB_SPIN_CAP) { atomicAdd(&bar[XB_TMO], 1u); break; } }
    }
    nloc = mine > 0u ? mine : 1u; nx = cnt > 0u ? cnt : 1u;
}

__device__ __forceinline__ void xcd_barrier(const XcdBarrier& b) {
    asm volatile("s_waitcnt vmcnt(0)" ::: "memory");
    __syncthreads();
    if (threadIdx.x == 0) {
        unsigned* bar = b.bar;
        __builtin_amdgcn_s_waitcnt(0);
        unsigned nloc = b.st[0], nx = b.st[1];
        if (nloc == 0u) { xcd_barrier_complete(bar, b.x, nloc, nx); b.st[0] = nloc; b.st[1] = nx; }
        const unsigned old = xb_add(&bar[XB_XSUB(b.x)], 1u);
        const unsigned gen = old / nloc;
        if (old + 1u == (gen + 1u) * nloc) {
            __builtin_amdgcn_fence(__ATOMIC_RELEASE, "agent");
            asm volatile("s_waitcnt vmcnt(0)" ::: "memory");
            const unsigned og = xb_add(&bar[XB_TOP], 1u);
            const unsigned tg = og / nx;
            if (og + 1u == (tg + 1u) * nx) xb_add(&bar[XB_TOPGEN], 1u);
            else XB_SPIN(xb_ld(&bar[XB_TOPGEN]) == tg, bar);
            __builtin_amdgcn_fence(__ATOMIC_ACQUIRE, "agent");
            xb_add(&bar[XB_XGEN(b.x)], 1u);
            asm volatile("s_waitcnt vmcnt(0)" ::: "memory");
        } else {
            XB_SPIN(xb_ld(&bar[XB_XGEN(b.x)]) == gen, bar);
            __builtin_amdgcn_fence(__ATOMIC_ACQUIRE, "agent");
            asm volatile("s_waitcnt vmcnt(0)" ::: "memory");
        }
    }
    __syncthreads();
}

constexpr int N_PHASES = 16;

__global__ void __launch_bounds__(512, 2) hymba_fwd(Args a) {
    extern __shared__ __attribute__((aligned(16))) unsigned char lds_raw[];
    cg::grid_group grid = cg::this_grid();
    Ctx F;
    F.lds = (LAS unsigned char*)lds_raw;
    F.tid = threadIdx.x; F.lane = F.tid & 63; F.wave = __builtin_amdgcn_readfirstlane(F.tid >> 6); F.G = gridDim.x; F.bid = blockIdx.x;
    float* Y = a.out;
    bf16_t* XN = (bf16_t*)(FWS + WS_XN); bf16_t* PROJ = (bf16_t*)(FWS + WS_PROJ); bf16_t* MIX = (bf16_t*)(FWS + WS_MIX); bf16_t* U = (bf16_t*)(FWS + WS_BIG);
    if (blockIdx.x == 0) for (int i = threadIdx.x; i < XCD_BAR_WORDS; i += 512) ((unsigned*)FWS)[i] = 0u;
    if (threadIdx.x < 4) ((LAS unsigned*)(F.lds + 131072 + 64))[threadIdx.x] = 0u;
    __syncthreads();
    XcdBarrier bar; bar.bar = (unsigned*)FWS; bar.x = 0; bar.st = nullptr; bool census = false;
    for (int ph = a.ph_lo; ph < a.ph_hi; ++ph) {
        if (ph > a.ph_lo && ph != 1) {
            if (!census) { grid.sync();
                bar = xcd_barrier_post((unsigned*)FWS, (volatile LAS unsigned*)(F.lds + 131072 + 64)); census = true; }
            else xcd_barrier(bar);
        }
        { int t_ = threadIdx.x; asm volatile("" : "+v"(t_)); F.tid = t_; F.lane = t_ & 63; F.wave = __builtin_amdgcn_readfirstlane(t_ >> 6); }
        if (ph == 0) {
#ifndef NO_W
#ifdef PROBE_W2
 phase_weights(F, a); __syncthreads(); phase_weights(F, a); __syncthreads();
#endif
 phase_weights(F, a);
#endif
 __syncthreads(); continue; }
        if (ph == 1) { phase_convert(F, a); __syncthreads(); continue; }
        const int l = (ph - 2) / 7, s = (ph - 2) % 7;
        bf16_t* XB = XN; float* SSQ = (float*)(FWS + WS_SSQ); float* HSQ = (float*)(FWS + WS_HSQ) + (size_t)l * MT * 8;
        float* ssq_in = SSQ + (l == 0 ? 0 : 2 * MT);
        float* ssq_mid = SSQ + (l == 0 ? MT : 3 * MT);
        if (s == 0) { pg8::Gemm g{XB, (const bf16_t*)(FWS + WS_WIN) + (size_t)l * NPW * DM, MT, NPW, DM, DM}; pg8::StaticOrder S; S.init(MT, NPW, F.G, F.bid);
            pg8::EpiScale<0, true> E{PROJ, NPJ, ssq_in, 1.0f / DM, EPS, (float*)(FWS + WS_GATES), FIN(10) + l * 4, FIN(11) + l * 4, NPJ / 256};
            pg8::gemm_phase<pg8::EpiScale<0, true>, pg8::StaticOrder, true, true>(F.lds, g, S, E); }
        else if (s == 1) phase_mixers<3>(F, a, l);
        else if (s == 2 || s == 5) {
            pg8::Gemm g;
            if (s == 2) g = pg8::Gemm{MIX, (const bf16_t*)(FWS + WS_WOUT) + (size_t)l * DM * DM, MP, DM, DM, DM};
            else g = pg8::Gemm{U, (const bf16_t*)(FWS + WS_WDN) + (size_t)l * DM * FF, MP, DM, FF, FF};
            pg8::StaticOrder S; S.init(MP, DM, F.G, F.bid);
            if (s == 2) { pg8::EpiResBK E{XB, DM, ssq_mid, HSQ, EPS}; pg8::gemm_phase<pg8::EpiResBK, pg8::StaticOrder, false, true>(F.lds, g, S, E); }
            else if (l == 1) { pg8::EpiResF E{XB, Y, DM}; pg8::gemm_phase<pg8::EpiResF, pg8::StaticOrder, false, true>(F.lds, g, S, E); }
            else { pg8::EpiResB E{XB, DM, SSQ + 2 * MT}; pg8::gemm_phase<pg8::EpiResB, pg8::StaticOrder, false, true>(F.lds, g, S, E); }
            __syncthreads();
            const int kfull = (s == 2) ? DM : FF; pg8::Gemm g2 = g; g2.K = kfull / 16;
            pg8::SplitKOrder S2; S2.init(DM, 16, kfull / 16, MP / 256, F.G, F.bid);
            pg8::EpiPartial E2{(float*)(FWS + WS_PART), DM, kfull / 16, MP, MS};
            pg8::gemm_phase<pg8::EpiPartial, pg8::SplitKOrder, true, true>(F.lds, g2, S2, E2); }
        else if (s == 3) phase_fold(F, a, ssq_mid, nullptr, HSQ);
        else if (s == 4) { pg8::Gemm g{XB, (const bf16_t*)(FWS + WS_WUP) + (size_t)l * FF * DM, MT, FF, DM, DM}; pg8::StaticOrder S; S.init(MT, FF, F.G, F.bid);
            pg8::EpiScale<2, false> E{U, FF, ssq_mid, 1.0f / DM, EPS, nullptr, nullptr, nullptr, -1};
            pg8::gemm_phase<pg8::EpiScale<2, false>, pg8::StaticOrder, true, true>(F.lds, g, S, E); }
        else { if (l == 0) phase_fold(F, a, SSQ + 2 * MT, nullptr, nullptr); else phase_fold(F, a, nullptr, Y, nullptr); }
        __syncthreads();
    }
#ifdef DBG_STOP
    grid.sync();
#ifdef DBG_F32
    { const float* src = (const float*)(FWS + DBG_SRC); const size_t n = (size_t)DBG_F32;
      for (size_t i = (size_t)blockIdx.x * 512 + threadIdx.x; i < n; i += (size_t)gridDim.x * 512) Y[i] = src[i]; }
#else
    { const bf16_t* src = (const bf16_t*)(FWS + DBG_SRC); const size_t n = (size_t)MT * DM;
      for (size_t i = (size_t)blockIdx.x * 512 + threadIdx.x; i < n; i += (size_t)gridDim.x * 512) Y[i] = __builtin_bit_cast(float, (unsigned)src[i] << 16); }
#endif
#endif
}

#ifndef N_LAUNCH_MODE
#define N_LAUNCH_MODE 0
#endif
extern "C" void kernel_launch(void* const* d_in, const int* in_sizes, int n_in, void* d_out, int out_size, void* d_ws, size_t ws_size, hipStream_t stream) {
    static int grid = 0;
    if (grid == 0) {
        if (n_in != 21 || out_size != 80773376 || ws_size < WS_END) { fprintf(stderr, "kernel_launch: unexpected shapes (n_in %d out %d ws %zu need %zu)\n", n_in, out_size, ws_size, (size_t)WS_END); grid = -1; return; }
        int dev = 0, cus = 0, per_cu = 0;
        hipGetDevice(&dev); hipDeviceGetAttribute(&cus, hipDeviceAttributeMultiprocessorCount, dev);
        if (hipFuncSetAttribute((const void*)hymba_fwd, hipFuncAttributeMaxDynamicSharedMemorySize, LDS_BYTES) != hipSuccess) { fprintf(stderr, "kernel_launch: hipFuncSetAttribute failed\n"); grid = -1; return; }
        if (hipOccupancyMaxActiveBlocksPerMultiprocessor(&per_cu, (const void*)hymba_fwd, 512, LDS_BYTES) != hipSuccess || per_cu < 1) { fprintf(stderr, "kernel_launch: occupancy query gave %d\n", per_cu); per_cu = 1; }
        (void)hipGetLastError();
        grid = cus * per_cu;
        fprintf(stderr, "kernel_launch: grid %d (cus %d x %d)\n", grid, cus, per_cu);
    }
    if (grid < 0) return;
#ifdef DBG_MEMSET
    (void)hipMemsetAsync(d_ws, 0, WS_END, stream); (void)hipMemsetAsync(d_out, 0, (size_t)out_size * 4, stream);
#endif
    Args a{};
    for (int i = 0; i < 21; ++i) a.in[i] = (const float*)d_in[i];
    a.out = (float*)d_out; a.ws = (unsigned char*)d_ws;
#if N_LAUNCH_MODE == 0
#ifdef DBG_STOP
    a.ph_lo = 0; a.ph_hi = DBG_STOP;
#else
    a.ph_lo = 0; a.ph_hi = N_PHASES;
#endif
    { void* args[] = {&a}; hipError_t e = hipLaunchCooperativeKernel((const void*)hymba_fwd, dim3(grid), dim3(512), args, LDS_BYTES, stream);
        if (e != hipSuccess) fprintf(stderr, "cooperative launch failed: %s (grid %d)\n", hipGetErrorString(e), grid); }
#else
    for (int p = 0; p < N_PHASES; ++p) { a.ph_lo = p; a.ph_hi = p + 1; void* args[] = {&a};
        hipError_t e = hipLaunchCooperativeKernel((const void*)hymba_fwd, dim3(grid), dim3(512), args, LDS_BYTES, stream);
        if (e != hipSuccess) { fprintf(stderr, "cooperative launch %d failed: %s (grid %d)\n", p, hipGetErrorString(e), grid); break; } }
#endif
}
```

```cpp
#include <hip/hip_runtime.h>
#include <hip/hip_cooperative_groups.h>
#include <cstdio>
#include <cstdint>
namespace cg = cooperative_groups;
namespace pg8 {
#define PG8_LAS __attribute__((address_space(3)))
typedef unsigned short bf16_t;
typedef short bf16x8 __attribute__((ext_vector_type(8)));
typedef float f32x4 __attribute__((ext_vector_type(4)));
typedef unsigned u32x4 __attribute__((ext_vector_type(4)));
constexpr int BM = 256, BK = 64, HALF = 128, HTB = HALF * BK * 2  , STAGE_BYTES = 8 * HTB, NXCD = 8, WGM = 8;

__host__ __device__ __forceinline__ int lds_byte(int r, int c) { const int st = (r >> 4) * 2 + (c >> 5), rr = r & 15, cc = c & 31, ob = rr * 64 + cc * 2; return st * 1024 + (ob ^ (((ob >> 9) & 1) << 5)); }
__host__ __device__ __forceinline__ void stage_rc(int b, int& R, int& C) { const int st = b / 1024, sb = b % 1024, swz = sb ^ (((sb >> 9) & 1) << 5); R = (st >> 1) * 16 + swz / 64; C = (st & 1) * 32 + (swz % 64) / 2; }
__host__ __device__ __forceinline__ int perm32(int rho) { const int n = rho >> 4, i = rho & 15; return 8 * (i >> 2) + 4 * n + (i & 3); }

struct Unit { int pm, pn, ko; };
struct Gemm { const bf16_t* A; const bf16_t* Bt; int M, N, K, ld; };

struct StaticOrder {
    int nM, nN, nwg, G, c;
    __host__ __device__ void init(int M, int N, int G_, int c_) { nM = M / BM; nN = N / BM; nwg = nM * nN; G = G_; c = c_; }
    __host__ __device__ bool next(int i, Unit& u) const {
        const long L = (long)i * G + c; if (L >= nwg) return false;
        int wgid = (int)L; { const int q = nwg / NXCD, r = nwg % NXCD, xcd = wgid % NXCD, off = wgid / NXCD; wgid = (xcd < r ? xcd * (q + 1) : r * (q + 1) + (xcd - r) * q) + off; }
        const int nig = WGM * nN, gid = wgid / nig, fm = gid * WGM, gsz = (nM - fm) < WGM ? (nM - fm) : WGM;
        u.pm = fm + ((wgid % nig) % gsz); u.pn = (wgid % nig) / gsz; u.ko = 0; return true;
    }
    __device__ __forceinline__ void a_ready(const Unit&) const {}
    __device__ __forceinline__ void done(const Unit&) const {}
};

__device__ __forceinline__ unsigned cvt_pk_bf16(float lo, float hi) { unsigned r; asm volatile("v_cvt_pk_bf16_f32 %0, %1, %2" : "=v"(r) : "v"(lo), "v"(hi)); return r; }
typedef unsigned u32x2 __attribute__((ext_vector_type(2)));
template <int ACT> struct EpiBf16 {
    static constexpr bool PERM = true, AFTER_DRAIN = false, KSCALE = false;
    bf16_t* O; int ldc;
    __device__ __forceinline__ void operator()(const f32x4 (&acc)[2][2][4][2], const Unit& u, int wr, int wc, int fr, int fq) const {
        const int row0 = u.pm * BM + wr * 64 + fr; const int col0 = u.pn * BM + wc * 32 + 8 * fq;
#pragma unroll
        for (int ai = 0; ai < 2; ++ai)
#pragma unroll
            for (int m = 0; m < 4; ++m) { bf16_t* rowp = O + (size_t)(row0 + ai * HALF + m * 16) * ldc + col0;
#pragma unroll
                for (int bj = 0; bj < 2; ++bj) { f32x4 v0 = acc[ai][bj][m][0], v1 = acc[ai][bj][m][1];
                    if (ACT == 2) {
#pragma unroll
                        for (int e = 0; e < 4; ++e) { float a = fmaxf(v0[e], 0.f), b = fmaxf(v1[e], 0.f); v0[e] = a * a; v1[e] = b * b; } }
                    u32x4 w; w.x = cvt_pk_bf16(v0[0], v0[1]); w.y = cvt_pk_bf16(v0[2], v0[3]); w.z = cvt_pk_bf16(v1[0], v1[1]); w.w = cvt_pk_bf16(v1[2], v1[3]);
                    *(u32x4*)(rowp + bj * HALF) = w; } }
    }
};
struct EpiRes {
    static constexpr bool PERM = false, AFTER_DRAIN = false, KSCALE = false;
    const float* base_lo; const float* base_hi; float* out; int ldc; int split_pm;
    __device__ __forceinline__ void operator()(const f32x4 (&acc)[2][2][4][2], const Unit& u, int wr, int wc, int fr, int fq) const {
        const float* base = (u.pm < split_pm) ? base_lo : base_hi;
        const int col0 = u.pn * BM + wc * 32 + 4 * fq;
#pragma unroll
        for (int ai = 0; ai < 2; ++ai)
#pragma unroll
            for (int m = 0; m < 4; ++m) { const size_t off = (size_t)(u.pm * BM + ai * HALF + wr * 64 + m * 16 + fr) * ldc + col0;
                f32x4 bs[2][2];
#pragma unroll
                for (int bj = 0; bj < 2; ++bj)
#pragma unroll
                    for (int n = 0; n < 2; ++n) bs[bj][n] = *(const f32x4*)(base + off + bj * HALF + n * 16);
#pragma unroll
                for (int bj = 0; bj < 2; ++bj)
#pragma unroll
                    for (int n = 0; n < 2; ++n) *(f32x4*)(out + off + bj * HALF + n * 16) = bs[bj][n] + acc[ai][bj][m][n];
                asm volatile("" ::: "memory"); }
    }
};

struct SplitKOrder {
    int nN, nsplit, kslice, pm0, G, c;
    __host__ __device__ void init(int N, int nsplit_, int kslice_, int pm0_, int G_, int c_) { nN = N / BM; nsplit = nsplit_; kslice = kslice_; pm0 = pm0_; G = G_; c = c_; }
    __host__ __device__ bool next(int i, Unit& u) const {
        const int L = i * G + c; if (L >= 2 * nN * nsplit) return false;
        const int ks = L % nsplit, t = L / nsplit; u.pn = t % nN; u.pm = pm0 + t / nN; u.ko = ks * kslice; return true; }
    __device__ __forceinline__ void a_ready(const Unit&) const {}
    __device__ __forceinline__ void done(const Unit&) const {}
};
struct EpiPartial {
    static constexpr bool PERM = false, AFTER_DRAIN = false, KSCALE = false;
    float* P; int ldc, kslice, row0, rows;
    __device__ __forceinline__ void operator()(const f32x4 (&acc)[2][2][4][2], const Unit& u, int wr, int wc, int fr, int fq) const {
        const int col0 = u.pn * BM + wc * 32 + 4 * fq; float* base = P + (size_t)(u.ko / kslice) * rows * ldc;
#pragma unroll
        for (int ai = 0; ai < 2; ++ai)
#pragma unroll
            for (int m = 0; m < 4; ++m) { float* p = base + (size_t)(u.pm * BM + ai * HALF + wr * 64 + m * 16 + fr - row0) * ldc + col0;
#pragma unroll
                for (int bj = 0; bj < 2; ++bj)
#pragma unroll
                    for (int n = 0; n < 2; ++n) *(f32x4*)(p + bj * HALF + n * 16) = acc[ai][bj][m][n]; }
    }
};

__device__ __forceinline__ float bf_lo(unsigned w) { return __builtin_bit_cast(float, w << 16); }
__device__ __forceinline__ float bf_hi(unsigned w) { return __builtin_bit_cast(float, w & 0xffff0000u); }
template <int ACT, bool GATES> struct EpiScale {
    static constexpr bool PERM = true, AFTER_DRAIN = false, KSCALE = false;
    bf16_t* O; int ldc; const float* ssq; float inv_k, eps; float* gt; const float* bi; const float* bf; int gate_pn;
    __device__ __forceinline__ void operator()(const f32x4 (&acc)[2][2][4][2], const Unit& u, int wr, int wc, int fr, int fq) const {
        const int row0 = u.pm * BM + wr * 64 + fr; const int col0 = u.pn * BM + wc * 32 + 8 * fq;
        if (GATES && u.pn == gate_pn) {
            if (wc == 0 && fq == 0) { const f32x4 vbi = *(const f32x4*)bi, vbf = *(const f32x4*)bf;
#pragma unroll
                for (int ai = 0; ai < 2; ++ai)
#pragma unroll
                    for (int m = 0; m < 4; ++m) { const int row = row0 + ai * HALF + m * 16; const float r = 1.0f / sqrtf(ssq[row] * inv_k + eps);
                        const f32x4 gi = acc[ai][0][m][0] * r + vbi; const f32x4 z = acc[ai][0][m][1] * r + vbf; f32x4 lf;
#pragma unroll
                        for (int e2 = 0; e2 < 4; ++e2) lf[e2] = fminf(z[e2], 0.f) - log1pf(expf(-fabsf(z[e2])));
                        *(f32x4*)(gt + (size_t)row * 8) = gi; *(f32x4*)(gt + (size_t)row * 8 + 4) = lf; } }
            return; }
        float rr[2][4];
#pragma unroll
        for (int ai = 0; ai < 2; ++ai)
#pragma unroll
            for (int m = 0; m < 4; ++m) rr[ai][m] = ssq[row0 + ai * HALF + m * 16];
        asm volatile("" : "+v"(rr[0][0]), "+v"(rr[0][1]), "+v"(rr[0][2]), "+v"(rr[0][3]), "+v"(rr[1][0]), "+v"(rr[1][1]), "+v"(rr[1][2]), "+v"(rr[1][3]));
#pragma unroll
        for (int ai = 0; ai < 2; ++ai)
#pragma unroll
            for (int m = 0; m < 4; ++m) rr[ai][m] = 1.0f / sqrtf(rr[ai][m] * inv_k + eps);
#pragma unroll
        for (int ai = 0; ai < 2; ++ai)
#pragma unroll
            for (int m = 0; m < 4; ++m) asm volatile("" : "+v"(rr[ai][m]));
#pragma unroll
        for (int ai = 0; ai < 2; ++ai)
#pragma unroll
            for (int m = 0; m < 4; ++m) { const int row = row0 + ai * HALF + m * 16; const float r = rr[ai][m];
                bf16_t* rowp = O + (size_t)row * ldc + col0;
#pragma unroll
                for (int bj = 0; bj < 2; ++bj) { f32x4 v0 = acc[ai][bj][m][0] * r, v1 = acc[ai][bj][m][1] * r;
                    if (ACT == 2) {
#pragma unroll
                        for (int e2 = 0; e2 < 4; ++e2) { float p = fmaxf(v0[e2], 0.f), q = fmaxf(v1[e2], 0.f); v0[e2] = p * p; v1[e2] = q * q; } }
                    u32x4 w; w.x = cvt_pk_bf16(v0[0], v0[1]); w.y = cvt_pk_bf16(v0[2], v0[3]); w.z = cvt_pk_bf16(v1[0], v1[1]); w.w = cvt_pk_bf16(v1[2], v1[3]);
                    *(u32x4*)(rowp + bj * HALF) = w; } }
    }
};
struct EpiResB {
    static constexpr bool PERM = true, AFTER_DRAIN = false, KSCALE = false;
    bf16_t* X; int ldc; float* ssq;
    __device__ __forceinline__ void operator()(const f32x4 (&acc)[2][2][4][2], const Unit& u, int wr, int wc, int fr, int fq) const {
        const int row0 = u.pm * BM + wr * 64 + fr; const int col0 = u.pn * BM + wc * 32 + 8 * fq;
        u32x4 b[2][4][2];
#pragma unroll
        for (int ai = 0; ai < 2; ++ai)
#pragma unroll
            for (int m = 0; m < 4; ++m)
#pragma unroll
                for (int bj = 0; bj < 2; ++bj) b[ai][m][bj] = *(const u32x4*)(X + (size_t)(row0 + ai * HALF + m * 16) * ldc + col0 + bj * HALF);
        __builtin_amdgcn_s_waitcnt(0x0F70); asm volatile("" ::: "memory");
#pragma unroll
        for (int ai = 0; ai < 2; ++ai)
#pragma unroll
            for (int m = 0; m < 4; ++m) { const int row = row0 + ai * HALF + m * 16; bf16_t* rowp = X + (size_t)row * ldc + col0; float q = 0.f;
#pragma unroll
                for (int bj = 0; bj < 2; ++bj) { const u32x4 bb = b[ai][m][bj];
                    const f32x4 v0 = acc[ai][bj][m][0] + (f32x4){bf_lo(bb.x), bf_hi(bb.x), bf_lo(bb.y), bf_hi(bb.y)};
                    const f32x4 v1 = acc[ai][bj][m][1] + (f32x4){bf_lo(bb.z), bf_hi(bb.z), bf_lo(bb.w), bf_hi(bb.w)};
                    q += (v0[0] * v0[0] + v0[1] * v0[1]) + (v0[2] * v0[2] + v0[3] * v0[3]) + (v1[0] * v1[0] + v1[1] * v1[1]) + (v1[2] * v1[2] + v1[3] * v1[3]);
                    u32x4 w; w.x = cvt_pk_bf16(v0[0], v0[1]); w.y = cvt_pk_bf16(v0[2], v0[3]); w.z = cvt_pk_bf16(v1[0], v1[1]); w.w = cvt_pk_bf16(v1[2], v1[3]);
                    *(u32x4*)(rowp + bj * HALF) = w; }
                q += __shfl_xor(q, 16); q += __shfl_xor(q, 32);
                if (fq == 0) unsafeAtomicAdd(ssq + row, q); }
    }
};
struct EpiResF {
    static constexpr bool PERM = true, AFTER_DRAIN = false, KSCALE = false;
    const bf16_t* X; float* Y; int ldc;
    __device__ __forceinline__ void operator()(const f32x4 (&acc)[2][2][4][2], const Unit& u, int wr, int wc, int fr, int fq) const {
        const int row0 = u.pm * BM + wr * 64 + fr; const int col0 = u.pn * BM + wc * 32 + 8 * fq;
        u32x4 b[2][4][2];
#pragma unroll
        for (int ai = 0; ai < 2; ++ai)
#pragma unroll
            for (int m = 0; m < 4; ++m)
#pragma unroll
                for (int bj = 0; bj < 2; ++bj) b[ai][m][bj] = *(const u32x4*)(X + (size_t)(row0 + ai * HALF + m * 16) * ldc + col0 + bj * HALF);
        __builtin_amdgcn_s_waitcnt(0x0F70); asm volatile("" ::: "memory");
#pragma unroll
        for (int ai = 0; ai < 2; ++ai)
#pragma unroll
            for (int m = 0; m < 4; ++m) { const size_t off = (size_t)(row0 + ai * HALF + m * 16) * ldc + col0;
#pragma unroll
                for (int bj = 0; bj < 2; ++bj) { const u32x4 bb = b[ai][m][bj];
                    *(f32x4*)(Y + off + bj * HALF) = acc[ai][bj][m][0] + (f32x4){bf_lo(bb.x), bf_hi(bb.x), bf_lo(bb.y), bf_hi(bb.y)};
                    *(f32x4*)(Y + off + bj * HALF + 4) = acc[ai][bj][m][1] + (f32x4){bf_lo(bb.z), bf_hi(bb.z), bf_lo(bb.w), bf_hi(bb.w)}; } }
    }
};

struct EpiResBK {
    static constexpr bool PERM = true, AFTER_DRAIN = false, KSCALE = true;
    static constexpr int TBL_OFF = 131072 + 256, TBL_BYTES = 256 * 5 * 4;
    bf16_t* X; int ldc; float* ssq; const float* hsq; float eps;
    __device__ __forceinline__ void unit_begin(PG8_LAS unsigned char* lds, const Unit& u, int ui, int tid) const {
        if (tid < 256) { const float* hp = hsq + (size_t)(u.pm * BM + tid) * 8; const f32x4 h4 = *(const f32x4*)hp; const float ha = hp[4];
            const float x0 = h4[0] * (1.0f / 256.0f) + eps, x1 = h4[1] * (1.0f / 256.0f) + eps, x2 = h4[2] * (1.0f / 256.0f) + eps, x3 = h4[3] * (1.0f / 256.0f) + eps, xa = ha * (1.0f / 1024.0f) + eps;
            PG8_LAS float* T = (PG8_LAS float*)(lds + TBL_OFF + (ui & 1) * TBL_BYTES) + tid * 5;
            T[0] = __builtin_sqrtf(x1 * __builtin_amdgcn_rcpf(x0)); T[1] = __builtin_sqrtf(x2 * __builtin_amdgcn_rcpf(x1)); T[2] = __builtin_sqrtf(x3 * __builtin_amdgcn_rcpf(x2));
            T[3] = __builtin_sqrtf(xa * __builtin_amdgcn_rcpf(x3)); T[4] = 1.0f / sqrtf(xa); }
    }
    __device__ __forceinline__ void kscale(f32x4 (&acc)[2][2][4][2], PG8_LAS unsigned char* lds, int ui, int seg, int wr, int fr) const {
        const PG8_LAS float* T = (const PG8_LAS float*)(lds + TBL_OFF + (ui & 1) * TBL_BYTES) + (wr * 64 + fr) * 5 + seg - 1;
#pragma unroll
        for (int ai = 0; ai < 2; ++ai)
#pragma unroll
            for (int m = 0; m < 4; ++m) { const float f = T[(ai * HALF + m * 16) * 5];
#pragma unroll
                for (int bj = 0; bj < 2; ++bj)
#pragma unroll
                    for (int n = 0; n < 2; ++n) acc[ai][bj][m][n] = acc[ai][bj][m][n] * f; }
    }
    __device__ __forceinline__ void epi(const f32x4 (&acc)[2][2][4][2], const Unit& u, PG8_LAS unsigned char* lds, int ui, int wr, int wc, int fr, int fq) const {
        const int row0 = u.pm * BM + wr * 64 + fr; const int col0 = u.pn * BM + wc * 32 + 8 * fq;
        const PG8_LAS float* T = (const PG8_LAS float*)(lds + TBL_OFF + (ui & 1) * TBL_BYTES) + (wr * 64 + fr) * 5 + 4;
        u32x4 b[2][4][2];
#pragma unroll
        for (int ai = 0; ai < 2; ++ai)
#pragma unroll
            for (int m = 0; m < 4; ++m)
#pragma unroll
                for (int bj = 0; bj < 2; ++bj) b[ai][m][bj] = *(const u32x4*)(X + (size_t)(row0 + ai * HALF + m * 16) * ldc + col0 + bj * HALF);
        __builtin_amdgcn_s_waitcnt(0x0F70); asm volatile("" ::: "memory");
#pragma unroll
        for (int ai = 0; ai < 2; ++ai)
#pragma unroll
            for (int m = 0; m < 4; ++m) { const int row = row0 + ai * HALF + m * 16; bf16_t* rowp = X + (size_t)row * ldc + col0; float q = 0.f; const float ra = T[(ai * HALF + m * 16) * 5];
#pragma unroll
                for (int bj = 0; bj < 2; ++bj) { const u32x4 bb = b[ai][m][bj];
                    const f32x4 v0 = acc[ai][bj][m][0] * ra + (f32x4){bf_lo(bb.x), bf_hi(bb.x), bf_lo(bb.y), bf_hi(bb.y)};
                    const f32x4 v1 = acc[ai][bj][m][1] * ra + (f32x4){bf_lo(bb.z), bf_hi(bb.z), bf_lo(bb.w), bf_hi(bb.w)};
                    q += (v0[0] * v0[0] + v0[1] * v0[1]) + (v0[2] * v0[2] + v0[3] * v0[3]) + (v1[0] * v1[0] + v1[1] * v1[1]) + (v1[2] * v1[2] + v1[3] * v1[3]);
                    u32x4 w; w.x = cvt_pk_bf16(v0[0], v0[1]); w.y = cvt_pk_bf16(v0[2], v0[3]); w.z = cvt_pk_bf16(v1[0], v1[1]); w.w = cvt_pk_bf16(v1[2], v1[3]);
                    *(u32x4*)(rowp + bj * HALF) = w; }
                q += __shfl_xor(q, 16); q += __shfl_xor(q, 32);
                if (fq == 0) unsafeAtomicAdd(ssq + row, q); }
    }
};

template <class Epi, class Sched, bool ALIGN_EPI = false, bool SP2 = false>
__device__ __forceinline__ void gemm_phase(PG8_LAS unsigned char* lds, const Gemm g, const Sched& S, const Epi& E) {
    int tid_ = threadIdx.x; asm volatile("" : "+v"(tid_)); const int tid = tid_, wid = __builtin_amdgcn_readfirstlane(tid >> 6), lane = tid & 63, wr = wid >> 2, wc = wid & 3, fr = lane & 15, fq = lane >> 4;
    const int K = g.ld, nt = g.K / BK;
    unsigned voffA[2], voffB[2];
#pragma unroll
    for (int i = 0; i < 2; ++i) { int R, C; stage_rc(tid * 16 + i * 8192, R, C); const int Rb = Epi::PERM ? ((R & ~31) + perm32(R & 31)) : R;
        voffA[i] = (unsigned)(R * K + C) * 2u; voffB[i] = (unsigned)(Rb * K + C) * 2u; }
    const size_t kstep = (size_t)(BK * 2);
    const size_t hstep = (size_t)HALF * K * 2;
    const size_t tstep = 2 * hstep;
    const unsigned ldsw = (unsigned)wid * 1024u;
    const int aoff = lds_byte(wr * 64 + fr, fq * 8), boff = lds_byte(wc * 32 + fr, fq * 8);
#define PG8_SA(b, h) (((b) * 2 + (h)) * HTB)
#define PG8_SB(b, h) ((4 + (b) * 2 + (h)) * HTB)
#define PG8_STAGE(bufoff, gbase, voff) do { _Pragma("unroll") for (int _i = 0; _i < 2; ++_i) \
        __builtin_amdgcn_global_load_lds((const unsigned*)((const char*)(gbase) + (voff)[_i]), (PG8_LAS unsigned*)(lds + (bufoff) + ldsw + _i * 8192), 16, 0, 0); } while (0)
#define PG8_LDA(dst, b, h) do { _Pragma("unroll") for (int m = 0; m < 4; ++m) _Pragma("unroll") for (int k = 0; k < 2; ++k) dst[m][k] = *(const PG8_LAS bf16x8*)(lds + PG8_SA(b, h) + aoff + m * 2048 + k * 1024); } while (0)
#define PG8_LDB(dst, b, h) do { _Pragma("unroll") for (int n = 0; n < 2; ++n) _Pragma("unroll") for (int k = 0; k < 2; ++k) dst[n][k] = *(const PG8_LAS bf16x8*)(lds + PG8_SB(b, h) + boff + n * 2048 + k * 1024); } while (0)
#define PG8_MMA(ai, bj, At, Bt) do { __builtin_amdgcn_s_setprio(1); _Pragma("unroll") for (int m = 0; m < 4; ++m) _Pragma("unroll") for (int n = 0; n < 2; ++n) _Pragma("unroll") for (int k = 0; k < 2; ++k) \
        acc[ai][bj][m][n] = __builtin_amdgcn_mfma_f32_16x16x32_bf16(Bt[n][k], At[m][k], acc[ai][bj][m][n], 0, 0, 0); __builtin_amdgcn_s_setprio(0); } while (0)
#define PG8_WAIT_V(n) asm volatile("s_waitcnt vmcnt(" #n ")" ::: "memory")
#define PG8_WAIT_L(n) asm volatile("s_waitcnt lgkmcnt(" #n ")" ::: "memory")
#define PG8_BAR __builtin_amdgcn_s_barrier()
#define PG8_SCHED __builtin_amdgcn_sched_barrier(0)
    Unit cur, nxt; int ui = 0;
    if (!S.next(0, cur)) return;
    f32x4 acc[2][2][4][2];
#pragma unroll
    for (int a = 0; a < 2; ++a)
#pragma unroll
        for (int b = 0; b < 2; ++b)
#pragma unroll
            for (int m = 0; m < 4; ++m)
#pragma unroll
                for (int n = 0; n < 2; ++n) acc[a][b][m][n] = (f32x4){0.f, 0.f, 0.f, 0.f};
    bf16x8 At[4][2], B0[2][2], B1[2][2];
    const char* cA = (const char*)g.A + (size_t)cur.pm * tstep + (size_t)cur.ko * 2; const char* cB = (const char*)g.Bt + (size_t)cur.pn * tstep + (size_t)cur.ko * 2;
    S.a_ready(cur);
    if constexpr (Epi::KSCALE) E.unit_begin(lds, cur, ui, tid);
    if constexpr (SP2) {
        PG8_STAGE(PG8_SB(0, 0), cB, voffB); PG8_STAGE(PG8_SB(0, 1), cB + hstep, voffB); PG8_STAGE(PG8_SA(0, 0), cA, voffA); PG8_STAGE(PG8_SA(0, 1), cA + hstep, voffA);
        if (wr == 1) PG8_BAR;
        PG8_WAIT_V(2); PG8_BAR;
        PG8_STAGE(PG8_SB(1, 0), cB + kstep, voffB); PG8_STAGE(PG8_SA(1, 0), cA + kstep, voffA); PG8_STAGE(PG8_SB(1, 1), cB + hstep + kstep, voffB);
        PG8_WAIT_V(6); PG8_BAR;
    } else {
        PG8_STAGE(PG8_SB(0, 0), cB, voffB); PG8_STAGE(PG8_SA(0, 0), cA, voffA); PG8_STAGE(PG8_SB(0, 1), cB + hstep, voffB); PG8_STAGE(PG8_SA(0, 1), cA + hstep, voffA);
        if (wr == 1) PG8_BAR;
        PG8_WAIT_V(4); PG8_BAR;
        PG8_STAGE(PG8_SB(1, 0), cB + kstep, voffB); PG8_STAGE(PG8_SA(1, 0), cA + kstep, voffA); PG8_STAGE(PG8_SB(1, 1), cB + hstep + kstep, voffB);
        PG8_WAIT_V(6); PG8_BAR;
    }
    for (;;) {
        const bool has_next = S.next(ui + 1, nxt);
        const char* nA = has_next ? (const char*)g.A + (size_t)nxt.pm * tstep + (size_t)nxt.ko * 2 : cA; const char* nB = has_next ? (const char*)g.Bt + (size_t)nxt.pn * tstep + (size_t)nxt.ko * 2 : cB;
        for (int t = 0; t < nt; t += 2) {
            const bool last = (t == nt - 2);
            if constexpr (Epi::KSCALE) { if (t == 4 || t == 8 || t == 12 || t == 16) E.kscale(acc, lds, ui, t >> 2, wr, fr); }
            const char* a1 = cA + (size_t)(t + 1) * kstep;
            const char* a2 = last ? nA : cA + (size_t)(t + 2) * kstep; const char* b2 = last ? nB : cB + (size_t)(t + 2) * kstep;
            const char* a3 = a2 + kstep; const char* b3 = b2 + kstep;
            if (last && has_next) S.a_ready(nxt);
            if constexpr (SP2) {
            PG8_LDB(B0, 0, 0); PG8_LDB(B1, 0, 1); PG8_SCHED; PG8_LDA(At, 0, 0); PG8_STAGE(PG8_SA(1, 1), a1 + hstep, voffA);
            PG8_WAIT_V(8); PG8_WAIT_L(0); PG8_BAR; PG8_MMA(0, 0, At, B0); PG8_MMA(0, 1, At, B1); PG8_BAR; PG8_SCHED;
            PG8_LDA(At, 0, 1); PG8_STAGE(PG8_SB(0, 0), b2, voffB); PG8_STAGE(PG8_SB(0, 1), b2 + hstep, voffB); PG8_STAGE(PG8_SA(0, 0), a2, voffA);
            PG8_WAIT_V(8); PG8_WAIT_L(0); PG8_BAR; PG8_MMA(1, 0, At, B0); PG8_MMA(1, 1, At, B1); PG8_BAR; PG8_SCHED;
            PG8_LDB(B0, 1, 0); PG8_LDB(B1, 1, 1); PG8_SCHED; PG8_LDA(At, 1, 0); PG8_STAGE(PG8_SA(0, 1), a2 + hstep, voffA);
            PG8_WAIT_V(8); PG8_WAIT_L(0); PG8_BAR; PG8_MMA(0, 0, At, B0); PG8_MMA(0, 1, At, B1); PG8_BAR; PG8_SCHED;
            PG8_LDA(At, 1, 1); PG8_STAGE(PG8_SB(1, 0), b3, voffB); PG8_STAGE(PG8_SB(1, 1), b3 + hstep, voffB); PG8_STAGE(PG8_SA(1, 0), a3, voffA);
            PG8_WAIT_V(8); PG8_WAIT_L(0); PG8_BAR; PG8_MMA(1, 0, At, B0); PG8_MMA(1, 1, At, B1); PG8_BAR; PG8_SCHED;
            } else {
            PG8_LDB(B0, 0, 0); PG8_SCHED; PG8_LDA(At, 0, 0); PG8_STAGE(PG8_SA(1, 1), a1 + hstep, voffA);
            PG8_WAIT_L(8); PG8_BAR; PG8_WAIT_L(0); PG8_MMA(0, 0, At, B0); PG8_BAR; PG8_SCHED;
            PG8_LDB(B1, 0, 1); PG8_STAGE(PG8_SB(0, 0), b2, voffB);
            PG8_BAR; PG8_WAIT_L(0); PG8_MMA(0, 1, At, B1); PG8_BAR;
            PG8_LDA(At, 0, 1); PG8_STAGE(PG8_SA(0, 0), a2, voffA);
            PG8_BAR; PG8_WAIT_L(0); PG8_MMA(1, 0, At, B0); PG8_BAR; PG8_SCHED;
            PG8_STAGE(PG8_SB(0, 1), b2 + hstep, voffB);
            PG8_WAIT_V(6); PG8_BAR; PG8_MMA(1, 1, At, B1); PG8_BAR;
            PG8_LDB(B0, 1, 0); PG8_SCHED; PG8_LDA(At, 1, 0); PG8_STAGE(PG8_SA(0, 1), a2 + hstep, voffA);
            PG8_WAIT_L(8); PG8_BAR; PG8_WAIT_L(0); PG8_MMA(0, 0, At, B0); PG8_BAR; PG8_SCHED;
            PG8_LDB(B1, 1, 1); PG8_STAGE(PG8_SB(1, 0), b3, voffB);
            PG8_BAR; PG8_WAIT_L(0); PG8_MMA(0, 1, At, B1); PG8_BAR;
            PG8_LDA(At, 1, 1); PG8_STAGE(PG8_SA(1, 0), a3, voffA);
            PG8_BAR; PG8_WAIT_L(0); PG8_MMA(1, 0, At, B0); PG8_BAR; PG8_SCHED;
            PG8_STAGE(PG8_SB(1, 1), b3 + hstep, voffB);
            PG8_WAIT_V(6); PG8_BAR; PG8_MMA(1, 1, At, B1); PG8_BAR;
            }
        }
        if constexpr (ALIGN_EPI) { if (wr == 0) PG8_BAR; }
        if constexpr (Epi::KSCALE) { E.epi(acc, cur, lds, ui, wr, wc, fr, fq); S.done(cur); } else
        if constexpr (!Epi::AFTER_DRAIN) { E(acc, cur, wr, wc, fr, fq); S.done(cur); }
        if (!has_next) break;
#pragma unroll
        for (int a = 0; a < 2; ++a)
#pragma unroll
            for (int b = 0; b < 2; ++b)
#pragma unroll
                for (int m = 0; m < 4; ++m)
#pragma unroll
                    for (int n = 0; n < 2; ++n) acc[a][b][m][n] = (f32x4){0.f, 0.f, 0.f, 0.f};
        cur = nxt; cA = nA; cB = nB; ++ui;
        if constexpr (Epi::KSCALE) E.unit_begin(lds, cur, ui, tid);
        if constexpr (ALIGN_EPI) { if (wr == 1) PG8_BAR; }
    }
    PG8_WAIT_V(0);
    if constexpr (!ALIGN_EPI) { if (wr == 0) PG8_BAR; }
    PG8_BAR;
    if constexpr (Epi::AFTER_DRAIN) { E.fused(acc, cur, wr, wc, fr, fq, lds, wid, lane); S.done(cur); }
#undef PG8_SA
#undef PG8_SB
#undef PG8_STAGE
#undef PG8_LDA
#undef PG8_LDB
#undef PG8_MMA
#undef PG8_WAIT_V
#undef PG8_WAIT_L
#undef PG8_BAR
#undef PG8_SCHED
}
}
#define LAS __attribute__((address_space(3)))
typedef unsigned short bf16_t;
typedef short bf16x8 __attribute__((ext_vector_type(8)));
typedef float f32x4 __attribute__((ext_vector_type(4)));
typedef unsigned u32x4 __attribute__((ext_vector_type(4)));
typedef unsigned u32x2 __attribute__((ext_vector_type(2)));

constexpr int DM = 2048, NB = 16, SEQ = 2048, SB = 16, SL = 32, FF = 8192;
constexpr int MP = NB * SEQ;
constexpr int MS = SB * SL;
constexpr int MT = MP + MS;
constexpr int DIN = 4616, NPJ = 4608, NPW = 4864;
constexpr int DIN_UNUSED = 0;
constexpr int PJ_MQ = 0, PJ_MK = 512, PJ_MV = 1024, PJ_MO = 2048, PJ_AQ = 3072, PJ_AK = 4096, PJ_AV = 4352;
constexpr float EPS = 1e-6f;
constexpr size_t O_YP = 0, O_YS = 67108864, O_PCK = 68157440, O_PCV = 69206016, O_PC = 70254592, O_PN = 74448896, O_PM = 74465280,
                 O_SCK = 74465408, O_SCV = 75513984, O_SC = 76562560, O_SN = 80756864, O_SM = 80773248;
constexpr size_t MiB = 1u << 20;
constexpr size_t WS_WIN = 1 * MiB;
constexpr size_t WS_SSQ = 64 * 1024;
constexpr size_t WS_WOUT = WS_WIN + 38 * MiB;
constexpr size_t WS_WUP = WS_WOUT + 16 * MiB;
constexpr size_t WS_WDN = WS_WUP + 64 * MiB;
constexpr size_t WS_XN = WS_WDN + 64 * MiB;
constexpr size_t WS_GATES = WS_XN + 130 * MiB;
constexpr size_t WS_BIG = WS_GATES + 2 * MiB;
constexpr size_t WS_PROJ = WS_BIG, WS_MIX = WS_BIG + 293 * MiB;
constexpr size_t WS_PART = WS_BIG + 520 * MiB;
constexpr size_t WS_HSQ = WS_PART + 64 * MiB;
constexpr size_t WS_END = WS_HSQ + 3 * MiB;
constexpr int LDS_BYTES = 147456;

__device__ __forceinline__ unsigned f2bf(float f) { unsigned u = __builtin_bit_cast(unsigned, f); return (u + 0x7fffu + ((u >> 16) & 1u)) >> 16; }
__device__ __forceinline__ float bflo(unsigned w) { return __builtin_bit_cast(float, w << 16); }
__device__ __forceinline__ float bfhi(unsigned w) { return __builtin_bit_cast(float, w & 0xffff0000u); }
typedef float f32x2_t __attribute__((ext_vector_type(2)));
typedef __bf16 bf16x2_t __attribute__((ext_vector_type(2)));
__device__ __forceinline__ unsigned pkbf(float lo, float hi) { unsigned r; asm volatile("v_cvt_pk_bf16_f32 %0, %1, %2" : "=v"(r) : "v"(lo), "v"(hi)); return r; }
__device__ __forceinline__ unsigned pkbf_mfma(float lo, float hi) { const f32x2_t v = {lo, hi}; const bf16x2_t b = __builtin_convertvector(v, bf16x2_t); return __builtin_bit_cast(unsigned, b); }
__device__ __forceinline__ void unpack8(const u32x4 w, float (&f)[8]) { f[0] = bflo(w.x); f[1] = bfhi(w.x); f[2] = bflo(w.y); f[3] = bfhi(w.y); f[4] = bflo(w.z); f[5] = bfhi(w.z); f[6] = bflo(w.w); f[7] = bfhi(w.w); }
__device__ __forceinline__ float wave_sum(float v) {
#pragma unroll
    for (int o = 1; o < 64; o <<= 1) v += __shfl_xor(v, o);
    return v;
}
#define LDS_WAIT() asm volatile("s_waitcnt lgkmcnt(0)" ::: "memory")
#define MFMA16(a, b, c) __builtin_amdgcn_mfma_f32_16x16x32_bf16((a), (b), (c), 0, 0, 0)

struct Args { const float* in[21]; float* out; unsigned char* ws; int ph_lo, ph_hi; };
struct Ctx {
    LAS unsigned char* lds;
    int tid, lane, wave, G, bid;
};
#define FIN(i) (a.in[i])
#define FOUT (a.out)
#define FWS (a.ws)

__device__ __forceinline__ void transpose_item(const float* W, int ldw, int c0, int nvalid, int k0, bf16_t* WT, int Kdst, int r0, float scale, const float* gk, LAS float* scr, int lane) {
#pragma unroll 8
    for (int i = 0; i < 32; ++i) { const int kk = 2 * i + (lane >> 5); scr[kk * 33 + (lane & 31)] = ((lane & 31) < nvalid) ? W[(size_t)(k0 + kk) * ldw + c0 + (lane & 31)] : 0.f; }
    LDS_WAIT(); asm volatile("" ::: "memory");
    const int c = lane & 7;
    float sk[8];
#pragma unroll
    for (int e = 0; e < 8; ++e) sk[e] = gk ? scale * gk[k0 + 8 * c + e] : scale;
#pragma unroll
    for (int j = 0; j < 4; ++j) { const int n = (lane >> 3) + 8 * j; const LAS float* s = scr + (8 * c) * 33 + n;
        u32x4 o; o.x = pkbf(s[0 * 33] * sk[0], s[1 * 33] * sk[1]); o.y = pkbf(s[2 * 33] * sk[2], s[3 * 33] * sk[3]); o.z = pkbf(s[4 * 33] * sk[4], s[5 * 33] * sk[5]); o.w = pkbf(s[6 * 33] * sk[6], s[7 * 33] * sk[7]);
        *(u32x4*)(WT + (size_t)(r0 + n) * Kdst + k0 + 8 * c) = o; }
    LDS_WAIT(); asm volatile("" ::: "memory");
}
__device__ __forceinline__ void phase_weights(Ctx& F, const Args& a) {
    LAS float* scr = (LAS float*)(F.lds + F.wave * 16384);
    const int gw = F.bid * 8 + F.wave, NGW = F.G * 8;
    constexpr int I_IN = 32 * 152, I_OUT = 32 * 64, I_UP = 32 * 256, I_DN = 128 * 64, I_L = I_IN + I_OUT + I_UP + I_DN;
    for (int it = gw; it < 2 * I_L; it += NGW) {
        const int l = it / I_L; int r = it % I_L;
        if (r < I_IN) { const int kb = r / 152, nb = r % 152, n0 = nb * 32;
            const int c0 = n0 < 3072 ? n0 : (n0 < 4608 ? n0 + 8 : 3072); const int nvalid = n0 < 4608 ? 32 : (n0 == 4608 ? 8 : 0);
            const float sc = (n0 >= PJ_MK && n0 < PJ_MV) ? 0.08838834764831845f : 1.0f;
            transpose_item(FIN(9) + (size_t)l * DM * DIN, DIN, c0, nvalid, kb * 64, (bf16_t*)(FWS + WS_WIN) + (size_t)l * NPW * DM, DM, n0, sc, FIN(8) + l * DM, scr, F.lane); continue; }
        r -= I_IN;
        if (r < I_OUT) { const int kb = r / 64, nb = r % 64;
            transpose_item(FIN(17) + (size_t)l * DM * DM, DM, nb * 32, 32, kb * 64, (bf16_t*)(FWS + WS_WOUT) + (size_t)l * DM * DM, DM, nb * 32, 1.0f, nullptr, scr, F.lane); continue; }
        r -= I_OUT;
        if (r < I_UP) { const int kb = r / 256, nb = r % 256;
            transpose_item(FIN(19) + (size_t)l * DM * FF, FF, nb * 32, 32, kb * 64, (bf16_t*)(FWS + WS_WUP) + (size_t)l * FF * DM, DM, nb * 32, 1.0f, FIN(18) + l * DM, scr, F.lane); continue; }
        r -= I_UP;
        { const int kb = r / 64, nb = r % 64;
            transpose_item(FIN(20) + (size_t)l * FF * DM, DM, nb * 32, 32, kb * 64, (bf16_t*)(FWS + WS_WDN) + (size_t)l * DM * FF, FF, nb * 32, 1.0f, nullptr, scr, F.lane); }
    }
}

__device__ __forceinline__ void phase_convert(Ctx& F, const Args& a) {
    bf16_t* XB = (bf16_t*)(FWS + WS_XN); float* SSQ = (float*)(FWS + WS_SSQ);
    const float* xlo = FIN(0); const float* xhi = FIN(1) - (size_t)MP * DM;
    const int gw = F.bid * 8 + F.wave, NGW = F.G * 8;
    f32x4 v[8], vn[8];
    if (gw < MT) { const float* xr = (gw < MP ? xlo : xhi) + (size_t)gw * DM + 4 * F.lane;
#pragma unroll
        for (int j = 0; j < 8; ++j) v[j] = *(const f32x4*)(xr + 256 * j); }
    for (int m = gw; m < MT; m += NGW) {
        const int mn = m + NGW;
        if (mn < MT) { const float* xr = (mn < MP ? xlo : xhi) + (size_t)mn * DM + 4 * F.lane;
#pragma unroll
            for (int j = 0; j < 8; ++j) vn[j] = *(const f32x4*)(xr + 256 * j); }
        float ss = 0.f; bf16_t* orow = XB + (size_t)m * DM + 4 * F.lane;
#pragma unroll
        for (int j = 0; j < 8; ++j) { ss += (v[j].x * v[j].x + v[j].y * v[j].y) + (v[j].z * v[j].z + v[j].w * v[j].w);
            u32x2 w; w.x = pkbf(v[j].x, v[j].y); w.y = pkbf(v[j].z, v[j].w); *(u32x2*)(orow + 256 * j) = w; }
        ss = wave_sum(ss);
        if (F.lane == 0) { SSQ[m] = ss; SSQ[MT + m] = 0.f; SSQ[2 * MT + m] = 0.f; SSQ[3 * MT + m] = 0.f; }
        if (F.lane < 16) ((float*)(FWS + WS_HSQ))[(size_t)(F.lane >> 3) * MT * 8 + (size_t)m * 8 + (F.lane & 7)] = 0.f;
#pragma unroll
        for (int j = 0; j < 8; ++j) v[j] = vn[j];
    }
}
__device__ __forceinline__ void phase_fold(Ctx& F, const Args& a, float* ssq, float* yout, const float* hsq) {
    bf16_t* XB = (bf16_t*)(FWS + WS_XN); const float* part = (const float*)(FWS + WS_PART);
    for (int m = MP + F.bid * 8 + F.wave; m < MT; m += F.G * 8) {
        bf16_t* xr = XB + (size_t)m * DM; f32x4 v[8];
#pragma unroll
        for (int j = 0; j < 4; ++j) { const u32x4 b = *(const u32x4*)(xr + (F.lane + 64 * j) * 8); float f[8]; unpack8(b, f);
            v[2 * j] = (f32x4){f[0], f[1], f[2], f[3]}; v[2 * j + 1] = (f32x4){f[4], f[5], f[6], f[7]}; }
        for (int k = 0; k < 16; ++k) { const float* pp = part + ((size_t)k * MS + (m - MP)) * DM;
            float sc = 1.0f;
            if (hsq) { const int sg = k < 8 ? (k >> 1) : 4; sc = 1.0f / sqrtf(hsq[(size_t)m * 8 + sg] * (sg < 4 ? (1.0f / 256.0f) : (1.0f / 1024.0f)) + EPS); }
#pragma unroll
            for (int j = 0; j < 4; ++j) { v[2 * j] += *(const f32x4*)(pp + (F.lane + 64 * j) * 8) * sc; v[2 * j + 1] += *(const f32x4*)(pp + (F.lane + 64 * j) * 8 + 4) * sc; } }
        if (yout) {
#pragma unroll
            for (int j = 0; j < 4; ++j) { *(f32x4*)(yout + (size_t)m * DM + (F.lane + 64 * j) * 8) = v[2 * j]; *(f32x4*)(yout + (size_t)m * DM + (F.lane + 64 * j) * 8 + 4) = v[2 * j + 1]; }
        } else { float ss = 0.f;
#pragma unroll
            for (int j = 0; j < 4; ++j) { const f32x4 p = v[2 * j], q = v[2 * j + 1];
                ss += (p.x * p.x + p.y * p.y) + (p.z * p.z + p.w * p.w) + (q.x * q.x + q.y * q.y) + (q.z * q.z + q.w * q.w);
                u32x4 w; w.x = pkbf(p.x, p.y); w.y = pkbf(p.z, p.w); w.z = pkbf(q.x, q.y); w.w = pkbf(q.z, q.w); *(u32x4*)(xr + (F.lane + 64 * j) * 8) = w; }
            ss = wave_sum(ss); if (F.lane == 0) ssq[m] = ss; }
    }
}

template <bool GATES>
__device__ __forceinline__ void phase_norm(Ctx& F, const Args& a, const float* xlo, const float* xhi  , const float* gvec, int l, float* ycopy, const float* part) {
    bf16_t* XN = (bf16_t*)(FWS + WS_XN);
    float* GT = (float*)(FWS + WS_GATES);
    LAS f32x4* WG = (LAS f32x4*)F.lds;
    if (GATES) {
        const float* win = FIN(9) + (size_t)l * DM * DIN;
        for (int k = F.tid; k < DM; k += 512) { const int j = k >> 8, ln = (k & 255) >> 2, e = k & 3;
            const f32x4 wa = *(const f32x4*)(win + (size_t)k * DIN + 3072), wb = *(const f32x4*)(win + (size_t)k * DIN + 3076);
            WG[((j * 4 + e) * 2 + 0) * 64 + ln] = wa; WG[((j * 4 + e) * 2 + 1) * 64 + ln] = wb; }
        __syncthreads();
    }
    f32x4 gv[8];
#pragma unroll
    for (int j = 0; j < 8; ++j) gv[j] = *(const f32x4*)(gvec + 4 * F.lane + 256 * j);
    float bi[4], bfv[4];
    if (GATES) {
#pragma unroll
        for (int h = 0; h < 4; ++h) { bi[h] = FIN(10)[l * 4 + h]; bfv[h] = FIN(11)[l * 4 + h]; } }
    const int gw = F.bid * 8 + F.wave, NGW = F.G * 8;
    f32x4 v[8], vn[8];
    if (gw < MT) { const float* xr = (gw < MP ? xlo : xhi) + (size_t)gw * DM + 4 * F.lane;
#pragma unroll
        for (int j = 0; j < 8; ++j) v[j] = *(const f32x4*)(xr + 256 * j); }
    for (int m = gw; m < MT; m += NGW) {
        const int mn = m + NGW;
        if (mn < MT) { const float* xr = (mn < MP ? xlo : xhi) + (size_t)mn * DM + 4 * F.lane;
#pragma unroll
            for (int j = 0; j < 8; ++j) vn[j] = *(const f32x4*)(xr + 256 * j); }
        float ss = 0.f;
        if (part && m >= MP) {
            for (int k = 0; k < 16; ++k) { const float* pp = part + ((size_t)k * MS + (m - MP)) * DM + 4 * F.lane;
#pragma unroll
                for (int j = 0; j < 8; ++j) v[j] += *(const f32x4*)(pp + 256 * j); }
#pragma unroll
            for (int j = 0; j < 8; ++j) *(f32x4*)(ycopy + (size_t)m * DM + 4 * F.lane + 256 * j) = v[j];
        }
#pragma unroll
        for (int j = 0; j < 8; ++j) ss += (v[j].x * v[j].x + v[j].y * v[j].y) + (v[j].z * v[j].z + v[j].w * v[j].w);
        const float rstd = 1.0f / sqrtf(wave_sum(ss) * (1.0f / DM) + EPS);
        if (!part && ycopy && m >= MP) {
#pragma unroll
            for (int j = 0; j < 8; ++j) *(f32x4*)(ycopy + (size_t)m * DM + 4 * F.lane + 256 * j) = v[j]; }
        bf16_t* orow = XN + (size_t)m * DM + 4 * F.lane;
        float ga[8];
#pragma unroll
        for (int q = 0; q < 8; ++q) ga[q] = 0.f;
#pragma unroll
        for (int j = 0; j < 8; ++j) { const f32x4 hv = v[j] * rstd * gv[j];
            u32x2 w; w.x = pkbf(hv.x, hv.y); w.y = pkbf(hv.z, hv.w); *(u32x2*)(orow + 256 * j) = w;
            if (GATES) {
#pragma unroll
                for (int e = 0; e < 4; ++e) { const f32x4 wa = WG[((j * 4 + e) * 2 + 0) * 64 + F.lane], wb = WG[((j * 4 + e) * 2 + 1) * 64 + F.lane]; const float hx = hv[e];
                    ga[0] += hx * wa.x; ga[1] += hx * wa.y; ga[2] += hx * wa.z; ga[3] += hx * wa.w; ga[4] += hx * wb.x; ga[5] += hx * wb.y; ga[6] += hx * wb.z; ga[7] += hx * wb.w; } } }
        if (GATES) {
#pragma unroll
            for (int q = 0; q < 8; ++q) ga[q] = wave_sum(ga[q]);
            if (F.lane == 0) { f32x4 o0, o1;
#pragma unroll
                for (int h = 0; h < 4; ++h) { o0[h] = ga[h] + bi[h]; const float z = ga[4 + h] + bfv[h]; o1[h] = fminf(z, 0.f) - log1pf(expf(-fabsf(z))); }
                *(f32x4*)(GT + (size_t)m * 8) = o0; *(f32x4*)(GT + (size_t)m * 8 + 4) = o1; } }
#pragma unroll
        for (int j = 0; j < 8; ++j) v[j] = vn[j];
    }
    if (GATES) __syncthreads();
}

namespace ml {
constexpr int QS = 272, TS = 144;
constexpr int OFF_Q = 0, OFF_K = 17408, OFF_CB = 34816, OFF_KT = 52224  , OFF_VT = 89088  , OFF_W = 107520, OFF_SC = 116736  ,
              OFF_DEN = 118784, OFF_NQ = 119296, OFF_N = 119552;
}
template <int CTRL, int ROWMASK> __device__ __forceinline__ float dpp_mov(float ident, float v) {
    return __builtin_bit_cast(float, __builtin_amdgcn_update_dpp(__builtin_bit_cast(int, ident), __builtin_bit_cast(int, v), CTRL, ROWMASK, 0xf, false)); }
__device__ __forceinline__ float scan_add64(float v) {
    v += dpp_mov<0x111, 0xf>(0.f, v); v += dpp_mov<0x112, 0xf>(0.f, v); v += dpp_mov<0x114, 0xf>(0.f, v); v += dpp_mov<0x118, 0xf>(0.f, v);
    v += dpp_mov<0x142, 0xa>(0.f, v); v += dpp_mov<0x143, 0xc>(0.f, v); return v; }
__device__ __forceinline__ float scan_max64(float v) { const float NI = -3.0e38f;
    v = fmaxf(v, dpp_mov<0x111, 0xf>(NI, v)); v = fmaxf(v, dpp_mov<0x112, 0xf>(NI, v)); v = fmaxf(v, dpp_mov<0x114, 0xf>(NI, v)); v = fmaxf(v, dpp_mov<0x118, 0xf>(NI, v));
    v = fmaxf(v, dpp_mov<0x142, 0xa>(NI, v)); v = fmaxf(v, dpp_mov<0x143, 0xc>(NI, v)); return v; }
struct MReg { u32x4 q[2], k[2], v; u32x2 mo[2]; float ig, lf; };
__device__ __forceinline__ void ml_load(MReg& R, const bf16_t* PROJ, const float* GT, int row0, int nvalid, int h, int vs, int tid, int lane, int w) {
    const u32x4 z = {0u, 0u, 0u, 0u};
#pragma unroll
    for (int j = 0; j < 2; ++j) { const int r = (tid >> 4) + 32 * j; R.q[j] = (r < nvalid) ? *(const u32x4*)(PROJ + (size_t)(row0 + r) * NPJ + PJ_MQ + h * 128 + (tid & 15) * 8) : z; }
    const bool ok = lane < nvalid; const size_t rb = (size_t)(row0 + lane) * NPJ;
#pragma unroll
    for (int j = 0; j < 2; ++j) R.k[j] = ok ? *(const u32x4*)(PROJ + rb + PJ_MK + h * 128 + (w + 8 * j) * 8) : z;
    R.v = ok ? *(const u32x4*)(PROJ + rb + PJ_MV + h * 256 + vs * 64 + w * 8) : z;
    R.ig = ok ? GT[(size_t)(row0 + lane) * 8 + h] : -1e30f; R.lf = ok ? GT[(size_t)(row0 + lane) * 8 + 4 + h] : 0.f;
    { const int t = (w >> 1) * 16 + (lane & 15);
#pragma unroll
        for (int j = 0; j < 2; ++j) R.mo[j] = (t < nvalid) ? *(const u32x2*)(PROJ + (size_t)(row0 + t) * NPJ + PJ_MO + h * 256 + vs * 64 + ((w & 1) * 2 + j) * 16 + 4 * (lane >> 4)) : (u32x2){0u, 0u}; }
}
__device__ __forceinline__ float ml_stage(const MReg& R, LAS unsigned char* lds, int buf, float& m_prev, int tid, int lane, int w) {
    using namespace ml;
    const float b = scan_add64(R.lf);
    const float a = R.ig - b; const float pm = scan_max64(a);
    const float M = fmaxf(m_prev, pm), M63 = __builtin_bit_cast(float, __builtin_amdgcn_readlane(__builtin_bit_cast(int, M), 63)), b63 = __builtin_bit_cast(float, __builtin_amdgcn_readlane(__builtin_bit_cast(int, b), 63));
    const float wk = __expf(a - M63), decay = __expf(m_prev - M63), gt = __expf(m_prev - M), emt = __expf(-(b + M));
    if (w == 0) { LAS float* sc = (LAS float*)(lds + OFF_SC) + buf * 256; sc[lane] = a; sc[64 + lane] = M; sc[128 + lane] = gt; sc[192 + lane] = emt; }
    m_prev = b63 + M63;
#pragma unroll
    for (int j = 0; j < 2; ++j) *(LAS u32x4*)(lds + OFF_Q + ((tid >> 4) + 32 * j) * QS + (tid & 15) * 16) = R.q[j];
#pragma unroll
    for (int j = 0; j < 2; ++j) { *(LAS u32x4*)(lds + OFF_K + lane * QS + (w + 8 * j) * 16) = R.k[j];
        float f[8]; unpack8(R.k[j], f);
#pragma unroll
        for (int e = 0; e < 8; ++e) *(LAS bf16_t*)(lds + OFF_KT + buf * 18432 + ((w + 8 * j) * 8 + e) * TS + lane * 2) = (bf16_t)f2bf(f[e] * wk); }
    { const unsigned vw[4] = {R.v.x, R.v.y, R.v.z, R.v.w};
#pragma unroll
        for (int e = 0; e < 8; ++e) *(LAS bf16_t*)(lds + OFF_VT + buf * 9216 + (w * 8 + e) * TS + lane * 2) = (bf16_t)((e & 1) ? (vw[e >> 1] >> 16) : (vw[e >> 1] & 0xffffu)); }
    return decay;
}
__device__ __forceinline__ void mlstm_chain(Ctx& F, const Args& a, const float* C0, const float* n0, const float* m0, float* Cout, float* nout, float* mout,
                                            int row0, int nchunks, int nvalid, int h, int vs, float* hsq, const float* gmo) {
    using namespace ml;
    LAS unsigned char* lds = F.lds;
    const bf16_t* PROJ = (const bf16_t*)(FWS + WS_PROJ); const float* GT = (const float*)(FWS + WS_GATES); bf16_t* MIX = (bf16_t*)(FWS + WS_MIX);
    const int tid = F.tid, lane = F.lane, w = F.wave, c16 = lane & 15, g = lane >> 4, tt = w >> 1, half = w & 1;
    __syncthreads();
    f32x4 accC[4];
#pragma unroll
    for (int vt = 0; vt < 4; ++vt) { accC[vt] = C0 ? *(const f32x4*)(C0 + (size_t)(vs * 64 + vt * 16 + c16) * 128 + 16 * w + 4 * g) : (f32x4){0.f, 0.f, 0.f, 0.f};
        u32x2 o; o.x = pkbf(accC[vt][0], accC[vt][1]); o.y = pkbf(accC[vt][2], accC[vt][3]); *(LAS u32x2*)(lds + OFF_CB + (vt * 16 + c16) * QS + (16 * w + 4 * g) * 2) = o; }
    if (tid < 128) ((LAS float*)(lds + OFF_N))[tid] = n0 ? n0[tid] : 0.f;
    float m_prev = m0 ? m0[0] : 0.f;
    f32x4 gmv[2];
#pragma unroll
    for (int j = 0; j < 2; ++j) gmv[j] = *(const f32x4*)(gmo + h * 256 + vs * 64 + ((w & 1) * 2 + j) * 16 + 4 * (lane >> 4));
    MReg RA, RB; ml_load(RA, PROJ, GT, row0, nvalid, h, vs, tid, lane, w);
    if (nchunks > 1) ml_load(RB, PROJ, GT, row0 + 64, nvalid, h, vs, tid, lane, w);
    float decay = ml_stage(RA, lds, 0, m_prev, tid, lane, w);
    u32x2 mocur[2] = {RA.mo[0], RA.mo[1]};
    if (nchunks > 2) ml_load(RA, PROJ, GT, row0 + 128, nvalid, h, vs, tid, lane, w);
    auto step = [&](const int c, MReg& R) __attribute__((always_inline)) {
        const int buf = c & 1; const int rbase = row0 + c * 64;
        __syncthreads();
        const LAS float* sc = (const LAS float*)(lds + OFF_SC) + buf * 256;
        bf16x8 qf[4];
#pragma unroll
        for (int ks = 0; ks < 4; ++ks) qf[ks] = *(const LAS bf16x8*)(lds + OFF_Q + (tt * 16 + c16) * QS + (g * 8 + 32 * ks) * 2);
        const int t = tt * 16 + c16; const float Mt = sc[64 + t];
        float dsum = 0.f;
#pragma unroll
        for (int j = 0; j < 2; ++j) { const int st = half * 2 + j; f32x4 wv = {0.f, 0.f, 0.f, 0.f};
            if (st <= tt) { f32x4 acc = {0.f, 0.f, 0.f, 0.f};
#pragma unroll
                for (int ks = 0; ks < 4; ++ks) { const bf16x8 kf = *(const LAS bf16x8*)(lds + OFF_K + (st * 16 + c16) * QS + (g * 8 + 32 * ks) * 2); acc = MFMA16(kf, qf[ks], acc); }
                const f32x4 as = *(const LAS f32x4*)(sc + st * 16 + 4 * g);
#pragma unroll
                for (int r = 0; r < 4; ++r) { const int s = st * 16 + 4 * g + r; wv[r] = (s <= t) ? __expf(as[r] - Mt) * acc[r] : 0.f; } }
            dsum += (wv[0] + wv[1]) + (wv[2] + wv[3]);
            u32x2 o; o.x = pkbf(wv[0], wv[1]); o.y = pkbf(wv[2], wv[3]); *(LAS u32x2*)(lds + OFF_W + t * TS + (st * 16 + 4 * g) * 2) = o; }
        dsum += __shfl_xor(dsum, 16); dsum += __shfl_xor(dsum, 32);
        if (g == 0) ((LAS float*)(lds + OFF_DEN))[t * 2 + half] = dsum;
        f32x4 acc2[2];
#pragma unroll
        for (int j = 0; j < 2; ++j) { const int vt = half * 2 + j; acc2[j] = (f32x4){0.f, 0.f, 0.f, 0.f};
#pragma unroll
            for (int ks = 0; ks < 4; ++ks) { const bf16x8 cf = *(const LAS bf16x8*)(lds + OFF_CB + (vt * 16 + c16) * QS + (g * 8 + 32 * ks) * 2); acc2[j] = MFMA16(cf, qf[ks], acc2[j]); } }
        { const int tq = tid >> 3, part = tid & 7; float s = 0.f;
#pragma unroll
            for (int i = 0; i < 2; ++i) { const u32x4 qq = *(const LAS u32x4*)(lds + OFF_Q + tq * QS + (part * 16 + i * 8) * 2); float f[8]; unpack8(qq, f);
                const LAS float* nn = (const LAS float*)(lds + OFF_N) + part * 16 + i * 8;
#pragma unroll
                for (int e = 0; e < 8; ++e) s += f[e] * nn[e]; }
            s += __shfl_xor(s, 1); s += __shfl_xor(s, 2); s += __shfl_xor(s, 4);
            if (part == 0) ((LAS float*)(lds + OFF_NQ))[tq] = s; }
        __syncthreads();
        bf16x8 wf[2];
#pragma unroll
        for (int ks = 0; ks < 2; ++ks) wf[ks] = *(const LAS bf16x8*)(lds + OFF_W + (tt * 16 + c16) * TS + (g * 8 + 32 * ks) * 2);
        const float gtt = sc[128 + t], emt = sc[192 + t];
        const float den = ((const LAS float*)(lds + OFF_DEN))[t * 2] + ((const LAS float*)(lds + OFF_DEN))[t * 2 + 1] + gtt * ((const LAS float*)(lds + OFF_NQ))[t];
        const float inv = 1.0f / fmaxf(fabsf(den), emt);
        const LAS unsigned char* vtb = lds + OFF_VT + buf * 9216; const LAS unsigned char* ktb = lds + OFF_KT + buf * 18432;
        float hq2 = 0.f;
#pragma unroll
        for (int j = 0; j < 2; ++j) { const int vt = half * 2 + j; f32x4 a1 = {0.f, 0.f, 0.f, 0.f};
#pragma unroll
            for (int ks = 0; ks < 2; ++ks) { const bf16x8 vf = *(const LAS bf16x8*)(vtb + (vt * 16 + c16) * TS + (g * 8 + 32 * ks) * 2); a1 = MFMA16(vf, wf[ks], a1); }
            const f32x4 hv = (a1 + gtt * acc2[j]) * inv;
            hq2 += (hv[0] * hv[0] + hv[1] * hv[1]) + (hv[2] * hv[2] + hv[3] * hv[3]);
            if (t < nvalid) { const u32x2 mo = mocur[j];
                const f32x4 mf = {bflo(mo.x), bfhi(mo.x), bflo(mo.y), bfhi(mo.y)}; f32x4 ov;
#pragma unroll
                for (int r = 0; r < 4; ++r) ov[r] = hv[r] * gmv[j][r] * (1.0f / (1.0f + __expf(-mf[r])));
                u32x2 o; o.x = pkbf(ov[0], ov[1]); o.y = pkbf(ov[2], ov[3]); *(u32x2*)(MIX + (size_t)(rbase + t) * DM + h * 256 + vs * 64 + vt * 16 + 4 * g) = o; } }
        hq2 += __shfl_xor(hq2, 16); hq2 += __shfl_xor(hq2, 32);
        if (g == 0 && t < nvalid) unsafeAtomicAdd(hsq + (size_t)(rbase + t) * 8 + h, hq2);
        bf16x8 kf2[2];
#pragma unroll
        for (int ks = 0; ks < 2; ++ks) kf2[ks] = *(const LAS bf16x8*)(ktb + (w * 16 + c16) * TS + (g * 8 + 32 * ks) * 2);
#pragma unroll
        for (int vt = 0; vt < 4; ++vt) { accC[vt] = accC[vt] * decay;
#pragma unroll
            for (int ks = 0; ks < 2; ++ks) { const bf16x8 vf = *(const LAS bf16x8*)(vtb + (vt * 16 + c16) * TS + (g * 8 + 32 * ks) * 2); accC[vt] = MFMA16(kf2[ks], vf, accC[vt]); }
            u32x2 o; o.x = pkbf_mfma(accC[vt][0], accC[vt][1]); o.y = pkbf_mfma(accC[vt][2], accC[vt][3]); *(LAS u32x2*)(lds + OFF_CB + (vt * 16 + c16) * QS + (16 * w + 4 * g) * 2) = o; }
        { float s = 0.f;
#pragma unroll
            for (int i = 0; i < 2; ++i) { const u32x4 kk = *(const LAS u32x4*)(ktb + (w * 16 + c16) * TS + (g * 16 + i * 8) * 2); float f[8]; unpack8(kk, f);
#pragma unroll
                for (int e = 0; e < 8; ++e) s += f[e]; }
            s += __shfl_xor(s, 16); s += __shfl_xor(s, 32);
            if (g == 0) { LAS float* nn = (LAS float*)(lds + OFF_N) + w * 16 + c16; *nn = decay * (*nn) + s; } }
        if (c + 1 < nchunks) { decay = ml_stage(R, lds, buf ^ 1, m_prev, tid, lane, w); mocur[0] = R.mo[0]; mocur[1] = R.mo[1];
            if (c + 3 < nchunks) ml_load(R, PROJ, GT, rbase + 192, nvalid, h, vs, tid, lane, w); }
    };
    for (int c = 0; c < nchunks; c += 2) { step(c, RB); if (c + 1 < nchunks) step(c + 1, RA); }
    __syncthreads();
#pragma unroll
    for (int vt = 0; vt < 4; ++vt) *(f32x4*)(Cout + (size_t)(vs * 64 + vt * 16 + c16) * 128 + 16 * w + 4 * g) = accC[vt];
    if (vs == 0 && tid < 128) nout[tid] = ((const LAS float*)(lds + OFF_N))[tid];
    if (vs == 0 && tid == 0) mout[0] = m_prev;
}

namespace at {
constexpr int KS = 144, VS = 400;
constexpr int OFF_KN = 0, OFF_VT = 27648, OFF_BT = 53248;
}
__device__ __forceinline__ int t5_bucket(int rel) {
    const int n = rel < 0 ? -rel : rel; int v;
    if (n < 8) v = n; else if (n <= 11) v = 8; else if (n <= 15) v = 9; else if (n <= 22) v = 10; else if (n <= 31) v = 11; else if (n <= 45) v = 12; else if (n <= 63) v = 13; else if (n <= 90) v = 14; else v = 15;
    return v + (rel > 0 ? 16 : 0);
}
__device__ __forceinline__ void knorm8(float (&f)[8], const float* gk, int ch) {
    float ss = 0.f;
#pragma unroll
    for (int e = 0; e < 8; ++e) ss += f[e] * f[e];
    ss += __shfl_xor(ss, 1); ss += __shfl_xor(ss, 2); ss += __shfl_xor(ss, 4);
    const float rn = 1.0f / sqrtf(ss * (1.0f / 64.0f) + EPS);
#pragma unroll
    for (int e = 0; e < 8; ++e) f[e] = f[e] * rn * gk[ch * 8 + e];
}
__device__ __forceinline__ void attn_unit(Ctx& F, const Args& a, int l, bool prompt, int b, int c, int kvh) {
    using namespace at;
    LAS unsigned char* lds = F.lds;
    const bf16_t* PROJ = (const bf16_t*)(FWS + WS_PROJ); bf16_t* MIX = (bf16_t*)(FWS + WS_MIX);
    const int tid = F.tid, lane = F.lane, w = F.wave, c16 = lane & 15, g = lane >> 4;
    const float* gq = FIN(12) + l * 64; const float* gk = FIN(13) + l * 64;
    float* hsq = (float*)(FWS + WS_HSQ) + (size_t)l * MT * 8; const float* gao = FIN(16) + l * 1024;
    __syncthreads();
    int nkeys, nprev;
    if (prompt) {
        const int nkc = (c < 2 ? c : 2) + 1; nkeys = nkc * 64; nprev = nkeys - 64; const int p0 = (c - (nkc - 1)) * 64;
        for (int kc = 0; kc < nkc; ++kc) {
            const bool own = (kc == nkc - 1) && (c >= 30);
            { const int key = tid >> 3, ch = tid & 7; const size_t row = (size_t)b * SEQ + p0 + kc * 64 + key;
                const u32x4 kk = *(const u32x4*)(PROJ + row * NPJ + PJ_AK + kvh * 64 + ch * 8); float f[8]; unpack8(kk, f); knorm8(f, gk, ch);
                u32x4 o; o.x = pkbf(f[0], f[1]); o.y = pkbf(f[2], f[3]); o.z = pkbf(f[4], f[5]); o.w = pkbf(f[6], f[7]);
                *(LAS u32x4*)(lds + OFF_KN + (kc * 64 + key) * KS + ch * 16) = o;
                if (own) { float* dst = FOUT + O_PCK + ((size_t)(l * 16 + b) * 128 + (c * 64 + key - 1920)) * 256 + kvh * 64 + ch * 8;
                    *(f32x4*)dst = (f32x4){f[0], f[1], f[2], f[3]}; *(f32x4*)(dst + 4) = (f32x4){f[4], f[5], f[6], f[7]}; } }
            { const size_t row = (size_t)b * SEQ + p0 + kc * 64 + lane;
                const u32x4 vv = *(const u32x4*)(PROJ + row * NPJ + PJ_AV + kvh * 64 + w * 8); float f[8]; unpack8(vv, f);
#pragma unroll
                for (int e = 0; e < 8; ++e) *(LAS bf16_t*)(lds + OFF_VT + (w * 8 + e) * VS + (kc * 64 + lane) * 2) = (bf16_t)(__builtin_bit_cast(unsigned, f[e]) >> 16);
                if (own) { float* dst = FOUT + O_PCV + ((size_t)(l * 16 + b) * 128 + (c * 64 + lane - 1920)) * 256 + kvh * 64 + w * 8;
                    *(f32x4*)dst = (f32x4){f[0], f[1], f[2], f[3]}; *(f32x4*)(dst + 4) = (f32x4){f[4], f[5], f[6], f[7]}; } }
        }
    } else {
        nkeys = 160; nprev = 128;
        const float* ck = FIN(2) + (size_t)(l * 16 + b) * 128 * 256; const float* cv = FIN(3) + (size_t)(l * 16 + b) * 128 * 256;
        float* sk = FOUT + O_SCK + (size_t)(l * 16 + b) * 128 * 256; float* sv = FOUT + O_SCV + (size_t)(l * 16 + b) * 128 * 256;
#pragma unroll
        for (int j = 0; j < 2; ++j) {
            { const int key = (tid >> 3) + 64 * j, ch = tid & 7; const float* src = ck + (size_t)key * 256 + kvh * 64 + ch * 8;
                const f32x4 va = *(const f32x4*)src, bb = *(const f32x4*)(src + 4);
                u32x4 o; o.x = pkbf(va.x, va.y); o.y = pkbf(va.z, va.w); o.z = pkbf(bb.x, bb.y); o.w = pkbf(bb.z, bb.w);
                *(LAS u32x4*)(lds + OFF_KN + key * KS + ch * 16) = o;
                if (key >= 32) { float* dst = sk + (size_t)(key - 32) * 256 + kvh * 64 + ch * 8; *(f32x4*)dst = va; *(f32x4*)(dst + 4) = bb; } }
            { const int key = lane + 64 * j; const float* src = cv + (size_t)key * 256 + kvh * 64 + w * 8;
                const f32x4 va = *(const f32x4*)src, bb = *(const f32x4*)(src + 4); const float f[8] = {va.x, va.y, va.z, va.w, bb.x, bb.y, bb.z, bb.w};
#pragma unroll
                for (int e = 0; e < 8; ++e) *(LAS bf16_t*)(lds + OFF_VT + (w * 8 + e) * VS + key * 2) = (bf16_t)f2bf(f[e]);
                if (key >= 32) { float* dst = sv + (size_t)(key - 32) * 256 + kvh * 64 + w * 8; *(f32x4*)dst = va; *(f32x4*)(dst + 4) = bb; } }
        }
        if (tid < 256) { const int key = tid >> 3, ch = tid & 7; const size_t row = (size_t)MP + b * SL + key;
            const u32x4 kk = *(const u32x4*)(PROJ + row * NPJ + PJ_AK + kvh * 64 + ch * 8); float f[8]; unpack8(kk, f); knorm8(f, gk, ch);
            u32x4 o; o.x = pkbf(f[0], f[1]); o.y = pkbf(f[2], f[3]); o.z = pkbf(f[4], f[5]); o.w = pkbf(f[6], f[7]);
            *(LAS u32x4*)(lds + OFF_KN + (128 + key) * KS + ch * 16) = o;
            float* dst = sk + (size_t)(96 + key) * 256 + kvh * 64 + ch * 8; *(f32x4*)dst = (f32x4){f[0], f[1], f[2], f[3]}; *(f32x4*)(dst + 4) = (f32x4){f[4], f[5], f[6], f[7]}; }
        if (lane < 32) { const size_t row = (size_t)MP + b * SL + lane;
            const u32x4 vv = *(const u32x4*)(PROJ + row * NPJ + PJ_AV + kvh * 64 + w * 8); float f[8]; unpack8(vv, f);
#pragma unroll
            for (int e = 0; e < 8; ++e) *(LAS bf16_t*)(lds + OFF_VT + (w * 8 + e) * VS + (128 + lane) * 2) = (bf16_t)(__builtin_bit_cast(unsigned, f[e]) >> 16);
            float* dst = sv + (size_t)(96 + lane) * 256 + kvh * 64 + w * 8; *(f32x4*)dst = (f32x4){f[0], f[1], f[2], f[3]}; *(f32x4*)(dst + 4) = (f32x4){f[4], f[5], f[6], f[7]}; }
    }
    __syncthreads();
    const int hl = w >> 1, hq = kvh * 4 + hl; const float sink = FIN(14)[l * 16 + hq];
    const LAS float* BT = (const LAS float*)(lds + OFF_BT) + hq * 256;
    const int nqt = prompt ? 2 : 1, nkb = nkeys >> 5;
    for (int qt = 0; qt < nqt; ++qt) {
        const int qin = prompt ? (w & 1) * 32 + qt * 16 + c16 : (w & 1) * 16 + c16;
        const size_t row = prompt ? (size_t)b * SEQ + c * 64 + qin : (size_t)MP + b * SL + qin;
        bf16x8 qf[2];
        { float f[2][8]; float ss = 0.f;
#pragma unroll
            for (int ks = 0; ks < 2; ++ks) { const u32x4 qq = *(const u32x4*)(PROJ + row * NPJ + PJ_AQ + hq * 64 + g * 8 + 32 * ks); unpack8(qq, f[ks]);
#pragma unroll
                for (int e = 0; e < 8; ++e) ss += f[ks][e] * f[ks][e]; }
            ss += __shfl_xor(ss, 16); ss += __shfl_xor(ss, 32);
            const float rn = 0.125f / sqrtf(ss * (1.0f / 64.0f) + EPS);
#pragma unroll
            for (int ks = 0; ks < 2; ++ks) { u32x4 o; const float* gg = gq + g * 8 + 32 * ks;
                o.x = pkbf(f[ks][0] * rn * gg[0], f[ks][1] * rn * gg[1]); o.y = pkbf(f[ks][2] * rn * gg[2], f[ks][3] * rn * gg[3]);
                o.z = pkbf(f[ks][4] * rn * gg[4], f[ks][5] * rn * gg[5]); o.w = pkbf(f[ks][6] * rn * gg[6], f[ks][7] * rn * gg[7]);
                qf[ks] = __builtin_bit_cast(bf16x8, o); } }
        float mrun = sink, lsum = (g == 0) ? 1.0f : 0.0f;
        f32x4 O[4];
#pragma unroll
        for (int dt = 0; dt < 4; ++dt) O[dt] = (f32x4){0.f, 0.f, 0.f, 0.f};
        for (int kb = 0; kb < nkb; ++kb) {
            f32x4 s[2];
#pragma unroll
            for (int j = 0; j < 2; ++j) { s[j] = (f32x4){0.f, 0.f, 0.f, 0.f};
#pragma unroll
                for (int ks = 0; ks < 2; ++ks) { const bf16x8 kf = *(const LAS bf16x8*)(lds + OFF_KN + (kb * 32 + 16 * j + c16) * KS + (g * 8 + 32 * ks) * 2); s[j] = MFMA16(kf, qf[ks], s[j]); }
                const int ib = kb * 32 + 16 * j + 4 * g - nprev - qin + 191;
#pragma unroll
                for (int r = 0; r < 4; ++r) s[j][r] += BT[ib + r]; }
            float mx = fmaxf(fmaxf(fmaxf(s[0][0], s[0][1]), fmaxf(s[0][2], s[0][3])), fmaxf(fmaxf(s[1][0], s[1][1]), fmaxf(s[1][2], s[1][3])));
            mx = fmaxf(mx, __shfl_xor(mx, 16)); mx = fmaxf(mx, __shfl_xor(mx, 32));
            const float mnew = fmaxf(mrun, mx), alpha = __expf(mrun - mnew); mrun = mnew;
            float ps = 0.f;
#pragma unroll
            for (int j = 0; j < 2; ++j)
#pragma unroll
                for (int r = 0; r < 4; ++r) { s[j][r] = __expf(s[j][r] - mnew); ps += s[j][r]; }
            lsum = lsum * alpha + ps;
            u32x4 pw; pw.x = pkbf(s[0][0], s[0][1]); pw.y = pkbf(s[0][2], s[0][3]); pw.z = pkbf(s[1][0], s[1][1]); pw.w = pkbf(s[1][2], s[1][3]);
            const bf16x8 pf = __builtin_bit_cast(bf16x8, pw);
#pragma unroll
            for (int dt = 0; dt < 4; ++dt) { const LAS unsigned char* vp = lds + OFF_VT + (dt * 16 + c16) * VS + (kb * 32 + 4 * g) * 2;
                const u32x2 v0 = *(const LAS u32x2*)vp, v1 = *(const LAS u32x2*)(vp + 32);
                u32x4 vw; vw.x = v0.x; vw.y = v0.y; vw.z = v1.x; vw.w = v1.y;
                O[dt] = O[dt] * alpha; O[dt] = MFMA16(__builtin_bit_cast(bf16x8, vw), pf, O[dt]); }
        }
        lsum += __shfl_xor(lsum, 16); lsum += __shfl_xor(lsum, 32);
        const float inv = 1.0f / lsum; float aq2 = 0.f;
#pragma unroll
        for (int dt = 0; dt < 4; ++dt) { const f32x4 ov = O[dt] * inv; const f32x4 gg = *(const f32x4*)(gao + hq * 64 + dt * 16 + 4 * g);
            aq2 += (ov[0] * ov[0] + ov[1] * ov[1]) + (ov[2] * ov[2] + ov[3] * ov[3]);
            u32x2 o; o.x = pkbf(ov[0] * gg[0], ov[1] * gg[1]); o.y = pkbf(ov[2] * gg[2], ov[3] * gg[3]);
            *(u32x2*)(MIX + row * DM + 1024 + hq * 64 + dt * 16 + 4 * g) = o; }
        aq2 += __shfl_xor(aq2, 16); aq2 += __shfl_xor(aq2, 32);
        if (g == 0) unsafeAtomicAdd(hsq + row * 8 + 4, aq2);
    }
}


struct AReg { u32x4 kk[3], vv[3], q[2][2]; };
__device__ __forceinline__ void attn_loadp(AReg& R, const bf16_t* PROJ, int b, int c, int kvh, int tid, int lane, int w) {
    const int nkc = (c < 2 ? c : 2) + 1, p0 = (c - (nkc - 1)) * 64, c16 = lane & 15, g = lane >> 4, hq = kvh * 4 + (w >> 1);
#pragma unroll
    for (int kc = 0; kc < 3; ++kc) if (kc < nkc) {
        R.kk[kc] = *(const u32x4*)(PROJ + ((size_t)b * SEQ + p0 + kc * 64 + (tid >> 3)) * NPJ + PJ_AK + kvh * 64 + (tid & 7) * 8);
        R.vv[kc] = *(const u32x4*)(PROJ + ((size_t)b * SEQ + p0 + kc * 64 + lane) * NPJ + PJ_AV + kvh * 64 + w * 8); }
#pragma unroll
    for (int qt = 0; qt < 2; ++qt) { const size_t row = (size_t)b * SEQ + c * 64 + (w & 1) * 32 + qt * 16 + c16;
#pragma unroll
        for (int ks = 0; ks < 2; ++ks) R.q[qt][ks] = *(const u32x4*)(PROJ + row * NPJ + PJ_AQ + hq * 64 + g * 8 + 32 * ks); }
}
__device__ __forceinline__ void attn_prompt_unit(Ctx& F, const Args& a, int l, int b, int c, int kvh, AReg& R, bool has_next, int nb, int nc, int nkvh) {
    using namespace at;
    LAS unsigned char* lds = F.lds;
    const bf16_t* PROJ = (const bf16_t*)(FWS + WS_PROJ); bf16_t* MIX = (bf16_t*)(FWS + WS_MIX);
    const int tid = F.tid, lane = F.lane, w = F.wave, c16 = lane & 15, g = lane >> 4;
    const float* gq = FIN(12) + l * 64; const float* gk = FIN(13) + l * 64;
    float* hsq = (float*)(FWS + WS_HSQ) + (size_t)l * MT * 8; const float* gao = FIN(16) + l * 1024;
    const int nkc = (c < 2 ? c : 2) + 1, nkeys = nkc * 64, nprev = nkeys - 64;
    __syncthreads();
#pragma unroll
    for (int kc = 0; kc < 3; ++kc) if (kc < nkc) {
        const bool own = (kc == nkc - 1) && (c >= 30);
        { const int key = tid >> 3, ch = tid & 7; float f[8]; unpack8(R.kk[kc], f); knorm8(f, gk, ch);
            u32x4 o; o.x = pkbf(f[0], f[1]); o.y = pkbf(f[2], f[3]); o.z = pkbf(f[4], f[5]); o.w = pkbf(f[6], f[7]);
            *(LAS u32x4*)(lds + OFF_KN + (kc * 64 + key) * KS + ch * 16) = o;
            if (own) { float* dst = FOUT + O_PCK + ((size_t)(l * 16 + b) * 128 + (c * 64 + key - 1920)) * 256 + kvh * 64 + ch * 8;
                *(f32x4*)dst = (f32x4){f[0], f[1], f[2], f[3]}; *(f32x4*)(dst + 4) = (f32x4){f[4], f[5], f[6], f[7]}; } }
        { float f[8]; unpack8(R.vv[kc], f);
#pragma unroll
            for (int e = 0; e < 8; ++e) *(LAS bf16_t*)(lds + OFF_VT + (w * 8 + e) * VS + (kc * 64 + lane) * 2) = (bf16_t)(__builtin_bit_cast(unsigned, f[e]) >> 16);
            if (own) { float* dst = FOUT + O_PCV + ((size_t)(l * 16 + b) * 128 + (c * 64 + lane - 1920)) * 256 + kvh * 64 + w * 8;
                *(f32x4*)dst = (f32x4){f[0], f[1], f[2], f[3]}; *(f32x4*)(dst + 4) = (f32x4){f[4], f[5], f[6], f[7]}; } }
    }
    const int hl = w >> 1, hq = kvh * 4 + hl; const float sink = FIN(14)[l * 16 + hq];
    bf16x8 qf[2][2];
#pragma unroll
    for (int qt = 0; qt < 2; ++qt) { float f[2][8]; float ss = 0.f;
#pragma unroll
        for (int ks = 0; ks < 2; ++ks) { unpack8(R.q[qt][ks], f[ks]);
#pragma unroll
            for (int e = 0; e < 8; ++e) ss += f[ks][e] * f[ks][e]; }
        ss += __shfl_xor(ss, 16); ss += __shfl_xor(ss, 32);
        const float rn = 0.125f / sqrtf(ss * (1.0f / 64.0f) + EPS);
#pragma unroll
        for (int ks = 0; ks < 2; ++ks) { u32x4 o; const float* gg = gq + g * 8 + 32 * ks;
            o.x = pkbf(f[ks][0] * rn * gg[0], f[ks][1] * rn * gg[1]); o.y = pkbf(f[ks][2] * rn * gg[2], f[ks][3] * rn * gg[3]);
            o.z = pkbf(f[ks][4] * rn * gg[4], f[ks][5] * rn * gg[5]); o.w = pkbf(f[ks][6] * rn * gg[6], f[ks][7] * rn * gg[7]);
            qf[qt][ks] = __builtin_bit_cast(bf16x8, o); } }
    __syncthreads();
    if (has_next) attn_loadp(R, PROJ, nb, nc, nkvh, tid, lane, w);
    const LAS float* BT = (const LAS float*)(lds + OFF_BT) + hq * 256;
    const int nkb = nkeys >> 5;
    const int qin0 = (w & 1) * 32 + c16;
    float mrun[2] = {sink, sink}, lsum[2] = {(g == 0) ? 1.0f : 0.0f, (g == 0) ? 1.0f : 0.0f};
    f32x4 O[2][4];
#pragma unroll
    for (int qt = 0; qt < 2; ++qt)
#pragma unroll
        for (int dt = 0; dt < 4; ++dt) O[qt][dt] = (f32x4){0.f, 0.f, 0.f, 0.f};
    for (int kb = 0; kb < nkb; ++kb) {
        bf16x8 kf[2][2];
#pragma unroll
        for (int j = 0; j < 2; ++j)
#pragma unroll
            for (int ks = 0; ks < 2; ++ks) kf[j][ks] = *(const LAS bf16x8*)(lds + OFF_KN + (kb * 32 + 16 * j + c16) * KS + (g * 8 + 32 * ks) * 2);
        f32x4 s[2][2];
#pragma unroll
        for (int qt = 0; qt < 2; ++qt)
#pragma unroll
            for (int j = 0; j < 2; ++j) { s[qt][j] = (f32x4){0.f, 0.f, 0.f, 0.f};
#pragma unroll
                for (int ks = 0; ks < 2; ++ks) s[qt][j] = MFMA16(kf[j][ks], qf[qt][ks], s[qt][j]); }
        bf16x8 pf[2];
#pragma unroll
        for (int qt = 0; qt < 2; ++qt) {
#pragma unroll
            for (int j = 0; j < 2; ++j) { const int ib = kb * 32 + 16 * j + 4 * g - nprev - (qin0 + 16 * qt) + 191;
#pragma unroll
                for (int r = 0; r < 4; ++r) s[qt][j][r] += BT[ib + r]; }
            float mx = fmaxf(fmaxf(fmaxf(s[qt][0][0], s[qt][0][1]), fmaxf(s[qt][0][2], s[qt][0][3])), fmaxf(fmaxf(s[qt][1][0], s[qt][1][1]), fmaxf(s[qt][1][2], s[qt][1][3])));
            mx = fmaxf(mx, __shfl_xor(mx, 16)); mx = fmaxf(mx, __shfl_xor(mx, 32));
            const float mnew = fmaxf(mrun[qt], mx), alpha = __expf(mrun[qt] - mnew); mrun[qt] = mnew;
            float ps = 0.f;
#pragma unroll
            for (int j = 0; j < 2; ++j)
#pragma unroll
                for (int r = 0; r < 4; ++r) { s[qt][j][r] = __expf(s[qt][j][r] - mnew); ps += s[qt][j][r]; }
            lsum[qt] = lsum[qt] * alpha + ps;
            u32x4 pw; pw.x = pkbf(s[qt][0][0], s[qt][0][1]); pw.y = pkbf(s[qt][0][2], s[qt][0][3]); pw.z = pkbf(s[qt][1][0], s[qt][1][1]); pw.w = pkbf(s[qt][1][2], s[qt][1][3]);
            pf[qt] = __builtin_bit_cast(bf16x8, pw);
#pragma unroll
            for (int dt = 0; dt < 4; ++dt) O[qt][dt] = O[qt][dt] * alpha;
        }
#pragma unroll
        for (int dt = 0; dt < 4; ++dt) { const LAS unsigned char* vp = lds + OFF_VT + (dt * 16 + c16) * VS + (kb * 32 + 4 * g) * 2;
            const u32x2 v0 = *(const LAS u32x2*)vp, v1 = *(const LAS u32x2*)(vp + 32);
            u32x4 vw; vw.x = v0.x; vw.y = v0.y; vw.z = v1.x; vw.w = v1.y; const bf16x8 vf = __builtin_bit_cast(bf16x8, vw);
            O[0][dt] = MFMA16(vf, pf[0], O[0][dt]); O[1][dt] = MFMA16(vf, pf[1], O[1][dt]); }
    }
#pragma unroll
    for (int qt = 0; qt < 2; ++qt) {
        const size_t row = (size_t)b * SEQ + c * 64 + qin0 + 16 * qt;
        float ls = lsum[qt]; ls += __shfl_xor(ls, 16); ls += __shfl_xor(ls, 32);
        const float inv = 1.0f / ls; float aq2 = 0.f;
#pragma unroll
        for (int dt = 0; dt < 4; ++dt) { const f32x4 ov = O[qt][dt] * inv; const f32x4 gg = *(const f32x4*)(gao + hq * 64 + dt * 16 + 4 * g);
            aq2 += (ov[0] * ov[0] + ov[1] * ov[1]) + (ov[2] * ov[2] + ov[3] * ov[3]);
            u32x2 o; o.x = pkbf(ov[0] * gg[0], ov[1] * gg[1]); o.y = pkbf(ov[2] * gg[2], ov[3] * gg[3]);
            *(u32x2*)(MIX + row * DM + 1024 + hq * 64 + dt * 16 + 4 * g) = o; }
        aq2 += __shfl_xor(aq2, 16); aq2 += __shfl_xor(aq2, 32);
        if (g == 0) unsafeAtomicAdd(hsq + row * 8 + 4, aq2);
    }
}

template <int WHICH>
__device__ __forceinline__ void phase_mixers(Ctx& F, const Args& a, int l) {
    float* hsq = (float*)(FWS + WS_HSQ) + (size_t)l * MT * 8; const float* gmo = FIN(15) + l * 1024;
#ifndef DBG_NO_ML
    if (WHICH & 1) for (int u = F.bid; u < 512; u += F.G) {
        const bool smp = u >= 256; const int uu = u & 255, b = uu >> 4, h = (uu >> 2) & 3, vs = uu & 3; const size_t so = (size_t)((l * 16 + b) * 4 + h);
        if (!smp) mlstm_chain(F, a, nullptr, nullptr, nullptr, FOUT + O_PC + so * 32768, FOUT + O_PN + so * 128, FOUT + O_PM + so, b * SEQ, 32, 64, h, vs, hsq, gmo);
        else mlstm_chain(F, a, FIN(4) + so * 32768, FIN(5) + so * 128, FIN(6) + so, FOUT + O_SC + so * 32768, FOUT + O_SN + so * 128, FOUT + O_SM + so, MP + b * SL, 1, 32, h, vs, hsq, gmo);
    }
#endif
#ifndef DBG_NO_ATTN
    if (WHICH & 2) {
        __syncthreads();
        { LAS float* BT = (LAS float*)(F.lds + at::OFF_BT); const float* rb = FIN(7);
            for (int i = F.tid; i < 4096; i += 512) { const int hh = i >> 8, idx = i & 255; BT[i] = (idx < 255) ? rb[t5_bucket(idx - 191) * 16 + hh] : 0.f; } }
        const bf16_t* PROJ = (const bf16_t*)(FWS + WS_PROJ);
        AReg R; int u = F.bid;
        if (u < 2048) attn_loadp(R, PROJ, u >> 7, (u >> 2) & 31, u & 3, F.tid, F.lane, F.wave);
        for (; u < 2048; u += F.G) { const int un = u + F.G;
            attn_prompt_unit(F, a, l, u >> 7, (u >> 2) & 31, u & 3, R, un < 2048, un >> 7, (un >> 2) & 31, un & 3); }
        for (int v = F.bid; v < 64; v += F.G) attn_unit(F, a, l, false, v >> 2, 0, v & 3);
    }
#endif
    __syncthreads();
}

__device__ __forceinline__ void phase_finalize(Ctx& F, const Args& a, int l) {
    const bf16_t* PROJ = (const bf16_t*)(FWS + WS_PROJ); bf16_t* MIX = (bf16_t*)(FWS + WS_MIX);
    const float* gmo = FIN(15) + l * 1024; const float* gao = FIN(16) + l * 1024;
    const int gw = F.bid * 8 + F.wave, NGW = F.G * 8, lane = F.lane;
    u32x4 raw[4], mo[2], rawn[4], mon[2];
    if (gw < MT) {
#pragma unroll
        for (int j = 0; j < 4; ++j) raw[j] = *(const u32x4*)(MIX + (size_t)gw * DM + (lane + 64 * j) * 8);
#pragma unroll
        for (int j = 0; j < 2; ++j) mo[j] = *(const u32x4*)(PROJ + (size_t)gw * NPJ + PJ_MO + (lane + 64 * j) * 8); }
    for (int m = gw; m < MT; m += NGW) {
        bf16_t* mr = MIX + (size_t)m * DM; const int mn = m + NGW;
        if (mn < MT) {
#pragma unroll
            for (int j = 0; j < 4; ++j) rawn[j] = *(const u32x4*)(MIX + (size_t)mn * DM + (lane + 64 * j) * 8);
#pragma unroll
            for (int j = 0; j < 2; ++j) mon[j] = *(const u32x4*)(PROJ + (size_t)mn * NPJ + PJ_MO + (lane + 64 * j) * 8); }
        float f[4][8];
#pragma unroll
        for (int j = 0; j < 4; ++j) unpack8(raw[j], f[j]);
        float sa = 0.f;
#pragma unroll
        for (int j = 0; j < 2; ++j) { float ss = 0.f;
#pragma unroll
            for (int e = 0; e < 8; ++e) ss += f[j][e] * f[j][e];
            ss += __shfl_xor(ss, 1); ss += __shfl_xor(ss, 2); ss += __shfl_xor(ss, 4); ss += __shfl_xor(ss, 8); ss += __shfl_xor(ss, 16);
            const float rn = 1.0f / sqrtf(ss * (1.0f / 256.0f) + EPS);
            float o[8], mf[8]; unpack8(mo[j], mf); const float* gg = gmo + (lane + 64 * j) * 8;
#pragma unroll
            for (int e = 0; e < 8; ++e) o[e] = f[j][e] * rn * gg[e] * (1.0f / (1.0f + __expf(-mf[e])));
            u32x4 ow; ow.x = pkbf(o[0], o[1]); ow.y = pkbf(o[2], o[3]); ow.z = pkbf(o[4], o[5]); ow.w = pkbf(o[6], o[7]);
            *(u32x4*)(mr + (lane + 64 * j) * 8) = ow; }
#pragma unroll
        for (int j = 2; j < 4; ++j)
#pragma unroll
            for (int e = 0; e < 8; ++e) sa += f[j][e] * f[j][e];
        sa = wave_sum(sa);
        const float ra = 1.0f / sqrtf(sa * (1.0f / 1024.0f) + EPS);
#pragma unroll
        for (int j = 2; j < 4; ++j) { float o[8]; const float* gg = gao + (lane + 64 * (j - 2)) * 8;
#pragma unroll
            for (int e = 0; e < 8; ++e) o[e] = f[j][e] * ra * gg[e];
            u32x4 ow; ow.x = pkbf(o[0], o[1]); ow.y = pkbf(o[2], o[3]); ow.z = pkbf(o[4], o[5]); ow.w = pkbf(o[6], o[7]);
            *(u32x4*)(mr + (lane + 64 * j) * 8) = ow; }
#pragma unroll
        for (int j = 0; j < 4; ++j) raw[j] = rawn[j];
#pragma unroll
        for (int j = 0; j < 2; ++j) mo[j] = mon[j];
    }
}

#define XB_TMO      128
#define XB_XCNT(j)  (256  + 64 * (j))
#define XB_XSUB(j)  (1280 + 64 * (j))
#define XB_XGEN(j)  (2304 + 64 * (j))
#define XB_TOP      3328
#define XB_TOPGEN   3392
#define XCD_BAR_WORDS 3456
#define XB_SPIN_CAP (1u << 18)

__device__ __forceinline__ unsigned xb_ld(unsigned* p)              { return __hip_atomic_load(p, __ATOMIC_RELAXED, __HIP_MEMORY_SCOPE_AGENT); }
__device__ __forceinline__ unsigned xb_add(unsigned* p, unsigned v) { return __hip_atomic_fetch_add(p, v, __ATOMIC_RELAXED, __HIP_MEMORY_SCOPE_AGENT); }
__device__ __forceinline__ unsigned xb_xcc_id() { return (unsigned)__builtin_amdgcn_s_getreg((3 << 11) | 20) & 0xFu; }
#define XB_SPIN(cond, bar) do { unsigned _sp = 0; while (cond) { __builtin_amdgcn_s_sleep(1); \
    if ((++_sp & 255u) == 0u) { if (xb_ld(&(bar)[XB_TMO])) break; if (_sp > XB_SPIN_CAP) { atomicAdd(&(bar)[XB_TMO], 1u); break; } } } } while (0)

struct XcdBarrier {
    unsigned* bar; unsigned x;
    volatile LAS unsigned* st;
};

__device__ __forceinline__ XcdBarrier xcd_barrier_post(unsigned* bar, volatile LAS unsigned* st) {
    XcdBarrier b; b.bar = bar; b.x = xb_xcc_id(); b.st = st;
    if (threadIdx.x == 0) (void)xb_add(&bar[XB_XCNT(b.x)], 1u);
    return b;
}
__device__ __forceinline__ void xcd_barrier_complete(unsigned* bar, unsigned x, unsigned& nloc, unsigned& nx) {
    const unsigned G = gridDim.x * gridDim.y * gridDim.z;
    unsigned sum, cnt, mine, sp = 0u;
    for (;;) {
        sum = 0u; cnt = 0u; mine = 0u;
#pragma unroll
        for (unsigned j = 0; j < 16; ++j) { const unsigned c = xb_ld(&bar[XB_XCNT(j)]); sum += c; cnt += (c > 0u) ? 1u : 0u; mine = (j == x) ? c : mine; }
        if (sum == G) break;
        __builtin_amdgcn_s_sleep(1);
        if ((++sp & 255u) == 0u) { if (xb_ld(&bar[XB_TMO])) break; if (sp > XB_SPIN_CAP) { atomicAdd(&bar[XB_TMO], 1u); break; } }
    }
    nloc = mine > 0u ? mine : 1u; nx = cnt > 0u ? cnt : 1u;
}

__device__ __forceinline__ void xcd_barrier(const XcdBarrier& b) {
    asm volatile("s_waitcnt vmcnt(0)" ::: "memory");
    __syncthreads();
    if (threadIdx.x == 0) {
        unsigned* bar = b.bar;
        __builtin_amdgcn_s_waitcnt(0);
        unsigned nloc = b.st[0], nx = b.st[1];
        if (nloc == 0u) { xcd_barrier_complete(bar, b.x, nloc, nx); b.st[0] = nloc; b.st[1] = nx; }
        const unsigned old = xb_add(&bar[XB_XSUB(b.x)], 1u);
        const unsigned gen = old / nloc;
        if (old + 1u == (gen + 1u) * nloc) {
            __builtin_amdgcn_fence(__ATOMIC_RELEASE, "agent");
            asm volatile("s_waitcnt vmcnt(0)" ::: "memory");
            const unsigned og = xb_add(&bar[XB_TOP], 1u);
            const unsigned tg = og / nx;
            if (og + 1u == (tg + 1u) * nx) xb_add(&bar[XB_TOPGEN], 1u);
            else XB_SPIN(xb_ld(&bar[XB_TOPGEN]) == tg, bar);
            __builtin_amdgcn_fence(__ATOMIC_ACQUIRE, "agent");
            xb_add(&bar[XB_XGEN(b.x)], 1u);
            asm volatile("s_waitcnt vmcnt(0)" ::: "memory");
        } else {
            XB_SPIN(xb_ld(&bar[XB_XGEN(b.x)]) == gen, bar);
            __builtin_amdgcn_fence(__ATOMIC_ACQUIRE, "agent");
            asm volatile("s_waitcnt vmcnt(0)" ::: "memory");
        }
    }
    __syncthreads();
}

constexpr int N_PHASES = 16;

__global__ void __launch_bounds__(512, 2) hymba_fwd(Args a) {
    extern __shared__ __attribute__((aligned(16))) unsigned char lds_raw[];
    cg::grid_group grid = cg::this_grid();
    Ctx F;
    F.lds = (LAS unsigned char*)lds_raw;
    F.tid = threadIdx.x; F.lane = F.tid & 63; F.wave = __builtin_amdgcn_readfirstlane(F.tid >> 6); F.G = gridDim.x; F.bid = blockIdx.x;
    float* Y = a.out;
    bf16_t* XN = (bf16_t*)(FWS + WS_XN); bf16_t* PROJ = (bf16_t*)(FWS + WS_PROJ); bf16_t* MIX = (bf16_t*)(FWS + WS_MIX); bf16_t* U = (bf16_t*)(FWS + WS_BIG);
    if (blockIdx.x == 0) for (int i = threadIdx.x; i < XCD_BAR_WORDS; i += 512) ((unsigned*)FWS)[i] = 0u;
    if (threadIdx.x < 4) ((LAS unsigned*)(F.lds + 131072 + 64))[threadIdx.x] = 0u;
    __syncthreads();
    XcdBarrier bar; bar.bar = (unsigned*)FWS; bar.x = 0; bar.st = nullptr; bool census = false;
    for (int ph = a.ph_lo; ph < a.ph_hi; ++ph) {
        if (ph > a.ph_lo && ph != 1) {
            if (!census) { grid.sync();
                bar = xcd_barrier_post((unsigned*)FWS, (volatile LAS unsigned*)(F.lds + 131072 + 64)); census = true; }
            else xcd_barrier(bar);
        }
        { int t_ = threadIdx.x; asm volatile("" : "+v"(t_)); F.tid = t_; F.lane = t_ & 63; F.wave = __builtin_amdgcn_readfirstlane(t_ >> 6); }
        if (ph == 0) {
#ifndef NO_W
#ifdef PROBE_W2
 phase_weights(F, a); __syncthreads(); phase_weights(F, a); __syncthreads();
#endif
 phase_weights(F, a);
#endif
 __syncthreads(); continue; }
        if (ph == 1) { phase_convert(F, a); __syncthreads(); continue; }
        const int l = (ph - 2) / 7, s = (ph - 2) % 7;
        bf16_t* XB = XN; float* SSQ = (float*)(FWS + WS_SSQ); float* HSQ = (float*)(FWS + WS_HSQ) + (size_t)l * MT * 8;
        float* ssq_in = SSQ + (l == 0 ? 0 : 2 * MT);
        float* ssq_mid = SSQ + (l == 0 ? MT : 3 * MT);
        if (s == 0) { pg8::Gemm g{XB, (const bf16_t*)(FWS + WS_WIN) + (size_t)l * NPW * DM, MT, NPW, DM, DM}; pg8::StaticOrder S; S.init(MT, NPW, F.G, F.bid);
            pg8::EpiScale<0, true> E{PROJ, NPJ, ssq_in, 1.0f / DM, EPS, (float*)(FWS + WS_GATES), FIN(10) + l * 4, FIN(11) + l * 4, NPJ / 256};
            pg8::gemm_phase<pg8::EpiScale<0, true>, pg8::StaticOrder, true, true>(F.lds, g, S, E); }
        else if (s == 1) phase_mixers<3>(F, a, l);
        else if (s == 2 || s == 5) {
            pg8::Gemm g;
            if (s == 2) g = pg8::Gemm{MIX, (const bf16_t*)(FWS + WS_WOUT) + (size_t)l * DM * DM, MP, DM, DM, DM};
            else g = pg8::Gemm{U, (const bf16_t*)(FWS + WS_WDN) + (size_t)l * DM * FF, MP, DM, FF, FF};
            pg8::StaticOrder S; S.init(MP, DM, F.G, F.bid);
            if (s == 2) { pg8::EpiResBK E{XB, DM, ssq_mid, HSQ, EPS}; pg8::gemm_phase<pg8::EpiResBK, pg8::StaticOrder, false, true>(F.lds, g, S, E); }
            else if (l == 1) { pg8::EpiResF E{XB, Y, DM}; pg8::gemm_phase<pg8::EpiResF, pg8::StaticOrder, false, true>(F.lds, g, S, E); }
            else { pg8::EpiResB E{XB, DM, SSQ + 2 * MT}; pg8::gemm_phase<pg8::EpiResB, pg8::StaticOrder, false, true>(F.lds, g, S, E); }
            __syncthreads();
            const int kfull = (s == 2) ? DM : FF; pg8::Gemm g2 = g; g2.K = kfull / 16;
            pg8::SplitKOrder S2; S2.init(DM, 16, kfull / 16, MP / 256, F.G, F.bid);
            pg8::EpiPartial E2{(float*)(FWS + WS_PART), DM, kfull / 16, MP, MS};
            pg8::gemm_phase<pg8::EpiPartial, pg8::SplitKOrder, true, true>(F.lds, g2, S2, E2); }
        else if (s == 3) phase_fold(F, a, ssq_mid, nullptr, HSQ);
        else if (s == 4) { pg8::Gemm g{XB, (const bf16_t*)(FWS + WS_WUP) + (size_t)l * FF * DM, MT, FF, DM, DM}; pg8::StaticOrder S; S.init(MT, FF, F.G, F.bid);
            pg8::EpiScale<2, false> E{U, FF, ssq_mid, 1.0f / DM, EPS, nullptr, nullptr, nullptr, -1};
            pg8::gemm_phase<pg8::EpiScale<2, false>, pg8::StaticOrder, true, true>(F.lds, g, S, E); }
        else { if (l == 0) phase_fold(F, a, SSQ + 2 * MT, nullptr, nullptr); else phase_fold(F, a, nullptr, Y, nullptr); }
        __syncthreads();
    }
#ifdef DBG_STOP
    grid.sync();
#ifdef DBG_F32
    { const float* src = (const float*)(FWS + DBG_SRC); const size_t n = (size_t)DBG_F32;
      for (size_t i = (size_t)blockIdx.x * 512 + threadIdx.x; i < n; i += (size_t)gridDim.x * 512) Y[i] = src[i]; }
#else
    { const bf16_t* src = (const bf16_t*)(FWS + DBG_SRC); const size_t n = (size_t)MT * DM;
      for (size_t i = (size_t)blockIdx.x * 512 + threadIdx.x; i < n; i += (size_t)gridDim.x * 512) Y[i] = __builtin_bit_cast(float, (unsigned)src[i] << 16); }
#endif
#endif
}

#ifndef N_LAUNCH_MODE
#define N_LAUNCH_MODE 0
#endif
extern "C" void kernel_launch(void* const* d_in, const int* in_sizes, int n_in, void* d_out, int out_size, void* d_ws, size_t ws_size, hipStream_t stream) {
    static int grid = 0;
    if (grid == 0) {
        if (n_in != 21 || out_size != 80773376 || ws_size < WS_END) { fprintf(stderr, "kernel_launch: unexpected shapes (n_in %d out %d ws %zu need %zu)\n", n_in, out_size, ws_size, (size_t)WS_END); grid = -1; return; }
        int dev = 0, cus = 0, per_cu = 0;
        hipGetDevice(&dev); hipDeviceGetAttribute(&cus, hipDeviceAttributeMultiprocessorCount, dev);
        if (hipFuncSetAttribute((const void*)hymba_fwd, hipFuncAttributeMaxDynamicSharedMemorySize, LDS_BYTES) != hipSuccess) { fprintf(stderr, "kernel_launch: hipFuncSetAttribute failed\n"); grid = -1; return; }
        if (hipOccupancyMaxActiveBlocksPerMultiprocessor(&per_cu, (const void*)hymba_fwd, 512, LDS_BYTES) != hipSuccess || per_cu < 1) { fprintf(stderr, "kernel_launch: occupancy query gave %d\n", per_cu); per_cu = 1; }
        (void)hipGetLastError();
        grid = cus * per_cu;
        fprintf(stderr, "kernel_launch: grid %d (cus %d x %d)\n", grid, cus, per_cu);
    }
    if (grid < 0) return;
#ifdef DBG_MEMSET
    (void)hipMemsetAsync(d_ws, 0, WS_END, stream); (void)hipMemsetAsync(d_out, 0, (size_t)out_size * 4, stream);
#endif
    Args a{};
    for (int i = 0; i < 21; ++i) a.in[i] = (const float*)d_in[i];
    a.out = (float*)d_out; a.ws = (unsigned char*)d_ws;
#if N_LAUNCH_MODE == 0
#ifdef DBG_STOP
    a.ph_lo = 0; a.ph_hi = DBG_STOP;
#else
    a.ph_lo = 0; a.ph_hi = N_PHASES;
#endif
    { void* args[] = {&a}; hipError_t e = hipLaunchCooperativeKernel((const void*)hymba_fwd, dim3(grid), dim3(512), args, LDS_BYTES, stream);
        if (e != hipSuccess) fprintf(stderr, "cooperative launch failed: %s (grid %d)\n", hipGetErrorString(e), grid); }
#else
    for (int p = 0; p < N_PHASES; ++p) { a.ph_lo = p; a.ph_hi = p + 1; void* args[] = {&a};
        hipError_t e = hipLaunchCooperativeKernel((const void*)hymba_fwd, dim3(grid), dim3(512), args, LDS_BYTES, stream);
        if (e != hipSuccess) { fprintf(stderr, "cooperative launch %d failed: %s (grid %d)\n", p, hipGetErrorString(e), grid); break; } }
#endif
}
```

```cpp
#include <hip/hip_runtime.h>
#include <hip/hip_cooperative_groups.h>
#include <cstdio>
#include <cstdint>
namespace cg = cooperative_groups;
namespace pg8 {
#define PG8_LAS __attribute__((address_space(3)))
typedef unsigned short bf16_t;
typedef short bf16x8 __attribute__((ext_vector_type(8)));
typedef float f32x4 __attribute__((ext_vector_type(4)));
typedef unsigned u32x4 __attribute__((ext_vector_type(4)));
constexpr int BM = 256, BK = 64, HALF = 128, HTB = HALF * BK * 2  , STAGE_BYTES = 8 * HTB, NXCD = 8, WGM = 8;

__host__ __device__ __forceinline__ int lds_byte(int r, int c) { const int st = (r >> 4) * 2 + (c >> 5), rr = r & 15, cc = c & 31, ob = rr * 64 + cc * 2; return st * 1024 + (ob ^ (((ob >> 9) & 1) << 5)); }
__host__ __device__ __forceinline__ void stage_rc(int b, int& R, int& C) { const int st = b / 1024, sb = b % 1024, swz = sb ^ (((sb >> 9) & 1) << 5); R = (st >> 1) * 16 + swz / 64; C = (st & 1) * 32 + (swz % 64) / 2; }
__host__ __device__ __forceinline__ int perm32(int rho) { const int n = rho >> 4, i = rho & 15; return 8 * (i >> 2) + 4 * n + (i & 3); }

struct Unit { int pm, pn, ko; };
struct Gemm { const bf16_t* A; const bf16_t* Bt; int M, N, K, ld; };

struct StaticOrder {
    int nM, nN, nwg, G, c;
    __host__ __device__ void init(int M, int N, int G_, int c_) { nM = M / BM; nN = N / BM; nwg = nM * nN; G = G_; c = c_; }
    __host__ __device__ bool next(int i, Unit& u) const {
        const long L = (long)i * G + c; if (L >= nwg) return false;
        int wgid = (int)L; { const int q = nwg / NXCD, r = nwg % NXCD, xcd = wgid % NXCD, off = wgid / NXCD; wgid = (xcd < r ? xcd * (q + 1) : r * (q + 1) + (xcd - r) * q) + off; }
        const int nig = WGM * nN, gid = wgid / nig, fm = gid * WGM, gsz = (nM - fm) < WGM ? (nM - fm) : WGM;
        u.pm = fm + ((wgid % nig) % gsz); u.pn = (wgid % nig) / gsz; u.ko = 0; return true;
    }
    __device__ __forceinline__ void a_ready(const Unit&) const {}
    __device__ __forceinline__ void done(const Unit&) const {}
};

__device__ __forceinline__ unsigned cvt_pk_bf16(float lo, float hi) { unsigned r; asm volatile("v_cvt_pk_bf16_f32 %0, %1, %2" : "=v"(r) : "v"(lo), "v"(hi)); return r; }
typedef unsigned u32x2 __attribute__((ext_vector_type(2)));
template <int ACT> struct EpiBf16 {
    static constexpr bool PERM = true, AFTER_DRAIN = false, KSCALE = false;
    bf16_t* O; int ldc;
    __device__ __forceinline__ void operator()(const f32x4 (&acc)[2][2][4][2], const Unit& u, int wr, int wc, int fr, int fq) const {
        const int row0 = u.pm * BM + wr * 64 + fr; const int col0 = u.pn * BM + wc * 32 + 8 * fq;
#pragma unroll
        for (int ai = 0; ai < 2; ++ai)
#pragma unroll
            for (int m = 0; m < 4; ++m) { bf16_t* rowp = O + (size_t)(row0 + ai * HALF + m * 16) * ldc + col0;
#pragma unroll
                for (int bj = 0; bj < 2; ++bj) { f32x4 v0 = acc[ai][bj][m][0], v1 = acc[ai][bj][m][1];
                    if (ACT == 2) {
#pragma unroll
                        for (int e = 0; e < 4; ++e) { float a = fmaxf(v0[e], 0.f), b = fmaxf(v1[e], 0.f); v0[e] = a * a; v1[e] = b * b; } }
                    u32x4 w; w.x = cvt_pk_bf16(v0[0], v0[1]); w.y = cvt_pk_bf16(v0[2], v0[3]); w.z = cvt_pk_bf16(v1[0], v1[1]); w.w = cvt_pk_bf16(v1[2], v1[3]);
                    *(u32x4*)(rowp + bj * HALF) = w; } }
    }
};
struct EpiRes {
    static constexpr bool PERM = false, AFTER_DRAIN = false, KSCALE = false;
    const float* base_lo; const float* base_hi; float* out; int ldc; int split_pm;
    __device__ __forceinline__ void operator()(const f32x4 (&acc)[2][2][4][2], const Unit& u, int wr, int wc, int fr, int fq) const {
        const float* base = (u.pm < split_pm) ? base_lo : base_hi;
        const int col0 = u.pn * BM + wc * 32 + 4 * fq;
#pragma unroll
        for (int ai = 0; ai < 2; ++ai)
#pragma unroll
            for (int m = 0; m < 4; ++m) { const size_t off = (size_t)(u.pm * BM + ai * HALF + wr * 64 + m * 16 + fr) * ldc + col0;
                f32x4 bs[2][2];
#pragma unroll
                for (int bj = 0; bj < 2; ++bj)
#pragma unroll
                    for (int n = 0; n < 2; ++n) bs[bj][n] = *(const f32x4*)(base + off + bj * HALF + n * 16);
#pragma unroll
                for (int bj = 0; bj < 2; ++bj)
#pragma unroll
                    for (int n = 0; n < 2; ++n) *(f32x4*)(out + off + bj * HALF + n * 16) = bs[bj][n] + acc[ai][bj][m][n];
                asm volatile("" ::: "memory"); }
    }
};

struct SplitKOrder {
    int nN, nsplit, kslice, pm0, G, c;
    __host__ __device__ void init(int N, int nsplit_, int kslice_, int pm0_, int G_, int c_) { nN = N / BM; nsplit = nsplit_; kslice = kslice_; pm0 = pm0_; G = G_; c = c_; }
    __host__ __device__ bool next(int i, Unit& u) const {
        const int L = i * G + c; if (L >= 2 * nN * nsplit) return false;
        const int ks = L % nsplit, t = L / nsplit; u.pn = t % nN; u.pm = pm0 + t / nN; u.ko = ks * kslice; return true; }
    __device__ __forceinline__ void a_ready(const Unit&) const {}
    __device__ __forceinline__ void done(const Unit&) const {}
};
struct EpiPartial {
    static constexpr bool PERM = false, AFTER_DRAIN = false, KSCALE = false;
    float* P; int ldc, kslice, row0, rows;
    __device__ __forceinline__ void operator()(const f32x4 (&acc)[2][2][4][2], const Unit& u, int wr, int wc, int fr, int fq) const {
        const int col0 = u.pn * BM + wc * 32 + 4 * fq; float* base = P + (size_t)(u.ko / kslice) * rows * ldc;
#pragma unroll
        for (int ai = 0; ai < 2; ++ai)
#pragma unroll
            for (int m = 0; m < 4; ++m) { float* p = base + (size_t)(u.pm * BM + ai * HALF + wr * 64 + m * 16 + fr - row0) * ldc + col0;
#pragma unroll
                for (int bj = 0; bj < 2; ++bj)
#pragma unroll
                    for (int n = 0; n < 2; ++n) *(f32x4*)(p + bj * HALF + n * 16) = acc[ai][bj][m][n]; }
    }
};

__device__ __forceinline__ float bf_lo(unsigned w) { return __builtin_bit_cast(float, w << 16); }
__device__ __forceinline__ float bf_hi(unsigned w) { return __builtin_bit_cast(float, w & 0xffff0000u); }
template <int ACT, bool GATES> struct EpiScale {
    static constexpr bool PERM = true, AFTER_DRAIN = false, KSCALE = false;
    bf16_t* O; int ldc; const float* ssq; float inv_k, eps; float* gt; const float* bi; const float* bf; int gate_pn;
    __device__ __forceinline__ void operator()(const f32x4 (&acc)[2][2][4][2], const Unit& u, int wr, int wc, int fr, int fq) const {
        const int row0 = u.pm * BM + wr * 64 + fr; const int col0 = u.pn * BM + wc * 32 + 8 * fq;
        if (GATES && u.pn == gate_pn) {
            if (wc == 0 && fq == 0) { const f32x4 vbi = *(const f32x4*)bi, vbf = *(const f32x4*)bf;
#pragma unroll
                for (int ai = 0; ai < 2; ++ai)
#pragma unroll
                    for (int m = 0; m < 4; ++m) { const int row = row0 + ai * HALF + m * 16; const float r = 1.0f / sqrtf(ssq[row] * inv_k + eps);
                        const f32x4 gi = acc[ai][0][m][0] * r + vbi; const f32x4 z = acc[ai][0][m][1] * r + vbf; f32x4 lf;
#pragma unroll
                        for (int e2 = 0; e2 < 4; ++e2) lf[e2] = fminf(z[e2], 0.f) - log1pf(expf(-fabsf(z[e2])));
                        *(f32x4*)(gt + (size_t)row * 8) = gi; *(f32x4*)(gt + (size_t)row * 8 + 4) = lf; } }
            return; }
        float rr[2][4];
#pragma unroll
        for (int ai = 0; ai < 2; ++ai)
#pragma unroll
            for (int m = 0; m < 4; ++m) rr[ai][m] = ssq[row0 + ai * HALF + m * 16];
        asm volatile("" : "+v"(rr[0][0]), "+v"(rr[0][1]), "+v"(rr[0][2]), "+v"(rr[0][3]), "+v"(rr[1][0]), "+v"(rr[1][1]), "+v"(rr[1][2]), "+v"(rr[1][3]));
#pragma unroll
        for (int ai = 0; ai < 2; ++ai)
#pragma unroll
            for (int m = 0; m < 4; ++m) rr[ai][m] = 1.0f / sqrtf(rr[ai][m] * inv_k + eps);
#pragma unroll
        for (int ai = 0; ai < 2; ++ai)
#pragma unroll
            for (int m = 0; m < 4; ++m) asm volatile("" : "+v"(rr[ai][m]));
#pragma unroll
        for (int ai = 0; ai < 2; ++ai)
#pragma unroll
            for (int m = 0; m < 4; ++m) { const int row = row0 + ai * HALF + m * 16; const float r = rr[ai][m];
                bf16_t* rowp = O + (size_t)row * ldc + col0;
#pragma unroll
                for (int bj = 0; bj < 2; ++bj) { f32x4 v0 = acc[ai][bj][m][0] * r, v1 = acc[ai][bj][m][1] * r;
                    if (ACT == 2) {
#pragma unroll
                        for (int e2 = 0; e2 < 4; ++e2) { float p = fmaxf(v0[e2], 0.f), q = fmaxf(v1[e2], 0.f); v0[e2] = p * p; v1[e2] = q * q; } }
                    u32x4 w; w.x = cvt_pk_bf16(v0[0], v0[1]); w.y = cvt_pk_bf16(v0[2], v0[3]); w.z = cvt_pk_bf16(v1[0], v1[1]); w.w = cvt_pk_bf16(v1[2], v1[3]);
                    *(u32x4*)(rowp + bj * HALF) = w; } }
    }
};
struct EpiResB {
    static constexpr bool PERM = true, AFTER_DRAIN = false, KSCALE = false;
    bf16_t* X; int ldc; float* ssq;
    __device__ __forceinline__ void operator()(const f32x4 (&acc)[2][2][4][2], const Unit& u, int wr, int wc, int fr, int fq) const {
        const int row0 = u.pm * BM + wr * 64 + fr; const int col0 = u.pn * BM + wc * 32 + 8 * fq;
        u32x4 b[2][4][2];
#pragma unroll
        for (int ai = 0; ai < 2; ++ai)
#pragma unroll
            for (int m = 0; m < 4; ++m)
#pragma unroll
                for (int bj = 0; bj < 2; ++bj) b[ai][m][bj] = *(const u32x4*)(X + (size_t)(row0 + ai * HALF + m * 16) * ldc + col0 + bj * HALF);
        __builtin_amdgcn_s_waitcnt(0x0F70); asm volatile("" ::: "memory");
#pragma unroll
        for (int ai = 0; ai < 2; ++ai)
#pragma unroll
            for (int m = 0; m < 4; ++m) { const int row = row0 + ai * HALF + m * 16; bf16_t* rowp = X + (size_t)row * ldc + col0; float q = 0.f;
#pragma unroll
                for (int bj = 0; bj < 2; ++bj) { const u32x4 bb = b[ai][m][bj];
                    const f32x4 v0 = acc[ai][bj][m][0] + (f32x4){bf_lo(bb.x), bf_hi(bb.x), bf_lo(bb.y), bf_hi(bb.y)};
                    const f32x4 v1 = acc[ai][bj][m][1] + (f32x4){bf_lo(bb.z), bf_hi(bb.z), bf_lo(bb.w), bf_hi(bb.w)};
                    q += (v0[0] * v0[0] + v0[1] * v0[1]) + (v0[2] * v0[2] + v0[3] * v0[3]) + (v1[0] * v1[0] + v1[1] * v1[1]) + (v1[2] * v1[2] + v1[3] * v1[3]);
                    u32x4 w; w.x = cvt_pk_bf16(v0[0], v0[1]); w.y = cvt_pk_bf16(v0[2], v0[3]); w.z = cvt_pk_bf16(v1[0], v1[1]); w.w = cvt_pk_bf16(v1[2], v1[3]);
                    *(u32x4*)(rowp + bj * HALF) = w; }
                q += __shfl_xor(q, 16); q += __shfl_xor(q, 32);
                if (fq == 0) unsafeAtomicAdd(ssq + row, q); }
    }
};
struct EpiResF {
    static constexpr bool PERM = true, AFTER_DRAIN = false, KSCALE = false;
    const bf16_t* X; float* Y; int ldc;
    __device__ __forceinline__ void operator()(const f32x4 (&acc)[2][2][4][2], const Unit& u, int wr, int wc, int fr, int fq) const {
        const int row0 = u.pm * BM + wr * 64 + fr; const int col0 = u.pn * BM + wc * 32 + 8 * fq;
        u32x4 b[2][4][2];
#pragma unroll
        for (int ai = 0; ai < 2; ++ai)
#pragma unroll
            for (int m = 0; m < 4; ++m)
#pragma unroll
                for (int bj = 0; bj < 2; ++bj) b[ai][m][bj] = *(const u32x4*)(X + (size_t)(row0 + ai * HALF + m * 16) * ldc + col0 + bj * HALF);
        __builtin_amdgcn_s_waitcnt(0x0F70); asm volatile("" ::: "memory");
#pragma unroll
        for (int ai = 0; ai < 2; ++ai)
#pragma unroll
            for (int m = 0; m < 4; ++m) { const size_t off = (size_t)(row0 + ai * HALF + m * 16) * ldc + col0;
#pragma unroll
                for (int bj = 0; bj < 2; ++bj) { const u32x4 bb = b[ai][m][bj];
                    *(f32x4*)(Y + off + bj * HALF) = acc[ai][bj][m][0] + (f32x4){bf_lo(bb.x), bf_hi(bb.x), bf_lo(bb.y), bf_hi(bb.y)};
                    *(f32x4*)(Y + off + bj * HALF + 4) = acc[ai][bj][m][1] + (f32x4){bf_lo(bb.z), bf_hi(bb.z), bf_lo(bb.w), bf_hi(bb.w)}; } }
    }
};

struct EpiResBK {
    static constexpr bool PERM = true, AFTER_DRAIN = false, KSCALE = true;
    static constexpr int TBL_OFF = 131072 + 256, TBL_BYTES = 256 * 5 * 4;
    bf16_t* X; int ldc; float* ssq; const float* hsq; float eps;
    __device__ __forceinline__ void unit_begin(PG8_LAS unsigned char* lds, const Unit& u, int ui, int tid) const {
        if (tid < 256) { const float* hp = hsq + (size_t)(u.pm * BM + tid) * 8; const f32x4 h4 = *(const f32x4*)hp; const float ha = hp[4];
            const float x0 = h4[0] * (1.0f / 256.0f) + eps, x1 = h4[1] * (1.0f / 256.0f) + eps, x2 = h4[2] * (1.0f / 256.0f) + eps, x3 = h4[3] * (1.0f / 256.0f) + eps, xa = ha * (1.0f / 1024.0f) + eps;
            PG8_LAS float* T = (PG8_LAS float*)(lds + TBL_OFF + (ui & 1) * TBL_BYTES) + tid * 5;
            T[0] = __builtin_sqrtf(x1 * __builtin_amdgcn_rcpf(x0)); T[1] = __builtin_sqrtf(x2 * __builtin_amdgcn_rcpf(x1)); T[2] = __builtin_sqrtf(x3 * __builtin_amdgcn_rcpf(x2));
            T[3] = __builtin_sqrtf(xa * __builtin_amdgcn_rcpf(x3)); T[4] = 1.0f / sqrtf(xa); }
    }
    __device__ __forceinline__ void kscale(f32x4 (&acc)[2][2][4][2], PG8_LAS unsigned char* lds, int ui, int seg, int wr, int fr) const {
        const PG8_LAS float* T = (const PG8_LAS float*)(lds + TBL_OFF + (ui & 1) * TBL_BYTES) + (wr * 64 + fr) * 5 + seg - 1;
#pragma unroll
        for (int ai = 0; ai < 2; ++ai)
#pragma unroll
            for (int m = 0; m < 4; ++m) { const float f = T[(ai * HALF + m * 16) * 5];
#pragma unroll
                for (int bj = 0; bj < 2; ++bj)
#pragma unroll
                    for (int n = 0; n < 2; ++n) acc[ai][bj][m][n] = acc[ai][bj][m][n] * f; }
    }
    __device__ __forceinline__ void epi(const f32x4 (&acc)[2][2][4][2], const Unit& u, PG8_LAS unsigned char* lds, int ui, int wr, int wc, int fr, int fq) const {
        const int row0 = u.pm * BM + wr * 64 + fr; const int col0 = u.pn * BM + wc * 32 + 8 * fq;
        const PG8_LAS float* T = (const PG8_LAS float*)(lds + TBL_OFF + (ui & 1) * TBL_BYTES) + (wr * 64 + fr) * 5 + 4;
        u32x4 b[2][4][2];
#pragma unroll
        for (int ai = 0; ai < 2; ++ai)
#pragma unroll
            for (int m = 0; m < 4; ++m)
#pragma unroll
                for (int bj = 0; bj < 2; ++bj) b[ai][m][bj] = *(const u32x4*)(X + (size_t)(row0 + ai * HALF + m * 16) * ldc + col0 + bj * HALF);
        __builtin_amdgcn_s_waitcnt(0x0F70); asm volatile("" ::: "memory");
#pragma unroll
        for (int ai = 0; ai < 2; ++ai)
#pragma unroll
            for (int m = 0; m < 4; ++m) { const int row = row0 + ai * HALF + m * 16; bf16_t* rowp = X + (size_t)row * ldc + col0; float q = 0.f; const float ra = T[(ai * HALF + m * 16) * 5];
#pragma unroll
                for (int bj = 0; bj < 2; ++bj) { const u32x4 bb = b[ai][m][bj];
                    const f32x4 v0 = acc[ai][bj][m][0] * ra + (f32x4){bf_lo(bb.x), bf_hi(bb.x), bf_lo(bb.y), bf_hi(bb.y)};
                    const f32x4 v1 = acc[ai][bj][m][1] * ra + (f32x4){bf_lo(bb.z), bf_hi(bb.z), bf_lo(bb.w), bf_hi(bb.w)};
                    q += (v0[0] * v0[0] + v0[1] * v0[1]) + (v0[2] * v0[2] + v0[3] * v0[3]) + (v1[0] * v1[0] + v1[1] * v1[1]) + (v1[2] * v1[2] + v1[3] * v1[3]);
                    u32x4 w; w.x = cvt_pk_bf16(v0[0], v0[1]); w.y = cvt_pk_bf16(v0[2], v0[3]); w.z = cvt_pk_bf16(v1[0], v1[1]); w.w = cvt_pk_bf16(v1[2], v1[3]);
                    *(u32x4*)(rowp + bj * HALF) = w; }
                q += __shfl_xor(q, 16); q += __shfl_xor(q, 32);
                if (fq == 0) unsafeAtomicAdd(ssq + row, q); }
    }
};

template <class Epi, class Sched, bool ALIGN_EPI = false, bool SP2 = false>
__device__ __forceinline__ void gemm_phase(PG8_LAS unsigned char* lds, const Gemm g, const Sched& S, const Epi& E) {
    int tid_ = threadIdx.x; asm volatile("" : "+v"(tid_)); const int tid = tid_, wid = __builtin_amdgcn_readfirstlane(tid >> 6), lane = tid & 63, wr = wid >> 2, wc = wid & 3, fr = lane & 15, fq = lane >> 4;
    const int K = g.ld, nt = g.K / BK;
    unsigned voffA[2], voffB[2];
#pragma unroll
    for (int i = 0; i < 2; ++i) { int R, C; stage_rc(tid * 16 + i * 8192, R, C); const int Rb = Epi::PERM ? ((R & ~31) + perm32(R & 31)) : R;
        voffA[i] = (unsigned)(R * K + C) * 2u; voffB[i] = (unsigned)(Rb * K + C) * 2u; }
    const size_t kstep = (size_t)(BK * 2);
    const size_t hstep = (size_t)HALF * K * 2;
    const size_t tstep = 2 * hstep;
    const unsigned ldsw = (unsigned)wid * 1024u;
    const int aoff = lds_byte(wr * 64 + fr, fq * 8), boff = lds_byte(wc * 32 + fr, fq * 8);
#define PG8_SA(b, h) (((b) * 2 + (h)) * HTB)
#define PG8_SB(b, h) ((4 + (b) * 2 + (h)) * HTB)
#define PG8_STAGE(bufoff, gbase, voff) do { _Pragma("unroll") for (int _i = 0; _i < 2; ++_i) \
        __builtin_amdgcn_global_load_lds((const unsigned*)((const char*)(gbase) + (voff)[_i]), (PG8_LAS unsigned*)(lds + (bufoff) + ldsw + _i * 8192), 16, 0, 0); } while (0)
#define PG8_LDA(dst, b, h) do { _Pragma("unroll") for (int m = 0; m < 4; ++m) _Pragma("unroll") for (int k = 0; k < 2; ++k) dst[m][k] = *(const PG8_LAS bf16x8*)(lds + PG8_SA(b, h) + aoff + m * 2048 + k * 1024); } while (0)
#define PG8_LDB(dst, b, h) do { _Pragma("unroll") for (int n = 0; n < 2; ++n) _Pragma("unroll") for (int k = 0; k < 2; ++k) dst[n][k] = *(const PG8_LAS bf16x8*)(lds + PG8_SB(b, h) + boff + n * 2048 + k * 1024); } while (0)
#define PG8_MMA(ai, bj, At, Bt) do { __builtin_amdgcn_s_setprio(1); _Pragma("unroll") for (int m = 0; m < 4; ++m) _Pragma("unroll") for (int n = 0; n < 2; ++n) _Pragma("unroll") for (int k = 0; k < 2; ++k) \
        acc[ai][bj][m][n] = __builtin_amdgcn_mfma_f32_16x16x32_bf16(Bt[n][k], At[m][k], acc[ai][bj][m][n], 0, 0, 0); __builtin_amdgcn_s_setprio(0); } while (0)
#define PG8_WAIT_V(n) asm volatile("s_waitcnt vmcnt(" #n ")" ::: "memory")
#define PG8_WAIT_L(n) asm volatile("s_waitcnt lgkmcnt(" #n ")" ::: "memory")
#define PG8_BAR __builtin_amdgcn_s_barrier()
#define PG8_SCHED __builtin_amdgcn_sched_barrier(0)
    Unit cur, nxt; int ui = 0;
    if (!S.next(0, cur)) return;
    f32x4 acc[2][2][4][2];
#pragma unroll
    for (int a = 0; a < 2; ++a)
#pragma unroll
        for (int b = 0; b < 2; ++b)
#pragma unroll
            for (int m = 0; m < 4; ++m)
#pragma unroll
                for (int n = 0; n < 2; ++n) acc[a][b][m][n] = (f32x4){0.f, 0.f, 0.f, 0.f};
    bf16x8 At[4][2], B0[2][2], B1[2][2];
    const char* cA = (const char*)g.A + (size_t)cur.pm * tstep + (size_t)cur.ko * 2; const char* cB = (const char*)g.Bt + (size_t)cur.pn * tstep + (size_t)cur.ko * 2;
    S.a_ready(cur);
    if constexpr (Epi::KSCALE) E.unit_begin(lds, cur, ui, tid);
    if constexpr (SP2) {
        PG8_STAGE(PG8_SB(0, 0), cB, voffB); PG8_STAGE(PG8_SB(0, 1), cB + hstep, voffB); PG8_STAGE(PG8_SA(0, 0), cA, voffA); PG8_STAGE(PG8_SA(0, 1), cA + hstep, voffA);
        if (wr == 1) PG8_BAR;
        PG8_WAIT_V(2); PG8_BAR;
        PG8_STAGE(PG8_SB(1, 0), cB + kstep, voffB); PG8_STAGE(PG8_SA(1, 0), cA + kstep, voffA); PG8_STAGE(PG8_SB(1, 1), cB + hstep + kstep, voffB);
        PG8_WAIT_V(6); PG8_BAR;
    } else {
        PG8_STAGE(PG8_SB(0, 0), cB, voffB); PG8_STAGE(PG8_SA(0, 0), cA, voffA); PG8_STAGE(PG8_SB(0, 1), cB + hstep, voffB); PG8_STAGE(PG8_SA(0, 1), cA + hstep, voffA);
        if (wr == 1) PG8_BAR;
        PG8_WAIT_V(4); PG8_BAR;
        PG8_STAGE(PG8_SB(1, 0), cB + kstep, voffB); PG8_STAGE(PG8_SA(1, 0), cA + kstep, voffA); PG8_STAGE(PG8_SB(1, 1), cB + hstep + kstep, voffB);
        PG8_WAIT_V(6); PG8_BAR;
    }
    for (;;) {
        const bool has_next = S.next(ui + 1, nxt);
        const char* nA = has_next ? (const char*)g.A + (size_t)nxt.pm * tstep + (size_t)nxt.ko * 2 : cA; const char* nB = has_next ? (const char*)g.Bt + (size_t)nxt.pn * tstep + (size_t)nxt.ko * 2 : cB;
        for (int t = 0; t < nt; t += 2) {
            const bool last = (t == nt - 2);
            if constexpr (Epi::KSCALE) { if (t == 4 || t == 8 || t == 12 || t == 16) E.kscale(acc, lds, ui, t >> 2, wr, fr); }
            const char* a1 = cA + (size_t)(t + 1) * kstep;
            const char* a2 = last ? nA : cA + (size_t)(t + 2) * kstep; const char* b2 = last ? nB : cB + (size_t)(t + 2) * kstep;
            const char* a3 = a2 + kstep; const char* b3 = b2 + kstep;
            if (last && has_next) S.a_ready(nxt);
            if constexpr (SP2) {
            PG8_LDB(B0, 0, 0); PG8_LDB(B1, 0, 1); PG8_SCHED; PG8_LDA(At, 0, 0); PG8_STAGE(PG8_SA(1, 1), a1 + hstep, voffA);
            PG8_WAIT_V(8); PG8_WAIT_L(0); PG8_BAR; PG8_MMA(0, 0, At, B0); PG8_MMA(0, 1, At, B1); PG8_BAR; PG8_SCHED;
            PG8_LDA(At, 0, 1); PG8_STAGE(PG8_SB(0, 0), b2, voffB); PG8_STAGE(PG8_SB(0, 1), b2 + hstep, voffB); PG8_STAGE(PG8_SA(0, 0), a2, voffA);
            PG8_WAIT_V(8); PG8_WAIT_L(0); PG8_BAR; PG8_MMA(1, 0, At, B0); PG8_MMA(1, 1, At, B1); PG8_BAR; PG8_SCHED;
            PG8_LDB(B0, 1, 0); PG8_LDB(B1, 1, 1); PG8_SCHED; PG8_LDA(At, 1, 0); PG8_STAGE(PG8_SA(0, 1), a2 + hstep, voffA);
            PG8_WAIT_V(8); PG8_WAIT_L(0); PG8_BAR; PG8_MMA(0, 0, At, B0); PG8_MMA(0, 1, At, B1); PG8_BAR; PG8_SCHED;
            PG8_LDA(At, 1, 1); PG8_STAGE(PG8_SB(1, 0), b3, voffB); PG8_STAGE(PG8_SB(1, 1), b3 + hstep, voffB); PG8_STAGE(PG8_SA(1, 0), a3, voffA);
            PG8_WAIT_V(8); PG8_WAIT_L(0); PG8_BAR; PG8_MMA(1, 0, At, B0); PG8_MMA(1, 1, At, B1); PG8_BAR; PG8_SCHED;
            } else {
            PG8_LDB(B0, 0, 0); PG8_SCHED; PG8_LDA(At, 0, 0); PG8_STAGE(PG8_SA(1, 1), a1 + hstep, voffA);
            PG8_WAIT_L(8); PG8_BAR; PG8_WAIT_L(0); PG8_MMA(0, 0, At, B0); PG8_BAR; PG8_SCHED;
            PG8_LDB(B1, 0, 1); PG8_STAGE(PG8_SB(0, 0), b2, voffB);
            PG8_BAR; PG8_WAIT_L(0); PG8_MMA(0, 1, At, B1); PG8_BAR;
            PG8_LDA(At, 0, 1); PG8_STAGE(PG8_SA(0, 0), a2, voffA);
            PG8_BAR; PG8_WAIT_L(0); PG8_MMA(1, 0, At, B0); PG8_BAR; PG8_SCHED;
            PG8_STAGE(PG8_SB(0, 1), b2 + hstep, voffB);
            PG8_WAIT_V(6); PG8_BAR; PG8_MMA(1, 1, At, B1); PG8_BAR;
            PG8_LDB(B0, 1, 0); PG8_SCHED; PG8_LDA(At, 1, 0); PG8_STAGE(PG8_SA(0, 1), a2 + hstep, voffA);
            PG8_WAIT_L(8); PG8_BAR; PG8_WAIT_L(0); PG8_MMA(0, 0, At, B0); PG8_BAR; PG8_SCHED;
            PG8_LDB(B1, 1, 1); PG8_STAGE(PG8_SB(1, 0), b3, voffB);
            PG8_BAR; PG8_WAIT_L(0); PG8_MMA(0, 1, At, B1); PG8_BAR;
            PG8_LDA(At, 1, 1); PG8_STAGE(PG8_SA(1, 0), a3, voffA);
            PG8_BAR; PG8_WAIT_L(0); PG8_MMA(1, 0, At, B0); PG8_BAR; PG8_SCHED;
            PG8_STAGE(PG8_SB(1, 1), b3 + hstep, voffB);
            PG8_WAIT_V(6); PG8_BAR; PG8_MMA(1, 1, At, B1); PG8_BAR;
            }
        }
        if constexpr (ALIGN_EPI) { if (wr == 0) PG8_BAR; }
        if constexpr (Epi::KSCALE) { E.epi(acc, cur, lds, ui, wr, wc, fr, fq); S.done(cur); } else
        if constexpr (!Epi::AFTER_DRAIN) { E(acc, cur, wr, wc, fr, fq); S.done(cur); }
        if (!has_next) break;
#pragma unroll
        for (int a = 0; a < 2; ++a)
#pragma unroll
            for (int b = 0; b < 2; ++b)
#pragma unroll
                for (int m = 0; m < 4; ++m)
#pragma unroll
                    for (int n = 0; n < 2; ++n) acc[a][b][m][n] = (f32x4){0.f, 0.f, 0.f, 0.f};
        cur = nxt; cA = nA; cB = nB; ++ui;
        if constexpr (Epi::KSCALE) E.unit_begin(lds, cur, ui, tid);
        if constexpr (ALIGN_EPI) { if (wr == 1) PG8_BAR; }
    }
    PG8_WAIT_V(0);
    if constexpr (!ALIGN_EPI) { if (wr == 0) PG8_BAR; }
    PG8_BAR;
    if constexpr (Epi::AFTER_DRAIN) { E.fused(acc, cur, wr, wc, fr, fq, lds, wid, lane); S.done(cur); }
#undef PG8_SA
#undef PG8_SB
#undef PG8_STAGE
#undef PG8_LDA
#undef PG8_LDB
#undef PG8_MMA
#undef PG8_WAIT_V
#undef PG8_WAIT_L
#undef PG8_BAR
#undef PG8_SCHED
}
}
#define LAS __attribute__((address_space(3)))
typedef unsigned short bf16_t;
typedef short bf16x8 __attribute__((ext_vector_type(8)));
typedef float f32x4 __attribute__((ext_vector_type(4)));
typedef unsigned u32x4 __attribute__((ext_vector_type(4)));
typedef unsigned u32x2 __attribute__((ext_vector_type(2)));

constexpr int DM = 2048, NB = 16, SEQ = 2048, SB = 16, SL = 32, FF = 8192;
constexpr int MP = NB * SEQ;
constexpr int MS = SB * SL;
constexpr int MT = MP + MS;
constexpr int DIN = 4616, NPJ = 4608, NPW = 4864;
constexpr int DIN_UNUSED = 0;
constexpr int PJ_MQ = 0, PJ_MK = 512, PJ_MV = 1024, PJ_MO = 2048, PJ_AQ = 3072, PJ_AK = 4096, PJ_AV = 4352;
constexpr float EPS = 1e-6f;
constexpr size_t O_YP = 0, O_YS = 67108864, O_PCK = 68157440, O_PCV = 69206016, O_PC = 70254592, O_PN = 74448896, O_PM = 74465280,
                 O_SCK = 74465408, O_SCV = 75513984, O_SC = 76562560, O_SN = 80756864, O_SM = 80773248;
constexpr size_t MiB = 1u << 20;
constexpr size_t WS_WIN = 1 * MiB;
constexpr size_t WS_SSQ = 64 * 1024;
constexpr size_t WS_WOUT = WS_WIN + 38 * MiB;
constexpr size_t WS_WUP = WS_WOUT + 16 * MiB;
constexpr size_t WS_WDN = WS_WUP + 64 * MiB;
constexpr size_t WS_XN = WS_WDN + 64 * MiB;
constexpr size_t WS_GATES = WS_XN + 130 * MiB;
constexpr size_t WS_BIG = WS_GATES + 2 * MiB;
constexpr size_t WS_PROJ = WS_BIG, WS_MIX = WS_BIG + 293 * MiB;
constexpr size_t WS_PART = WS_BIG + 520 * MiB;
constexpr size_t WS_HSQ = WS_PART + 64 * MiB;
constexpr size_t WS_END = WS_HSQ + 3 * MiB;
constexpr int LDS_BYTES = 147456;

__device__ __forceinline__ unsigned f2bf(float f) { unsigned u = __builtin_bit_cast(unsigned, f); return (u + 0x7fffu + ((u >> 16) & 1u)) >> 16; }
__device__ __forceinline__ float bflo(unsigned w) { return __builtin_bit_cast(float, w << 16); }
__device__ __forceinline__ float bfhi(unsigned w) { return __builtin_bit_cast(float, w & 0xffff0000u); }
typedef float f32x2_t __attribute__((ext_vector_type(2)));
typedef __bf16 bf16x2_t __attribute__((ext_vector_type(2)));
__device__ __forceinline__ unsigned pkbf(float lo, float hi) { unsigned r; asm volatile("v_cvt_pk_bf16_f32 %0, %1, %2" : "=v"(r) : "v"(lo), "v"(hi)); return r; }
__device__ __forceinline__ unsigned pkbf_mfma(float lo, float hi) { const f32x2_t v = {lo, hi}; const bf16x2_t b = __builtin_convertvector(v, bf16x2_t); return __builtin_bit_cast(unsigned, b); }
__device__ __forceinline__ void unpack8(const u32x4 w, float (&f)[8]) { f[0] = bflo(w.x); f[1] = bfhi(w.x); f[2] = bflo(w.y); f[3] = bfhi(w.y); f[4] = bflo(w.z); f[5] = bfhi(w.z); f[6] = bflo(w.w); f[7] = bfhi(w.w); }
__device__ __forceinline__ float wave_sum(float v) {
#pragma unroll
    for (int o = 1; o < 64; o <<= 1) v += __shfl_xor(v, o);
    return v;
}
#define LDS_WAIT() asm volatile("s_waitcnt lgkmcnt(0)" ::: "memory")
#define MFMA16(a, b, c) __builtin_amdgcn_mfma_f32_16x16x32_bf16((a), (b), (c), 0, 0, 0)

struct Args { const float* in[21]; float* out; unsigned char* ws; int ph_lo, ph_hi; };
struct Ctx {
    LAS unsigned char* lds;
    int tid, lane, wave, G, bid;
};
#define FIN(i) (a.in[i])
#define FOUT (a.out)
#define FWS (a.ws)

__device__ __forceinline__ void transpose_item(const float* W, int ldw, int c0, int nvalid, int k0, bf16_t* WT, int Kdst, int r0, float scale, const float* gk, LAS float* scr, int lane) {
#pragma unroll 8
    for (int i = 0; i < 32; ++i) { const int kk = 2 * i + (lane >> 5); scr[kk * 33 + (lane & 31)] = ((lane & 31) < nvalid) ? W[(size_t)(k0 + kk) * ldw + c0 + (lane & 31)] : 0.f; }
    LDS_WAIT(); asm volatile("" ::: "memory");
    const int c = lane & 7;
    float sk[8];
#pragma unroll
    for (int e = 0; e < 8; ++e) sk[e] = gk ? scale * gk[k0 + 8 * c + e] : scale;
#pragma unroll
    for (int j = 0; j < 4; ++j) { const int n = (lane >> 3) + 8 * j; const LAS float* s = scr + (8 * c) * 33 + n;
        u32x4 o; o.x = pkbf(s[0 * 33] * sk[0], s[1 * 33] * sk[1]); o.y = pkbf(s[2 * 33] * sk[2], s[3 * 33] * sk[3]); o.z = pkbf(s[4 * 33] * sk[4], s[5 * 33] * sk[5]); o.w = pkbf(s[6 * 33] * sk[6], s[7 * 33] * sk[7]);
        *(u32x4*)(WT + (size_t)(r0 + n) * Kdst + k0 + 8 * c) = o; }
    LDS_WAIT(); asm volatile("" ::: "memory");
}
__device__ __forceinline__ void phase_weights(Ctx& F, const Args& a) {
    LAS float* scr = (LAS float*)(F.lds + F.wave * 16384);
    const int gw = F.bid * 8 + F.wave, NGW = F.G * 8;
    constexpr int I_IN = 32 * 152, I_OUT = 32 * 64, I_UP = 32 * 256, I_DN = 128 * 64, I_L = I_IN + I_OUT + I_UP + I_DN;
    for (int it = gw; it < 2 * I_L; it += NGW) {
        const int l = it / I_L; int r = it % I_L;
        if (r < I_IN) { const int kb = r / 152, nb = r % 152, n0 = nb * 32;
            const int c0 = n0 < 3072 ? n0 : (n0 < 4608 ? n0 + 8 : 3072); const int nvalid = n0 < 4608 ? 32 : (n0 == 4608 ? 8 : 0);
            const float sc = (n0 >= PJ_MK && n0 < PJ_MV) ? 0.08838834764831845f : 1.0f;
            transpose_item(FIN(9) + (size_t)l * DM * DIN, DIN, c0, nvalid, kb * 64, (bf16_t*)(FWS + WS_WIN) + (size_t)l * NPW * DM, DM, n0, sc, FIN(8) + l * DM, scr, F.lane); continue; }
        r -= I_IN;
        if (r < I_OUT) { const int kb = r / 64, nb = r % 64;
            transpose_item(FIN(17) + (size_t)l * DM * DM, DM, nb * 32, 32, kb * 64, (bf16_t*)(FWS + WS_WOUT) + (size_t)l * DM * DM, DM, nb * 32, 1.0f, nullptr, scr, F.lane); continue; }
        r -= I_OUT;
        if (r < I_UP) { const int kb = r / 256, nb = r % 256;
            transpose_item(FIN(19) + (size_t)l * DM * FF, FF, nb * 32, 32, kb * 64, (bf16_t*)(FWS + WS_WUP) + (size_t)l * FF * DM, DM, nb * 32, 1.0f, FIN(18) + l * DM, scr, F.lane); continue; }
        r -= I_UP;
        { const int kb = r / 64, nb = r % 64;
            transpose_item(FIN(20) + (size_t)l * FF * DM, DM, nb * 32, 32, kb * 64, (bf16_t*)(FWS + WS_WDN) + (size_t)l * DM * FF, FF, nb * 32, 1.0f, nullptr, scr, F.lane); }
    }
}

__device__ __forceinline__ void phase_convert(Ctx& F, const Args& a) {
    bf16_t* XB = (bf16_t*)(FWS + WS_XN); float* SSQ = (float*)(FWS + WS_SSQ);
    const float* xlo = FIN(0); const float* xhi = FIN(1) - (size_t)MP * DM;
    const int gw = F.bid * 8 + F.wave, NGW = F.G * 8;
    f32x4 v[8], vn[8];
    if (gw < MT) { const float* xr = (gw < MP ? xlo : xhi) + (size_t)gw * DM + 4 * F.lane;
#pragma unroll
        for (int j = 0; j < 8; ++j) v[j] = *(const f32x4*)(xr + 256 * j); }
    for (int m = gw; m < MT; m += NGW) {
        const int mn = m + NGW;
        if (mn < MT) { const float* xr = (mn < MP ? xlo : xhi) + (size_t)mn * DM + 4 * F.lane;
#pragma unroll
            for (int j = 0; j < 8; ++j) vn[j] = *(const f32x4*)(xr + 256 * j); }
        float ss = 0.f; bf16_t* orow = XB + (size_t)m * DM + 4 * F.lane;
#pragma unroll
        for (int j = 0; j < 8; ++j) { ss += (v[j].x * v[j].x + v[j].y * v[j].y) + (v[j].z * v[j].z + v[j].w * v[j].w);
            u32x2 w; w.x = pkbf(v[j].x, v[j].y); w.y = pkbf(v[j].z, v[j].w); *(u32x2*)(orow + 256 * j) = w; }
        ss = wave_sum(ss);
        if (F.lane == 0) { SSQ[m] = ss; SSQ[MT + m] = 0.f; SSQ[2 * MT + m] = 0.f; SSQ[3 * MT + m] = 0.f; }
        if (F.lane < 16) ((float*)(FWS + WS_HSQ))[(size_t)(F.lane >> 3) * MT * 8 + (size_t)m * 8 + (F.lane & 7)] = 0.f;
#pragma unroll
        for (int j = 0; j < 8; ++j) v[j] = vn[j];
    }
}
__device__ __forceinline__ void phase_fold(Ctx& F, const Args& a, float* ssq, float* yout, const float* hsq) {
    bf16_t* XB = (bf16_t*)(FWS + WS_XN); const float* part = (const float*)(FWS + WS_PART);
    for (int m = MP + F.bid * 8 + F.wave; m < MT; m += F.G * 8) {
        bf16_t* xr = XB + (size_t)m * DM; f32x4 v[8];
#pragma unroll
        for (int j = 0; j < 4; ++j) { const u32x4 b = *(const u32x4*)(xr + (F.lane + 64 * j) * 8); float f[8]; unpack8(b, f);
            v[2 * j] = (f32x4){f[0], f[1], f[2], f[3]}; v[2 * j + 1] = (f32x4){f[4], f[5], f[6], f[7]}; }
        for (int k = 0; k < 16; ++k) { const float* pp = part + ((size_t)k * MS + (m - MP)) * DM;
            float sc = 1.0f;
            if (hsq) { const int sg = k < 8 ? (k >> 1) : 4; sc = 1.0f / sqrtf(hsq[(size_t)m * 8 + sg] * (sg < 4 ? (1.0f / 256.0f) : (1.0f / 1024.0f)) + EPS); }
#pragma unroll
            for (int j = 0; j < 4; ++j) { v[2 * j] += *(const f32x4*)(pp + (F.lane + 64 * j) * 8) * sc; v[2 * j + 1] += *(const f32x4*)(pp + (F.lane + 64 * j) * 8 + 4) * sc; } }
        if (yout) {
#pragma unroll
            for (int j = 0; j < 4; ++j) { *(f32x4*)(yout + (size_t)m * DM + (F.lane + 64 * j) * 8) = v[2 * j]; *(f32x4*)(yout + (size_t)m * DM + (F.lane + 64 * j) * 8 + 4) = v[2 * j + 1]; }
        } else { float ss = 0.f;
#pragma unroll
            for (int j = 0; j < 4; ++j) { const f32x4 p = v[2 * j], q = v[2 * j + 1];
                ss += (p.x * p.x + p.y * p.y) + (p.z * p.z + p.w * p.w) + (q.x * q.x + q.y * q.y) + (q.z * q.z + q.w * q.w);
                u32x4 w; w.x = pkbf(p.x, p.y); w.y = pkbf(p.z, p.w); w.z = pkbf(q.x, q.y); w.w = pkbf(q.z, q.w); *(u32x4*)(xr + (F.lane + 64 * j) * 8) = w; }
            ss = wave_sum(ss); if (F.lane == 0) ssq[m] = ss; }
    }
}

template <bool GATES>
__device__ __forceinline__ void phase_norm(Ctx& F, const Args& a, const float* xlo, const float* xhi  , const float* gvec, int l, float* ycopy, const float* part) {
    bf16_t* XN = (bf16_t*)(FWS + WS_XN);
    float* GT = (float*)(FWS + WS_GATES);
    LAS f32x4* WG = (LAS f32x4*)F.lds;
    if (GATES) {
        const float* win = FIN(9) + (size_t)l * DM * DIN;
        for (int k = F.tid; k < DM; k += 512) { const int j = k >> 8, ln = (k & 255) >> 2, e = k & 3;
            const f32x4 wa = *(const f32x4*)(win + (size_t)k * DIN + 3072), wb = *(const f32x4*)(win + (size_t)k * DIN + 3076);
            WG[((j * 4 + e) * 2 + 0) * 64 + ln] = wa; WG[((j * 4 + e) * 2 + 1) * 64 + ln] = wb; }
        __syncthreads();
    }
    f32x4 gv[8];
#pragma unroll
    for (int j = 0; j < 8; ++j) gv[j] = *(const f32x4*)(gvec + 4 * F.lane + 256 * j);
    float bi[4], bfv[4];
    if (GATES) {
#pragma unroll
        for (int h = 0; h < 4; ++h) { bi[h] = FIN(10)[l * 4 + h]; bfv[h] = FIN(11)[l * 4 + h]; } }
    const int gw = F.bid * 8 + F.wave, NGW = F.G * 8;
    f32x4 v[8], vn[8];
    if (gw < MT) { const float* xr = (gw < MP ? xlo : xhi) + (size_t)gw * DM + 4 * F.lane;
#pragma unroll
        for (int j = 0; j < 8; ++j) v[j] = *(const f32x4*)(xr + 256 * j); }
    for (int m = gw; m < MT; m += NGW) {
        const int mn = m + NGW;
        if (mn < MT) { const float* xr = (mn < MP ? xlo : xhi) + (size_t)mn * DM + 4 * F.lane;
#pragma unroll
            for (int j = 0; j < 8; ++j) vn[j] = *(const f32x4*)(xr + 256 * j); }
        float ss = 0.f;
        if (part && m >= MP) {
            for (int k = 0; k < 16; ++k) { const float* pp = part + ((size_t)k * MS + (m - MP)) * DM + 4 * F.lane;
#pragma unroll
                for (int j = 0; j < 8; ++j) v[j] += *(const f32x4*)(pp + 256 * j); }
#pragma unroll
            for (int j = 0; j < 8; ++j) *(f32x4*)(ycopy + (size_t)m * DM + 4 * F.lane + 256 * j) = v[j];
        }
#pragma unroll
        for (int j = 0; j < 8; ++j) ss += (v[j].x * v[j].x + v[j].y * v[j].y) + (v[j].z * v[j].z + v[j].w * v[j].w);
        const float rstd = 1.0f / sqrtf(wave_sum(ss) * (1.0f / DM) + EPS);
        if (!part && ycopy && m >= MP) {
#pragma unroll
            for (int j = 0; j < 8; ++j) *(f32x4*)(ycopy + (size_t)m * DM + 4 * F.lane + 256 * j) = v[j]; }
        bf16_t* orow = XN + (size_t)m * DM + 4 * F.lane;
        float ga[8];
#pragma unroll
        for (int q = 0; q < 8; ++q) ga[q] = 0.f;
#pragma unroll
        for (int j = 0; j < 8; ++j) { const f32x4 hv = v[j] * rstd * gv[j];
            u32x2 w; w.x = pkbf(hv.x, hv.y); w.y = pkbf(hv.z, hv.w); *(u32x2*)(orow + 256 * j) = w;
            if (GATES) {
#pragma unroll
                for (int e = 0; e < 4; ++e) { const f32x4 wa = WG[((j * 4 + e) * 2 + 0) * 64 + F.lane], wb = WG[((j * 4 + e) * 2 + 1) * 64 + F.lane]; const float hx = hv[e];
                    ga[0] += hx * wa.x; ga[1] += hx * wa.y; ga[2] += hx * wa.z; ga[3] += hx * wa.w; ga[4] += hx * wb.x; ga[5] += hx * wb.y; ga[6] += hx * wb.z; ga[7] += hx * wb.w; } } }
        if (GATES) {
#pragma unroll
            for (int q = 0; q < 8; ++q) ga[q] = wave_sum(ga[q]);
            if (F.lane == 0) { f32x4 o0, o1;
#pragma unroll
                for (int h = 0; h < 4; ++h) { o0[h] = ga[h] + bi[h]; const float z = ga[4 + h] + bfv[h]; o1[h] = fminf(z, 0.f) - log1pf(expf(-fabsf(z))); }
                *(f32x4*)(GT + (size_t)m * 8) = o0; *(f32x4*)(GT + (size_t)m * 8 + 4) = o1; } }
#pragma unroll
        for (int j = 0; j < 8; ++j) v[j] = vn[j];
    }
    if (GATES) __syncthreads();
}

namespace ml {
constexpr int QS = 272, TS = 144;
constexpr int OFF_Q = 0, OFF_K = 17408, OFF_CB = 34816, OFF_KT = 52224  , OFF_VT = 89088  , OFF_W = 107520, OFF_SC = 116736  ,
              OFF_DEN = 118784, OFF_NQ = 119296, OFF_N = 119552;
}
template <int CTRL, int ROWMASK> __device__ __forceinline__ float dpp_mov(float ident, float v) {
    return __builtin_bit_cast(float, __builtin_amdgcn_update_dpp(__builtin_bit_cast(int, ident), __builtin_bit_cast(int, v), CTRL, ROWMASK, 0xf, false)); }
__device__ __forceinline__ float scan_add64(float v) {
    v += dpp_mov<0x111, 0xf>(0.f, v); v += dpp_mov<0x112, 0xf>(0.f, v); v += dpp_mov<0x114, 0xf>(0.f, v); v += dpp_mov<0x118, 0xf>(0.f, v);
    v += dpp_mov<0x142, 0xa>(0.f, v); v += dpp_mov<0x143, 0xc>(0.f, v); return v; }
__device__ __forceinline__ float scan_max64(float v) { const float NI = -3.0e38f;
    v = fmaxf(v, dpp_mov<0x111, 0xf>(NI, v)); v = fmaxf(v, dpp_mov<0x112, 0xf>(NI, v)); v = fmaxf(v, dpp_mov<0x114, 0xf>(NI, v)); v = fmaxf(v, dpp_mov<0x118, 0xf>(NI, v));
    v = fmaxf(v, dpp_mov<0x142, 0xa>(NI, v)); v = fmaxf(v, dpp_mov<0x143, 0xc>(NI, v)); return v; }
__device__ __forceinline__ float sum8_dpp(float s) {
    s += dpp_mov<0xB1, 0xf>(0.f, s); s += dpp_mov<0x4E, 0xf>(0.f, s); s += dpp_mov<0x141, 0xf>(0.f, s); return s; }
struct MReg { u32x4 q[2], k[2], v; u32x2 mo[2]; float ig, lf; };
__device__ __forceinline__ void ml_load(MReg& R, const bf16_t* PROJ, const float* GT, int row0, int nvalid, int h, int vs, int tid, int lane, int w) {
    const u32x4 z = {0u, 0u, 0u, 0u};
#pragma unroll
    for (int j = 0; j < 2; ++j) { const int r = (tid >> 4) + 32 * j; R.q[j] = (r < nvalid) ? *(const u32x4*)(PROJ + (size_t)(row0 + r) * NPJ + PJ_MQ + h * 128 + (tid & 15) * 8) : z; }
    const bool ok = lane < nvalid; const size_t rb = (size_t)(row0 + lane) * NPJ;
#pragma unroll
    for (int j = 0; j < 2; ++j) R.k[j] = ok ? *(const u32x4*)(PROJ + rb + PJ_MK + h * 128 + (w + 8 * j) * 8) : z;
    R.v = ok ? *(const u32x4*)(PROJ + rb + PJ_MV + h * 256 + vs * 64 + w * 8) : z;
    R.ig = ok ? GT[(size_t)(row0 + lane) * 8 + h] : -1e30f; R.lf = ok ? GT[(size_t)(row0 + lane) * 8 + 4 + h] : 0.f;
    { const int t = (w >> 1) * 16 + (lane & 15);
#pragma unroll
        for (int j = 0; j < 2; ++j) R.mo[j] = (t < nvalid) ? *(const u32x2*)(PROJ + (size_t)(row0 + t) * NPJ + PJ_MO + h * 256 + vs * 64 + ((w & 1) * 2 + j) * 16 + 4 * (lane >> 4)) : (u32x2){0u, 0u}; }
}
__device__ __forceinline__ float ml_stage(const MReg& R, LAS unsigned char* lds, int buf, float& m_prev, int tid, int lane, int w) {
    using namespace ml;
    const float b = scan_add64(R.lf);
    const float a = R.ig - b; const float pm = scan_max64(a);
    const float M = fmaxf(m_prev, pm), M63 = __builtin_bit_cast(float, __builtin_amdgcn_readlane(__builtin_bit_cast(int, M), 63)), b63 = __builtin_bit_cast(float, __builtin_amdgcn_readlane(__builtin_bit_cast(int, b), 63));
    const float wk = __expf(a - M63), decay = __expf(m_prev - M63), gt = __expf(m_prev - M), emt = __expf(-(b + M));
    if (w == 0) { LAS float* sc = (LAS float*)(lds + OFF_SC) + buf * 256; sc[lane] = a; sc[64 + lane] = M; sc[128 + lane] = gt; sc[192 + lane] = emt; }
    m_prev = b63 + M63;
#pragma unroll
    for (int j = 0; j < 2; ++j) *(LAS u32x4*)(lds + OFF_Q + ((tid >> 4) + 32 * j) * QS + (tid & 15) * 16) = R.q[j];
#pragma unroll
    for (int j = 0; j < 2; ++j) { *(LAS u32x4*)(lds + OFF_K + lane * QS + (w + 8 * j) * 16) = R.k[j];
        float f[8]; unpack8(R.k[j], f);
#pragma unroll
        for (int e = 0; e < 8; ++e) *(LAS bf16_t*)(lds + OFF_KT + buf * 18432 + ((w + 8 * j) * 8 + e) * TS + lane * 2) = (bf16_t)pkbf(f[e] * wk, 0.f); }
    { const unsigned vw[4] = {R.v.x, R.v.y, R.v.z, R.v.w};
#pragma unroll
        for (int e = 0; e < 8; ++e) *(LAS bf16_t*)(lds + OFF_VT + buf * 9216 + (w * 8 + e) * TS + lane * 2) = (bf16_t)((e & 1) ? (vw[e >> 1] >> 16) : (vw[e >> 1] & 0xffffu)); }
    return decay;
}
__device__ __forceinline__ void mlstm_chain(Ctx& F, const Args& a, const float* C0, const float* n0, const float* m0, float* Cout, float* nout, float* mout,
                                            int row0, int nchunks, int nvalid, int h, int vs, float* hsq, const float* gmo) {
    using namespace ml;
    LAS unsigned char* lds = F.lds;
    const bf16_t* PROJ = (const bf16_t*)(FWS + WS_PROJ); const float* GT = (const float*)(FWS + WS_GATES); bf16_t* MIX = (bf16_t*)(FWS + WS_MIX);
    const int tid = F.tid, lane = F.lane, w = F.wave, c16 = lane & 15, g = lane >> 4, tt = w >> 1, half = w & 1;
    __syncthreads();
    f32x4 accC[4];
#pragma unroll
    for (int vt = 0; vt < 4; ++vt) { accC[vt] = C0 ? *(const f32x4*)(C0 + (size_t)(vs * 64 + vt * 16 + c16) * 128 + 16 * w + 4 * g) : (f32x4){0.f, 0.f, 0.f, 0.f};
        u32x2 o; o.x = pkbf(accC[vt][0], accC[vt][1]); o.y = pkbf(accC[vt][2], accC[vt][3]); *(LAS u32x2*)(lds + OFF_CB + (vt * 16 + c16) * QS + (16 * w + 4 * g) * 2) = o; }
    if (tid < 128) ((LAS float*)(lds + OFF_N))[tid] = n0 ? n0[tid] : 0.f;
    float m_prev = m0 ? m0[0] : 0.f;
    f32x4 gmv[2];
#pragma unroll
    for (int j = 0; j < 2; ++j) gmv[j] = *(const f32x4*)(gmo + h * 256 + vs * 64 + ((w & 1) * 2 + j) * 16 + 4 * (lane >> 4));
    MReg RA, RB; ml_load(RA, PROJ, GT, row0, nvalid, h, vs, tid, lane, w);
    if (nchunks > 1) ml_load(RB, PROJ, GT, row0 + 64, nvalid, h, vs, tid, lane, w);
    float decay = ml_stage(RA, lds, 0, m_prev, tid, lane, w);
    u32x2 mocur[2] = {RA.mo[0], RA.mo[1]};
    if (nchunks > 2) ml_load(RA, PROJ, GT, row0 + 128, nvalid, h, vs, tid, lane, w);
    auto step = [&](const int c, MReg& R) __attribute__((always_inline)) {
        const int buf = c & 1; const int rbase = row0 + c * 64;
        __syncthreads();
        const LAS float* sc = (const LAS float*)(lds + OFF_SC) + buf * 256;
        bf16x8 qf[4];
#pragma unroll
        for (int ks = 0; ks < 4; ++ks) qf[ks] = *(const LAS bf16x8*)(lds + OFF_Q + (tt * 16 + c16) * QS + (g * 8 + 32 * ks) * 2);
        const int t = tt * 16 + c16; const float Mt = sc[64 + t];
        float dsum = 0.f;
#pragma unroll
        for (int j = 0; j < 2; ++j) { const int st = half * 2 + j; f32x4 wv = {0.f, 0.f, 0.f, 0.f};
            if (st <= tt) { f32x4 acc = {0.f, 0.f, 0.f, 0.f};
#pragma unroll
                for (int ks = 0; ks < 4; ++ks) { const bf16x8 kf = *(const LAS bf16x8*)(lds + OFF_K + (st * 16 + c16) * QS + (g * 8 + 32 * ks) * 2); acc = MFMA16(kf, qf[ks], acc); }
                const f32x4 as = *(const LAS f32x4*)(sc + st * 16 + 4 * g);
#pragma unroll
                for (int r = 0; r < 4; ++r) { const int s = st * 16 + 4 * g + r; wv[r] = (s <= t) ? __expf(as[r] - Mt) * acc[r] : 0.f; } }
            dsum += (wv[0] + wv[1]) + (wv[2] + wv[3]);
            u32x2 o; o.x = pkbf(wv[0], wv[1]); o.y = pkbf(wv[2], wv[3]); *(LAS u32x2*)(lds + OFF_W + t * TS + (st * 16 + 4 * g) * 2) = o; }
        dsum += __shfl_xor(dsum, 16); dsum += __shfl_xor(dsum, 32);
        if (g == 0) ((LAS float*)(lds + OFF_DEN))[t * 2 + half] = dsum;
        f32x4 acc2[2];
#pragma unroll
        for (int j = 0; j < 2; ++j) { const int vt = half * 2 + j; acc2[j] = (f32x4){0.f, 0.f, 0.f, 0.f};
#pragma unroll
            for (int ks = 0; ks < 4; ++ks) { const bf16x8 cf = *(const LAS bf16x8*)(lds + OFF_CB + (vt * 16 + c16) * QS + (g * 8 + 32 * ks) * 2); acc2[j] = MFMA16(cf, qf[ks], acc2[j]); } }
        { const int tq = tid >> 3, part = tid & 7; float s = 0.f;
#pragma unroll
            for (int i = 0; i < 2; ++i) { const u32x4 qq = *(const LAS u32x4*)(lds + OFF_Q + tq * QS + (part * 16 + i * 8) * 2); float f[8]; unpack8(qq, f);
                const LAS float* nn = (const LAS float*)(lds + OFF_N) + part * 16 + i * 8;
#pragma unroll
                for (int e = 0; e < 8; ++e) s += f[e] * nn[e]; }
            s = sum8_dpp(s);
            if (part == 0) ((LAS float*)(lds + OFF_NQ))[tq] = s; }
        __syncthreads();
        bf16x8 wf[2];
#pragma unroll
        for (int ks = 0; ks < 2; ++ks) wf[ks] = *(const LAS bf16x8*)(lds + OFF_W + (tt * 16 + c16) * TS + (g * 8 + 32 * ks) * 2);
        const float gtt = sc[128 + t], emt = sc[192 + t];
        const float den = ((const LAS float*)(lds + OFF_DEN))[t * 2] + ((const LAS float*)(lds + OFF_DEN))[t * 2 + 1] + gtt * ((const LAS float*)(lds + OFF_NQ))[t];
        const float inv = 1.0f / fmaxf(fabsf(den), emt);
        const LAS unsigned char* vtb = lds + OFF_VT + buf * 9216; const LAS unsigned char* ktb = lds + OFF_KT + buf * 18432;
        float hq2 = 0.f;
#pragma unroll
        for (int j = 0; j < 2; ++j) { const int vt = half * 2 + j; f32x4 a1 = {0.f, 0.f, 0.f, 0.f};
#pragma unroll
            for (int ks = 0; ks < 2; ++ks) { const bf16x8 vf = *(const LAS bf16x8*)(vtb + (vt * 16 + c16) * TS + (g * 8 + 32 * ks) * 2); a1 = MFMA16(vf, wf[ks], a1); }
            const f32x4 hv = (a1 + gtt * acc2[j]) * inv;
            hq2 += (hv[0] * hv[0] + hv[1] * hv[1]) + (hv[2] * hv[2] + hv[3] * hv[3]);
            if (t < nvalid) { const u32x2 mo = mocur[j];
                const f32x4 mf = {bflo(mo.x), bfhi(mo.x), bflo(mo.y), bfhi(mo.y)}; f32x4 ov;
#pragma unroll
                for (int r = 0; r < 4; ++r) ov[r] = hv[r] * gmv[j][r] * (1.0f / (1.0f + __expf(-mf[r])));
                u32x2 o; o.x = pkbf(ov[0], ov[1]); o.y = pkbf(ov[2], ov[3]); *(u32x2*)(MIX + (size_t)(rbase + t) * DM + h * 256 + vs * 64 + vt * 16 + 4 * g) = o; } }
        hq2 += __shfl_xor(hq2, 16); hq2 += __shfl_xor(hq2, 32);
        if (g == 0 && t < nvalid) unsafeAtomicAdd(hsq + (size_t)(rbase + t) * 8 + h, hq2);
        bf16x8 kf2[2];
#pragma unroll
        for (int ks = 0; ks < 2; ++ks) kf2[ks] = *(const LAS bf16x8*)(ktb + (w * 16 + c16) * TS + (g * 8 + 32 * ks) * 2);
#pragma unroll
        for (int vt = 0; vt < 4; ++vt) { accC[vt] = accC[vt] * decay;
#pragma unroll
            for (int ks = 0; ks < 2; ++ks) { const bf16x8 vf = *(const LAS bf16x8*)(vtb + (vt * 16 + c16) * TS + (g * 8 + 32 * ks) * 2); accC[vt] = MFMA16(kf2[ks], vf, accC[vt]); }
            u32x2 o; o.x = pkbf_mfma(accC[vt][0], accC[vt][1]); o.y = pkbf_mfma(accC[vt][2], accC[vt][3]); *(LAS u32x2*)(lds + OFF_CB + (vt * 16 + c16) * QS + (16 * w + 4 * g) * 2) = o; }
        { float s = 0.f;
#pragma unroll
            for (int i = 0; i < 2; ++i) { const u32x4 kk = *(const LAS u32x4*)(ktb + (w * 16 + c16) * TS + (g * 16 + i * 8) * 2); float f[8]; unpack8(kk, f);
#pragma unroll
                for (int e = 0; e < 8; ++e) s += f[e]; }
            s += __shfl_xor(s, 16); s += __shfl_xor(s, 32);
            if (g == 0) { LAS float* nn = (LAS float*)(lds + OFF_N) + w * 16 + c16; *nn = decay * (*nn) + s; } }
        if (c + 1 < nchunks) { decay = ml_stage(R, lds, buf ^ 1, m_prev, tid, lane, w); mocur[0] = R.mo[0]; mocur[1] = R.mo[1];
            if (c + 3 < nchunks) ml_load(R, PROJ, GT, rbase + 192, nvalid, h, vs, tid, lane, w); }
    };
    for (int c = 0; c < nchunks; c += 2) { step(c, RB); if (c + 1 < nchunks) step(c + 1, RA); }
    __syncthreads();
#pragma unroll
    for (int vt = 0; vt < 4; ++vt) *(f32x4*)(Cout + (size_t)(vs * 64 + vt * 16 + c16) * 128 + 16 * w + 4 * g) = accC[vt];
    if (vs == 0 && tid < 128) nout[tid] = ((const LAS float*)(lds + OFF_N))[tid];
    if (vs == 0 && tid == 0) mout[0] = m_prev;
}

namespace at {
constexpr int KS = 144, VS = 400;
constexpr int OFF_KN = 0, OFF_VT = 27648, OFF_BT = 53248;
}
__device__ __forceinline__ int t5_bucket(int rel) {
    const int n = rel < 0 ? -rel : rel; int v;
    if (n < 8) v = n; else if (n <= 11) v = 8; else if (n <= 15) v = 9; else if (n <= 22) v = 10; else if (n <= 31) v = 11; else if (n <= 45) v = 12; else if (n <= 63) v = 13; else if (n <= 90) v = 14; else v = 15;
    return v + (rel > 0 ? 16 : 0);
}
__device__ __forceinline__ void knorm8(float (&f)[8], const float* gk, int ch) {
    float ss = 0.f;
#pragma unroll
    for (int e = 0; e < 8; ++e) ss += f[e] * f[e];
    ss = sum8_dpp(ss);
    const float rn = 1.0f / sqrtf(ss * (1.0f / 64.0f) + EPS);
#pragma unroll
    for (int e = 0; e < 8; ++e) f[e] = f[e] * rn * gk[ch * 8 + e];
}
__device__ __forceinline__ void attn_unit(Ctx& F, const Args& a, int l, bool prompt, int b, int c, int kvh) {
    using namespace at;
    LAS unsigned char* lds = F.lds;
    const bf16_t* PROJ = (const bf16_t*)(FWS + WS_PROJ); bf16_t* MIX = (bf16_t*)(FWS + WS_MIX);
    const int tid = F.tid, lane = F.lane, w = F.wave, c16 = lane & 15, g = lane >> 4;
    const float* gq = FIN(12) + l * 64; const float* gk = FIN(13) + l * 64;
    float* hsq = (float*)(FWS + WS_HSQ) + (size_t)l * MT * 8; const float* gao = FIN(16) + l * 1024;
    __syncthreads();
    int nkeys, nprev;
    if (prompt) {
        const int nkc = (c < 2 ? c : 2) + 1; nkeys = nkc * 64; nprev = nkeys - 64; const int p0 = (c - (nkc - 1)) * 64;
        for (int kc = 0; kc < nkc; ++kc) {
            const bool own = (kc == nkc - 1) && (c >= 30);
            { const int key = tid >> 3, ch = tid & 7; const size_t row = (size_t)b * SEQ + p0 + kc * 64 + key;
                const u32x4 kk = *(const u32x4*)(PROJ + row * NPJ + PJ_AK + kvh * 64 + ch * 8); float f[8]; unpack8(kk, f); knorm8(f, gk, ch);
                u32x4 o; o.x = pkbf(f[0], f[1]); o.y = pkbf(f[2], f[3]); o.z = pkbf(f[4], f[5]); o.w = pkbf(f[6], f[7]);
                *(LAS u32x4*)(lds + OFF_KN + (kc * 64 + key) * KS + ch * 16) = o;
                if (own) { float* dst = FOUT + O_PCK + ((size_t)(l * 16 + b) * 128 + (c * 64 + key - 1920)) * 256 + kvh * 64 + ch * 8;
                    *(f32x4*)dst = (f32x4){f[0], f[1], f[2], f[3]}; *(f32x4*)(dst + 4) = (f32x4){f[4], f[5], f[6], f[7]}; } }
            { const size_t row = (size_t)b * SEQ + p0 + kc * 64 + lane;
                const u32x4 vv = *(const u32x4*)(PROJ + row * NPJ + PJ_AV + kvh * 64 + w * 8); float f[8]; unpack8(vv, f);
#pragma unroll
                for (int e = 0; e < 8; ++e) *(LAS bf16_t*)(lds + OFF_VT + (w * 8 + e) * VS + (kc * 64 + lane) * 2) = (bf16_t)(__builtin_bit_cast(unsigned, f[e]) >> 16);
                if (own) { float* dst = FOUT + O_PCV + ((size_t)(l * 16 + b) * 128 + (c * 64 + lane - 1920)) * 256 + kvh * 64 + w * 8;
                    *(f32x4*)dst = (f32x4){f[0], f[1], f[2], f[3]}; *(f32x4*)(dst + 4) = (f32x4){f[4], f[5], f[6], f[7]}; } }
        }
    } else {
        nkeys = 160; nprev = 128;
        const float* ck = FIN(2) + (size_t)(l * 16 + b) * 128 * 256; const float* cv = FIN(3) + (size_t)(l * 16 + b) * 128 * 256;
        float* sk = FOUT + O_SCK + (size_t)(l * 16 + b) * 128 * 256; float* sv = FOUT + O_SCV + (size_t)(l * 16 + b) * 128 * 256;
#pragma unroll
        for (int j = 0; j < 2; ++j) {
            { const int key = (tid >> 3) + 64 * j, ch = tid & 7; const float* src = ck + (size_t)key * 256 + kvh * 64 + ch * 8;
                const f32x4 va = *(const f32x4*)src, bb = *(const f32x4*)(src + 4);
                u32x4 o; o.x = pkbf(va.x, va.y); o.y = pkbf(va.z, va.w); o.z = pkbf(bb.x, bb.y); o.w = pkbf(bb.z, bb.w);
                *(LAS u32x4*)(lds + OFF_KN + key * KS + ch * 16) = o;
                if (key >= 32) { float* dst = sk + (size_t)(key - 32) * 256 + kvh * 64 + ch * 8; *(f32x4*)dst = va; *(f32x4*)(dst + 4) = bb; } }
            { const int key = lane + 64 * j; const float* src = cv + (size_t)key * 256 + kvh * 64 + w * 8;
                const f32x4 va = *(const f32x4*)src, bb = *(const f32x4*)(src + 4); const float f[8] = {va.x, va.y, va.z, va.w, bb.x, bb.y, bb.z, bb.w};
#pragma unroll
                for (int e = 0; e < 8; ++e) *(LAS bf16_t*)(lds + OFF_VT + (w * 8 + e) * VS + key * 2) = (bf16_t)f2bf(f[e]);
                if (key >= 32) { float* dst = sv + (size_t)(key - 32) * 256 + kvh * 64 + w * 8; *(f32x4*)dst = va; *(f32x4*)(dst + 4) = bb; } }
        }
        if (tid < 256) { const int key = tid >> 3, ch = tid & 7; const size_t row = (size_t)MP + b * SL + key;
            const u32x4 kk = *(const u32x4*)(PROJ + row * NPJ + PJ_AK + kvh * 64 + ch * 8); float f[8]; unpack8(kk, f); knorm8(f, gk, ch);
            u32x4 o; o.x = pkbf(f[0], f[1]); o.y = pkbf(f[2], f[3]); o.z = pkbf(f[4], f[5]); o.w = pkbf(f[6], f[7]);
            *(LAS u32x4*)(lds + OFF_KN + (128 + key) * KS + ch * 16) = o;
            float* dst = sk + (size_t)(96 + key) * 256 + kvh * 64 + ch * 8; *(f32x4*)dst = (f32x4){f[0], f[1], f[2], f[3]}; *(f32x4*)(dst + 4) = (f32x4){f[4], f[5], f[6], f[7]}; }
        if (lane < 32) { const size_t row = (size_t)MP + b * SL + lane;
            const u32x4 vv = *(const u32x4*)(PROJ + row * NPJ + PJ_AV + kvh * 64 + w * 8); float f[8]; unpack8(vv, f);
#pragma unroll
            for (int e = 0; e < 8; ++e) *(LAS bf16_t*)(lds + OFF_VT + (w * 8 + e) * VS + (128 + lane) * 2) = (bf16_t)(__builtin_bit_cast(unsigned, f[e]) >> 16);
            float* dst = sv + (size_t)(96 + lane) * 256 + kvh * 64 + w * 8; *(f32x4*)dst = (f32x4){f[0], f[1], f[2], f[3]}; *(f32x4*)(dst + 4) = (f32x4){f[4], f[5], f[6], f[7]}; }
    }
    __syncthreads();
    const int hl = w >> 1, hq = kvh * 4 + hl; const float sink = FIN(14)[l * 16 + hq];
    const LAS float* BT = (const LAS float*)(lds + OFF_BT) + hq * 256;
    const int nqt = prompt ? 2 : 1, nkb = nkeys >> 5;
    for (int qt = 0; qt < nqt; ++qt) {
        const int qin = prompt ? (w & 1) * 32 + qt * 16 + c16 : (w & 1) * 16 + c16;
        const size_t row = prompt ? (size_t)b * SEQ + c * 64 + qin : (size_t)MP + b * SL + qin;
        bf16x8 qf[2];
        { float f[2][8]; float ss = 0.f;
#pragma unroll
            for (int ks = 0; ks < 2; ++ks) { const u32x4 qq = *(const u32x4*)(PROJ + row * NPJ + PJ_AQ + hq * 64 + g * 8 + 32 * ks); unpack8(qq, f[ks]);
#pragma unroll
                for (int e = 0; e < 8; ++e) ss += f[ks][e] * f[ks][e]; }
            ss += __shfl_xor(ss, 16); ss += __shfl_xor(ss, 32);
            const float rn = 0.125f / sqrtf(ss * (1.0f / 64.0f) + EPS);
#pragma unroll
            for (int ks = 0; ks < 2; ++ks) { u32x4 o; const float* gg = gq + g * 8 + 32 * ks;
                o.x = pkbf(f[ks][0] * rn * gg[0], f[ks][1] * rn * gg[1]); o.y = pkbf(f[ks][2] * rn * gg[2], f[ks][3] * rn * gg[3]);
                o.z = pkbf(f[ks][4] * rn * gg[4], f[ks][5] * rn * gg[5]); o.w = pkbf(f[ks][6] * rn * gg[6], f[ks][7] * rn * gg[7]);
                qf[ks] = __builtin_bit_cast(bf16x8, o); } }
        float mrun = sink, lsum = (g == 0) ? 1.0f : 0.0f;
        f32x4 O[4];
#pragma unroll
        for (int dt = 0; dt < 4; ++dt) O[dt] = (f32x4){0.f, 0.f, 0.f, 0.f};
        for (int kb = 0; kb < nkb; ++kb) {
            f32x4 s[2];
#pragma unroll
            for (int j = 0; j < 2; ++j) { s[j] = (f32x4){0.f, 0.f, 0.f, 0.f};
#pragma unroll
                for (int ks = 0; ks < 2; ++ks) { const bf16x8 kf = *(const LAS bf16x8*)(lds + OFF_KN + (kb * 32 + 16 * j + c16) * KS + (g * 8 + 32 * ks) * 2); s[j] = MFMA16(kf, qf[ks], s[j]); }
                const int ib = kb * 32 + 16 * j + 4 * g - nprev - qin + 191;
#pragma unroll
                for (int r = 0; r < 4; ++r) s[j][r] += BT[ib + r]; }
            float mx = fmaxf(fmaxf(fmaxf(s[0][0], s[0][1]), fmaxf(s[0][2], s[0][3])), fmaxf(fmaxf(s[1][0], s[1][1]), fmaxf(s[1][2], s[1][3])));
            mx = fmaxf(mx, __shfl_xor(mx, 16)); mx = fmaxf(mx, __shfl_xor(mx, 32));
            const float mnew = fmaxf(mrun, mx), alpha = __expf(mrun - mnew); mrun = mnew;
            float ps = 0.f;
#pragma unroll
            for (int j = 0; j < 2; ++j)
#pragma unroll
                for (int r = 0; r < 4; ++r) { s[j][r] = __expf(s[j][r] - mnew); ps += s[j][r]; }
            lsum = lsum * alpha + ps;
            u32x4 pw; pw.x = pkbf(s[0][0], s[0][1]); pw.y = pkbf(s[0][2], s[0][3]); pw.z = pkbf(s[1][0], s[1][1]); pw.w = pkbf(s[1][2], s[1][3]);
            const bf16x8 pf = __builtin_bit_cast(bf16x8, pw);
#pragma unroll
            for (int dt = 0; dt < 4; ++dt) { const LAS unsigned char* vp = lds + OFF_VT + (dt * 16 + c16) * VS + (kb * 32 + 4 * g) * 2;
                const u32x2 v0 = *(const LAS u32x2*)vp, v1 = *(const LAS u32x2*)(vp + 32);
                u32x4 vw; vw.x = v0.x; vw.y = v0.y; vw.z = v1.x; vw.w = v1.y;
                O[dt] = O[dt] * alpha; O[dt] = MFMA16(__builtin_bit_cast(bf16x8, vw), pf, O[dt]); }
        }
        lsum += __shfl_xor(lsum, 16); lsum += __shfl_xor(lsum, 32);
        const float inv = 1.0f / lsum; float aq2 = 0.f;
#pragma unroll
        for (int dt = 0; dt < 4; ++dt) { const f32x4 ov = O[dt] * inv; const f32x4 gg = *(const f32x4*)(gao + hq * 64 + dt * 16 + 4 * g);
            aq2 += (ov[0] * ov[0] + ov[1] * ov[1]) + (ov[2] * ov[2] + ov[3] * ov[3]);
            u32x2 o; o.x = pkbf(ov[0] * gg[0], ov[1] * gg[1]); o.y = pkbf(ov[2] * gg[2], ov[3] * gg[3]);
            *(u32x2*)(MIX + row * DM + 1024 + hq * 64 + dt * 16 + 4 * g) = o; }
        aq2 += __shfl_xor(aq2, 16); aq2 += __shfl_xor(aq2, 32);
        if (g == 0) unsafeAtomicAdd(hsq + row * 8 + 4, aq2);
    }
}


struct AReg { u32x4 kk[3], vv[3], q[2][2]; };
__device__ __forceinline__ void attn_loadp(AReg& R, const bf16_t* PROJ, int b, int c, int kvh, int tid, int lane, int w) {
    const int nkc = (c < 2 ? c : 2) + 1, p0 = (c - (nkc - 1)) * 64, c16 = lane & 15, g = lane >> 4, hq = kvh * 4 + (w >> 1);
#pragma unroll
    for (int kc = 0; kc < 3; ++kc) if (kc < nkc) {
        R.kk[kc] = *(const u32x4*)(PROJ + ((size_t)b * SEQ + p0 + kc * 64 + (tid >> 3)) * NPJ + PJ_AK + kvh * 64 + (tid & 7) * 8);
        R.vv[kc] = *(const u32x4*)(PROJ + ((size_t)b * SEQ + p0 + kc * 64 + lane) * NPJ + PJ_AV + kvh * 64 + w * 8); }
#pragma unroll
    for (int qt = 0; qt < 2; ++qt) { const size_t row = (size_t)b * SEQ + c * 64 + (w & 1) * 32 + qt * 16 + c16;
#pragma unroll
        for (int ks = 0; ks < 2; ++ks) R.q[qt][ks] = *(const u32x4*)(PROJ + row * NPJ + PJ_AQ + hq * 64 + g * 8 + 32 * ks); }
}
__device__ __forceinline__ void attn_prompt_unit(Ctx& F, const Args& a, int l, int b, int c, int kvh, AReg& R, bool has_next, int nb, int nc, int nkvh) {
    using namespace at;
    LAS unsigned char* lds = F.lds;
    const bf16_t* PROJ = (const bf16_t*)(FWS + WS_PROJ); bf16_t* MIX = (bf16_t*)(FWS + WS_MIX);
    const int tid = F.tid, lane = F.lane, w = F.wave, c16 = lane & 15, g = lane >> 4;
    const float* gq = FIN(12) + l * 64; const float* gk = FIN(13) + l * 64;
    float* hsq = (float*)(FWS + WS_HSQ) + (size_t)l * MT * 8; const float* gao = FIN(16) + l * 1024;
    const int nkc = (c < 2 ? c : 2) + 1, nkeys = nkc * 64, nprev = nkeys - 64;
    __syncthreads();
#pragma unroll
    for (int kc = 0; kc < 3; ++kc) if (kc < nkc) {
        const bool own = (kc == nkc - 1) && (c >= 30);
        { const int key = tid >> 3, ch = tid & 7; float f[8]; unpack8(R.kk[kc], f); knorm8(f, gk, ch);
            u32x4 o; o.x = pkbf(f[0], f[1]); o.y = pkbf(f[2], f[3]); o.z = pkbf(f[4], f[5]); o.w = pkbf(f[6], f[7]);
            *(LAS u32x4*)(lds + OFF_KN + (kc * 64 + key) * KS + ch * 16) = o;
            if (own) { float* dst = FOUT + O_PCK + ((size_t)(l * 16 + b) * 128 + (c * 64 + key - 1920)) * 256 + kvh * 64 + ch * 8;
                *(f32x4*)dst = (f32x4){f[0], f[1], f[2], f[3]}; *(f32x4*)(dst + 4) = (f32x4){f[4], f[5], f[6], f[7]}; } }
        { float f[8]; unpack8(R.vv[kc], f);
#pragma unroll
            for (int e = 0; e < 8; ++e) *(LAS bf16_t*)(lds + OFF_VT + (w * 8 + e) * VS + (kc * 64 + lane) * 2) = (bf16_t)(__builtin_bit_cast(unsigned, f[e]) >> 16);
            if (own) { float* dst = FOUT + O_PCV + ((size_t)(l * 16 + b) * 128 + (c * 64 + lane - 1920)) * 256 + kvh * 64 + w * 8;
                *(f32x4*)dst = (f32x4){f[0], f[1], f[2], f[3]}; *(f32x4*)(dst + 4) = (f32x4){f[4], f[5], f[6], f[7]}; } }
    }
    const int hl = w >> 1, hq = kvh * 4 + hl; const float sink = FIN(14)[l * 16 + hq];
    bf16x8 qf[2][2];
#pragma unroll
    for (int qt = 0; qt < 2; ++qt) { float f[2][8]; float ss = 0.f;
#pragma unroll
        for (int ks = 0; ks < 2; ++ks) { unpack8(R.q[qt][ks], f[ks]);
#pragma unroll
            for (int e = 0; e < 8; ++e) ss += f[ks][e] * f[ks][e]; }
        ss += __shfl_xor(ss, 16); ss += __shfl_xor(ss, 32);
        const float rn = 0.125f / sqrtf(ss * (1.0f / 64.0f) + EPS);
#pragma unroll
        for (int ks = 0; ks < 2; ++ks) { u32x4 o; const float* gg = gq + g * 8 + 32 * ks;
            o.x = pkbf(f[ks][0] * rn * gg[0], f[ks][1] * rn * gg[1]); o.y = pkbf(f[ks][2] * rn * gg[2], f[ks][3] * rn * gg[3]);
            o.z = pkbf(f[ks][4] * rn * gg[4], f[ks][5] * rn * gg[5]); o.w = pkbf(f[ks][6] * rn * gg[6], f[ks][7] * rn * gg[7]);
            qf[qt][ks] = __builtin_bit_cast(bf16x8, o); } }
    __syncthreads();
    if (has_next) attn_loadp(R, PROJ, nb, nc, nkvh, tid, lane, w);
    const LAS float* BT = (const LAS float*)(lds + OFF_BT) + hq * 256;
    const int nkb = nkeys >> 5;
    const int qin0 = (w & 1) * 32 + c16;
    float mrun[2] = {sink, sink}, lsum[2] = {(g == 0) ? 1.0f : 0.0f, (g == 0) ? 1.0f : 0.0f};
    f32x4 O[2][4];
#pragma unroll
    for (int qt = 0; qt < 2; ++qt)
#pragma unroll
        for (int dt = 0; dt < 4; ++dt) O[qt][dt] = (f32x4){0.f, 0.f, 0.f, 0.f};
    for (int kb = 0; kb < nkb; ++kb) {
        bf16x8 kf[2][2];
#pragma unroll
        for (int j = 0; j < 2; ++j)
#pragma unroll
            for (int ks = 0; ks < 2; ++ks) kf[j][ks] = *(const LAS bf16x8*)(lds + OFF_KN + (kb * 32 + 16 * j + c16) * KS + (g * 8 + 32 * ks) * 2);
        f32x4 s[2][2];
#pragma unroll
        for (int qt = 0; qt < 2; ++qt)
#pragma unroll
            for (int j = 0; j < 2; ++j) { s[qt][j] = (f32x4){0.f, 0.f, 0.f, 0.f};
#pragma unroll
                for (int ks = 0; ks < 2; ++ks) s[qt][j] = MFMA16(kf[j][ks], qf[qt][ks], s[qt][j]); }
        bf16x8 pf[2];
#pragma unroll
        for (int qt = 0; qt < 2; ++qt) {
#pragma unroll
            for (int j = 0; j < 2; ++j) { const int ib = kb * 32 + 16 * j + 4 * g - nprev - (qin0 + 16 * qt) + 191;
#pragma unroll
                for (int r = 0; r < 4; ++r) s[qt][j][r] += BT[ib + r]; }
            float mx = fmaxf(fmaxf(fmaxf(s[qt][0][0], s[qt][0][1]), fmaxf(s[qt][0][2], s[qt][0][3])), fmaxf(fmaxf(s[qt][1][0], s[qt][1][1]), fmaxf(s[qt][1][2], s[qt][1][3])));
            mx = fmaxf(mx, __shfl_xor(mx, 16)); mx = fmaxf(mx, __shfl_xor(mx, 32));
            const float mnew = fmaxf(mrun[qt], mx), alpha = __expf(mrun[qt] - mnew); mrun[qt] = mnew;
            float ps = 0.f;
#pragma unroll
            for (int j = 0; j < 2; ++j)
#pragma unroll
                for (int r = 0; r < 4; ++r) { s[qt][j][r] = __expf(s[qt][j][r] - mnew); ps += s[qt][j][r]; }
            lsum[qt] = lsum[qt] * alpha + ps;
            u32x4 pw; pw.x = pkbf(s[qt][0][0], s[qt][0][1]); pw.y = pkbf(s[qt][0][2], s[qt][0][3]); pw.z = pkbf(s[qt][1][0], s[qt][1][1]); pw.w = pkbf(s[qt][1][2], s[qt][1][3]);
            pf[qt] = __builtin_bit_cast(bf16x8, pw);
            if (__any(alpha != 1.0f)) {
#pragma unroll
            for (int dt = 0; dt < 4; ++dt) O[qt][dt] = O[qt][dt] * alpha; }
        }
#pragma unroll
        for (int dt = 0; dt < 4; ++dt) { const LAS unsigned char* vp = lds + OFF_VT + (dt * 16 + c16) * VS + (kb * 32 + 4 * g) * 2;
            const u32x2 v0 = *(const LAS u32x2*)vp, v1 = *(const LAS u32x2*)(vp + 32);
            u32x4 vw; vw.x = v0.x; vw.y = v0.y; vw.z = v1.x; vw.w = v1.y; const bf16x8 vf = __builtin_bit_cast(bf16x8, vw);
            O[0][dt] = MFMA16(vf, pf[0], O[0][dt]); O[1][dt] = MFMA16(vf, pf[1], O[1][dt]); }
    }
#pragma unroll
    for (int qt = 0; qt < 2; ++qt) {
        const size_t row = (size_t)b * SEQ + c * 64 + qin0 + 16 * qt;
        float ls = lsum[qt]; ls += __shfl_xor(ls, 16); ls += __shfl_xor(ls, 32);
        const float inv = 1.0f / ls; float aq2 = 0.f;
#pragma unroll
        for (int dt = 0; dt < 4; ++dt) { const f32x4 ov = O[qt][dt] * inv; const f32x4 gg = *(const f32x4*)(gao + hq * 64 + dt * 16 + 4 * g);
            aq2 += (ov[0] * ov[0] + ov[1] * ov[1]) + (ov[2] * ov[2] + ov[3] * ov[3]);
            u32x2 o; o.x = pkbf(ov[0] * gg[0], ov[1] * gg[1]); o.y = pkbf(ov[2] * gg[2], ov[3] * gg[3]);
            *(u32x2*)(MIX + row * DM + 1024 + hq * 64 + dt * 16 + 4 * g) = o; }
        aq2 += __shfl_xor(aq2, 16); aq2 += __shfl_xor(aq2, 32);
        if (g == 0) unsafeAtomicAdd(hsq + row * 8 + 4, aq2);
    }
}

template <int WHICH>
__device__ __forceinline__ void phase_mixers(Ctx& F, const Args& a, int l) {
    float* hsq = (float*)(FWS + WS_HSQ) + (size_t)l * MT * 8; const float* gmo = FIN(15) + l * 1024;
#ifndef DBG_NO_ML
    if (WHICH & 1) for (int u = F.bid; u < 512; u += F.G) {
        const bool smp = u >= 256; const int uu = u & 255, b = uu >> 4, h = (uu >> 2) & 3, vs = uu & 3; const size_t so = (size_t)((l * 16 + b) * 4 + h);
        if (!smp) mlstm_chain(F, a, nullptr, nullptr, nullptr, FOUT + O_PC + so * 32768, FOUT + O_PN + so * 128, FOUT + O_PM + so, b * SEQ, 32, 64, h, vs, hsq, gmo);
        else mlstm_chain(F, a, FIN(4) + so * 32768, FIN(5) + so * 128, FIN(6) + so, FOUT + O_SC + so * 32768, FOUT + O_SN + so * 128, FOUT + O_SM + so, MP + b * SL, 1, 32, h, vs, hsq, gmo);
    }
#endif
#ifndef DBG_NO_ATTN
    if (WHICH & 2) {
        __syncthreads();
        { LAS float* BT = (LAS float*)(F.lds + at::OFF_BT); const float* rb = FIN(7);
            for (int i = F.tid; i < 4096; i += 512) { const int hh = i >> 8, idx = i & 255; BT[i] = (idx < 255) ? rb[t5_bucket(idx - 191) * 16 + hh] : 0.f; } }
        const bf16_t* PROJ = (const bf16_t*)(FWS + WS_PROJ);
        AReg R; int u = F.bid;
        if (u < 2048) attn_loadp(R, PROJ, u >> 7, (u >> 2) & 31, u & 3, F.tid, F.lane, F.wave);
        for (; u < 2048; u += F.G) { const int un = u + F.G;
            attn_prompt_unit(F, a, l, u >> 7, (u >> 2) & 31, u & 3, R, un < 2048, un >> 7, (un >> 2) & 31, un & 3); }
        for (int v = F.bid; v < 64; v += F.G) attn_unit(F, a, l, false, v >> 2, 0, v & 3);
    }
#endif
    __syncthreads();
}

__device__ __forceinline__ void phase_finalize(Ctx& F, const Args& a, int l) {
    const bf16_t* PROJ = (const bf16_t*)(FWS + WS_PROJ); bf16_t* MIX = (bf16_t*)(FWS + WS_MIX);
    const float* gmo = FIN(15) + l * 1024; const float* gao = FIN(16) + l * 1024;
    const int gw = F.bid * 8 + F.wave, NGW = F.G * 8, lane = F.lane;
    u32x4 raw[4], mo[2], rawn[4], mon[2];
    if (gw < MT) {
#pragma unroll
        for (int j = 0; j < 4; ++j) raw[j] = *(const u32x4*)(MIX + (size_t)gw * DM + (lane + 64 * j) * 8);
#pragma unroll
        for (int j = 0; j < 2; ++j) mo[j] = *(const u32x4*)(PROJ + (size_t)gw * NPJ + PJ_MO + (lane + 64 * j) * 8); }
    for (int m = gw; m < MT; m += NGW) {
        bf16_t* mr = MIX + (size_t)m * DM; const int mn = m + NGW;
        if (mn < MT) {
#pragma unroll
            for (int j = 0; j < 4; ++j) rawn[j] = *(const u32x4*)(MIX + (size_t)mn * DM + (lane + 64 * j) * 8);
#pragma unroll
            for (int j = 0; j < 2; ++j) mon[j] = *(const u32x4*)(PROJ + (size_t)mn * NPJ + PJ_MO + (lane + 64 * j) * 8); }
        float f[4][8];
#pragma unroll
        for (int j = 0; j < 4; ++j) unpack8(raw[j], f[j]);
        float sa = 0.f;
#pragma unroll
        for (int j = 0; j < 2; ++j) { float ss = 0.f;
#pragma unroll
            for (int e = 0; e < 8; ++e) ss += f[j][e] * f[j][e];
            ss += __shfl_xor(ss, 1); ss += __shfl_xor(ss, 2); ss += __shfl_xor(ss, 4); ss += __shfl_xor(ss, 8); ss += __shfl_xor(ss, 16);
            const float rn = 1.0f / sqrtf(ss * (1.0f / 256.0f) + EPS);
            float o[8], mf[8]; unpack8(mo[j], mf); const float* gg = gmo + (lane + 64 * j) * 8;
#pragma unroll
            for (int e = 0; e < 8; ++e) o[e] = f[j][e] * rn * gg[e] * (1.0f / (1.0f + __expf(-mf[e])));
            u32x4 ow; ow.x = pkbf(o[0], o[1]); ow.y = pkbf(o[2], o[3]); ow.z = pkbf(o[4], o[5]); ow.w = pkbf(o[6], o[7]);
            *(u32x4*)(mr + (lane + 64 * j) * 8) = ow; }
#pragma unroll
        for (int j = 2; j < 4; ++j)
#pragma unroll
            for (int e = 0; e < 8; ++e) sa += f[j][e] * f[j][e];
        sa = wave_sum(sa);
        const float ra = 1.0f / sqrtf(sa * (1.0f / 1024.0f) + EPS);
#pragma unroll
        for (int j = 2; j < 4; ++j) { float o[8]; const float* gg = gao + (lane + 64 * (j - 2)) * 8;
#pragma unroll
            for (int e = 0; e < 8; ++e) o[e] = f[j][e] * ra * gg[e];
            u32x4 ow; ow.x = pkbf(o[0], o[1]); ow.y = pkbf(o[2], o[3]); ow.z = pkbf(o[4], o[5]); ow.w = pkbf(o[6], o[7]);
            *(u32x4*)(mr + (lane + 64 * j) * 8) = ow; }
#pragma unroll
        for (int j = 0; j < 4; ++j) raw[j] = rawn[j];
#pragma unroll
        for (int j = 0; j < 2; ++j) mo[j] = mon[j];
    }
}

#define XB_TMO      128
#define XB_XCNT(j)  (256  + 64 * (j))
#define XB_XSUB(j)  (1280 + 64 * (j))
#define XB_XGEN(j)  (2304 + 64 * (j))
#define XB_TOP      3328
#define XB_TOPGEN   3392
#define XCD_BAR_WORDS 3456
#define XB_SPIN_CAP (1u << 18)

__device__ __forceinline__ unsigned xb_ld(unsigned* p)              { return __hip_atomic_load(p, __ATOMIC_RELAXED, __HIP_MEMORY_SCOPE_AGENT); }
__device__ __forceinline__ unsigned xb_add(unsigned* p, unsigned v) { return __hip_atomic_fetch_add(p, v, __ATOMIC_RELAXED, __HIP_MEMORY_SCOPE_AGENT); }
__device__ __forceinline__ unsigned xb_xcc_id() { return (unsigned)__builtin_amdgcn_s_getreg((3 << 11) | 20) & 0xFu; }
#define XB_SPIN(cond, bar) do { unsigned _sp = 0; while (cond) { __builtin_amdgcn_s_sleep(1); \
    if ((++_sp & 255u) == 0u) { if (xb_ld(&(bar)[XB_TMO])) break; if (_sp > XB_SPIN_CAP) { atomicAdd(&(bar)[XB_TMO], 1u); break; } } } } while (0)

struct XcdBarrier {
    unsigned* bar; unsigned x;
    volatile LAS unsigned* st;
};

__device__ __forceinline__ XcdBarrier xcd_barrier_post(unsigned* bar, volatile LAS unsigned* st) {
    XcdBarrier b; b.bar = bar; b.x = xb_xcc_id(); b.st = st;
    if (threadIdx.x == 0) (void)xb_add(&bar[XB_XCNT(b.x)], 1u);
    return b;
}
__device__ __forceinline__ void xcd_barrier_complete(unsigned* bar, unsigned x, unsigned& nloc, unsigned& nx) {
    const unsigned G = gridDim.x * gridDim.y * gridDim.z;
    unsigned sum, cnt, mine, sp = 0u;
    for (;;) {
        sum = 0u; cnt = 0u; mine = 0u;
#pragma unroll
        for (unsigned j = 0; j < 16; ++j) { const unsigned c = xb_ld(&bar[XB_XCNT(j)]); sum += c; cnt += (c > 0u) ? 1u : 0u; mine = (j == x) ? c : mine; }
        if (sum == G) break;
        __builtin_amdgcn_s_sleep(1);
        if ((++sp & 255u) == 0u) { if (xb_ld(&bar[XB_TMO])) break; if (sp > XB_SPIN_CAP) { atomicAdd(&bar[XB_TMO], 1u); break; } }
    }
    nloc = mine > 0u ? mine : 1u; nx = cnt > 0u ? cnt : 1u;
}

__device__ __forceinline__ void xcd_barrier(const XcdBarrier& b) {
    asm volatile("s_waitcnt vmcnt(0)" ::: "memory");
    __syncthreads();
    if (threadIdx.x == 0) {
        unsigned* bar = b.bar;
        __builtin_amdgcn_s_waitcnt(0);
        unsigned nloc = b.st[0], nx = b.st[1];
        if (nloc == 0u) { xcd_barrier_complete(bar, b.x, nloc, nx); b.st[0] = nloc; b.st[1] = nx; }
        const unsigned old = xb_add(&bar[XB_XSUB(b.x)], 1u);
        const unsigned gen = old / nloc;
        if (old + 1u == (gen + 1u) * nloc) {
            __builtin_amdgcn_fence(__ATOMIC_RELEASE, "agent");
            asm volatile("s_waitcnt vmcnt(0)" ::: "memory");
            const unsigned og = xb_add(&bar[XB_TOP], 1u);
            const unsigned tg = og / nx;
            if (og + 1u == (tg + 1u) * nx) xb_add(&bar[XB_TOPGEN], 1u);
            else XB_SPIN(xb_ld(&bar[XB_TOPGEN]) == tg, bar);
            __builtin_amdgcn_fence(__ATOMIC_ACQUIRE, "agent");
            xb_add(&bar[XB_XGEN(b.x)], 1u);
            asm volatile("s_waitcnt vmcnt(0)" ::: "memory");
        } else {
            XB_SPIN(xb_ld(&bar[XB_XGEN(b.x)]) == gen, bar);
            __builtin_amdgcn_fence(__ATOMIC_ACQUIRE, "agent");
            asm volatile("s_waitcnt vmcnt(0)" ::: "memory");
        }
    }
    __syncthreads();
}

constexpr int N_PHASES = 16;

__global__ void __launch_bounds__(512, 2) hymba_fwd(Args a) {
    extern __shared__ __attribute__((aligned(16))) unsigned char lds_raw[];
    cg::grid_group grid = cg::this_grid();
    Ctx F;
    F.lds = (LAS unsigned char*)lds_raw;
    F.tid = threadIdx.x; F.lane = F.tid & 63; F.wave = __builtin_amdgcn_readfirstlane(F.tid >> 6); F.G = gridDim.x; F.bid = blockIdx.x;
    float* Y = a.out;
    bf16_t* XN = (bf16_t*)(FWS + WS_XN); bf16_t* PROJ = (bf16_t*)(FWS + WS_PROJ); bf16_t* MIX = (bf16_t*)(FWS + WS_MIX); bf16_t* U = (bf16_t*)(FWS + WS_BIG);
    if (blockIdx.x == 0) for (int i = threadIdx.x; i < XCD_BAR_WORDS; i += 512) ((unsigned*)FWS)[i] = 0u;
    if (threadIdx.x < 4) ((LAS unsigned*)(F.lds + 131072 + 64))[threadIdx.x] = 0u;
    __syncthreads();
    XcdBarrier bar; bar.bar = (unsigned*)FWS; bar.x = 0; bar.st = nullptr; bool census = false;
    for (int ph = a.ph_lo; ph < a.ph_hi; ++ph) {
        if (ph > a.ph_lo && ph != 1) {
            if (!census) { grid.sync();
                bar = xcd_barrier_post((unsigned*)FWS, (volatile LAS unsigned*)(F.lds + 131072 + 64)); census = true; }
            else xcd_barrier(bar);
        }
        { int t_ = threadIdx.x; asm volatile("" : "+v"(t_)); F.tid = t_; F.lane = t_ & 63; F.wave = __builtin_amdgcn_readfirstlane(t_ >> 6); }
        if (ph == 0) {
#ifndef NO_W
#ifdef PROBE_W2
 phase_weights(F, a); __syncthreads(); phase_weights(F, a); __syncthreads();
#endif
 phase_weights(F, a);
#endif
 __syncthreads(); continue; }
        if (ph == 1) { phase_convert(F, a); __syncthreads(); continue; }
        const int l = (ph - 2) / 7, s = (ph - 2) % 7;
        bf16_t* XB = XN; float* SSQ = (float*)(FWS + WS_SSQ); float* HSQ = (float*)(FWS + WS_HSQ) + (size_t)l * MT * 8;
        float* ssq_in = SSQ + (l == 0 ? 0 : 2 * MT);
        float* ssq_mid = SSQ + (l == 0 ? MT : 3 * MT);
        if (s == 0) { pg8::Gemm g{XB, (const bf16_t*)(FWS + WS_WIN) + (size_t)l * NPW * DM, MT, NPW, DM, DM}; pg8::StaticOrder S; S.init(MT, NPW, F.G, F.bid);
            pg8::EpiScale<0, true> E{PROJ, NPJ, ssq_in, 1.0f / DM, EPS, (float*)(FWS + WS_GATES), FIN(10) + l * 4, FIN(11) + l * 4, NPJ / 256};
            pg8::gemm_phase<pg8::EpiScale<0, true>, pg8::StaticOrder, true, true>(F.lds, g, S, E); }
        else if (s == 1) phase_mixers<3>(F, a, l);
        else if (s == 2 || s == 5) {
            pg8::Gemm g;
            if (s == 2) g = pg8::Gemm{MIX, (const bf16_t*)(FWS + WS_WOUT) + (size_t)l * DM * DM, MP, DM, DM, DM};
            else g = pg8::Gemm{U, (const bf16_t*)(FWS + WS_WDN) + (size_t)l * DM * FF, MP, DM, FF, FF};
            pg8::StaticOrder S; S.init(MP, DM, F.G, F.bid);
            if (s == 2) { pg8::EpiResBK E{XB, DM, ssq_mid, HSQ, EPS}; pg8::gemm_phase<pg8::EpiResBK, pg8::StaticOrder, false, true>(F.lds, g, S, E); }
            else if (l == 1) { pg8::EpiResF E{XB, Y, DM}; pg8::gemm_phase<pg8::EpiResF, pg8::StaticOrder, false, true>(F.lds, g, S, E); }
            else { pg8::EpiResB E{XB, DM, SSQ + 2 * MT}; pg8::gemm_phase<pg8::EpiResB, pg8::StaticOrder, false, true>(F.lds, g, S, E); }
            __syncthreads();
            const int kfull = (s == 2) ? DM : FF; pg8::Gemm g2 = g; g2.K = kfull / 16;
            pg8::SplitKOrder S2; S2.init(DM, 16, kfull / 16, MP / 256, F.G, F.bid);
            pg8::EpiPartial E2{(float*)(FWS + WS_PART), DM, kfull / 16, MP, MS};
            pg8::gemm_phase<pg8::EpiPartial, pg8::SplitKOrder, true, true>(F.lds, g2, S2, E2); }
        else if (s == 3) phase_fold(F, a, ssq_mid, nullptr, HSQ);
        else if (s == 4) { pg8::Gemm g{XB, (const bf16_t*)(FWS + WS_WUP) + (size_t)l * FF * DM, MT, FF, DM, DM}; pg8::StaticOrder S; S.init(MT, FF, F.G, F.bid);
            pg8::EpiScale<2, false> E{U, FF, ssq_mid, 1.0f / DM, EPS, nullptr, nullptr, nullptr, -1};
            pg8::gemm_phase<pg8::EpiScale<2, false>, pg8::StaticOrder, true, true>(F.lds, g, S, E); }
        else { if (l == 0) phase_fold(F, a, SSQ + 2 * MT, nullptr, nullptr); else phase_fold(F, a, nullptr, Y, nullptr); }
        __syncthreads();
    }
#ifdef DBG_STOP
    grid.sync();
#ifdef DBG_F32
    { const float* src = (const float*)(FWS + DBG_SRC); const size_t n = (size_t)DBG_F32;
      for (size_t i = (size_t)blockIdx.x * 512 + threadIdx.x; i < n; i += (size_t)gridDim.x * 512) Y[i] = src[i]; }
#else
    { const bf16_t* src = (const bf16_t*)(FWS + DBG_SRC); const size_t n = (size_t)MT * DM;
      for (size_t i = (size_t)blockIdx.x * 512 + threadIdx.x; i < n; i += (size_t)gridDim.x * 512) Y[i] = __builtin_bit_cast(float, (unsigned)src[i] << 16); }
#endif
#endif
}

#ifndef N_LAUNCH_MODE
#define N_LAUNCH_MODE 0
#endif
extern "C" void kernel_launch(void* const* d_in, const int* in_sizes, int n_in, void* d_out, int out_size, void* d_ws, size_t ws_size, hipStream_t stream) {
    static int grid = 0;
    if (grid == 0) {
        if (n_in != 21 || out_size != 80773376 || ws_size < WS_END) { fprintf(stderr, "kernel_launch: unexpected shapes (n_in %d out %d ws %zu need %zu)\n", n_in, out_size, ws_size, (size_t)WS_END); grid = -1; return; }
        int dev = 0, cus = 0, per_cu = 0;
        hipGetDevice(&dev); hipDeviceGetAttribute(&cus, hipDeviceAttributeMultiprocessorCount, dev);
        if (hipFuncSetAttribute((const void*)hymba_fwd, hipFuncAttributeMaxDynamicSharedMemorySize, LDS_BYTES) != hipSuccess) { fprintf(stderr, "kernel_launch: hipFuncSetAttribute failed\n"); grid = -1; return; }
        if (hipOccupancyMaxActiveBlocksPerMultiprocessor(&per_cu, (const void*)hymba_fwd, 512, LDS_BYTES) != hipSuccess || per_cu < 1) { fprintf(stderr, "kernel_launch: occupancy query gave %d\n", per_cu); per_cu = 1; }
        (void)hipGetLastError();
        grid = cus * per_cu;
        fprintf(stderr, "kernel_launch: grid %d (cus %d x %d)\n", grid, cus, per_cu);
    }
    if (grid < 0) return;
#ifdef DBG_MEMSET
    (void)hipMemsetAsync(d_ws, 0, WS_END, stream); (void)hipMemsetAsync(d_out, 0, (size_t)out_size * 4, stream);
#endif
    Args a{};
    for (int i = 0; i < 21; ++i) a.in[i] = (const float*)d_in[i];
    a.out = (float*)d_out; a.ws = (unsigned char*)d_ws;
#if N_LAUNCH_MODE == 0
#ifdef DBG_STOP
    a.ph_lo = 0; a.ph_hi = DBG_STOP;
#else
    a.ph_lo = 0; a.ph_hi = N_PHASES;
#endif
    { void* args[] = {&a}; hipError_t e = hipLaunchCooperativeKernel((const void*)hymba_fwd, dim3(grid), dim3(512), args, LDS_BYTES, stream);
        if (e != hipSuccess) fprintf(stderr, "cooperative launch failed: %s (grid %d)\n", hipGetErrorString(e), grid); }
#else
    for (int p = 0; p < N_PHASES; ++p) { a.ph_lo = p; a.ph_hi = p + 1; void* args[] = {&a};
        hipError_t e = hipLaunchCooperativeKernel((const void*)hymba_fwd, dim3(grid), dim3(512), args, LDS_BYTES, stream);
        if (e != hipSuccess) { fprintf(stderr, "cooperative launch %d failed: %s (grid %d)\n", p, hipGetErrorString(e), grid); break; } }
#endif
}
```
